# Optimizing an MI355X kernel written in HIP

```python
import math
import jax, jax.numpy as jnp
from jax import lax
import numpy as np

D_MODEL = 1024
BATCH = 16
SEQ = 2048
DEPTH = 2

HG_HEADS = 4
HG_DK = 128
HG_DV = 128
HG_WIDTH = HG_HEADS * HG_DK
HG_CHUNK = 64
ATT_HEADS = 8
ATT_DH = 64
ATT_WIDTH = ATT_HEADS * ATT_DH
DILATED_PATTERNS = ((128, 1), (512, 4), (2048, 16))
ROPE_DIMS = ATT_DH // 4
ROPE_THETA = 500000.0
MIX_WIDTH = HG_WIDTH + ATT_WIDTH
IN_SPLITS = (HG_WIDTH, HG_WIDTH, HG_WIDTH, HG_WIDTH, HG_WIDTH, ATT_WIDTH, ATT_WIDTH, ATT_WIDTH)
IN_COLS = sum(IN_SPLITS)
N_GROUPS = 4
EXPERTS_PER_GROUP = 8
N_EXPERTS = N_GROUPS * EXPERTS_PER_GROUP
TOP_K = 2
D_EXPERT = D_MODEL // 2
MOE_BLOCK = 256
DEEPNORM_ALPHA = (2 * DEPTH) ** 0.25
DEEPNORM_BETA = (8 * DEPTH) ** -0.25
LN_EPS = 1e-5
RMS_EPS = 1e-6
NEG_BIG = -1e30

kernel_name = 'hymba_hgrn2_dilated_attn_hier_moe_deepnorm'


def _layernorm(x, g, b):
    xf = x.astype(jnp.float32)
    mu = xf.mean(-1, keepdims=True)
    var = jnp.square(xf - mu).mean(-1, keepdims=True)
    return ((xf - mu) * lax.rsqrt(var + LN_EPS) * g + b).astype(x.dtype)


def _heads(t, n):
    B, S, W = t.shape
    return t.reshape(B, S, n, W // n).transpose(0, 2, 1, 3)


def _forget_gate(a, lb):
    log_f = jnp.logaddexp(jnp.log(lb), jnp.log1p(-lb) + jax.nn.log_sigmoid(a))
    k = (1.0 - lb) * jax.nn.sigmoid(-a)
    return k, log_f


def _chunk_gla(q, k, v, log_f):
    B, H, S, dk = q.shape
    dv = v.shape[-1]
    n = S // HG_CHUNK

    def chunks(t):
        return jnp.moveaxis(t.reshape(B, H, n, HG_CHUNK, t.shape[-1]), 2, 0)

    tri = jnp.tril(jnp.ones((HG_CHUNK, HG_CHUNK), bool))[:, :, None]

    def step(state, inp):
        qc, kc, vc, gc = inp
        b = jnp.cumsum(gc, axis=2)
        rel = b[:, :, :, None, :] - b[:, :, None, :, :]
        decay = jnp.exp(jnp.where(tri, rel, -jnp.inf))
        scores = jnp.einsum('bhtc,bhsc,bhtsc->bhts', qc, kc, decay)
        o = (jnp.einsum('bhts,bhsv->bhtv', scores, vc)
             + jnp.einsum('bhtc,bhcv->bhtv', qc * jnp.exp(b), state))
        b_end = b[:, :, -1:, :]
        state = (jnp.exp(b_end[:, :, 0, :, None]) * state
                 + jnp.einsum('bhsc,bhsv->bhcv', kc * jnp.exp(b_end - b), vc))
        return state, o

    s0 = jnp.zeros((B, H, dk, dv), jnp.float32)
    _, o = lax.scan(step, s0, (chunks(q), chunks(k), chunks(v), chunks(log_f)))
    return jnp.moveaxis(o, 0, 2).reshape(B, H, S, dv)


def _hgrn2_group(hq, hf_f, hf_b, hi, hg, lb, norm_g):
    B, S, _ = hq.shape
    f32 = jnp.float32
    q = _heads(hq.astype(f32), HG_HEADS) * HG_DK ** -0.5
    v = _heads(hi.astype(f32), HG_HEADS)
    lb = lb.astype(f32).reshape(2, HG_HEADS, 1, HG_DK)
    k_f, g_f = _forget_gate(_heads(hf_f.astype(f32), HG_HEADS), lb[0])
    k_b, g_b = _forget_gate(_heads(hf_b.astype(f32), HG_HEADS), lb[1])
    flip = lambda t: jnp.flip(t, axis=2)
    o_fwd = _chunk_gla(q, k_f, v, g_f)
    o_bwd = flip(_chunk_gla(flip(q), flip(k_b), flip(v), flip(g_b)))
    o = (o_fwd + o_bwd).transpose(0, 2, 1, 3)
    o = o * lax.rsqrt(jnp.mean(jnp.square(o), -1, keepdims=True) + RMS_EPS)
    o = o * norm_g.astype(f32).reshape(HG_HEADS, HG_DV)
    return o.reshape(B, S, HG_WIDTH) * jax.nn.silu(hg.astype(f32))


def _rope(x, pos):
    half = ROPE_DIMS // 2
    inv_freq = ROPE_THETA ** (-jnp.arange(half, dtype=jnp.float32) / half)
    ang = pos[:, None] * inv_freq[None, :]
    cos = jnp.cos(ang)[None, :, None, :]
    sin = jnp.sin(ang)[None, :, None, :]
    x1, x2 = x[..., :half], x[..., half:ROPE_DIMS]
    return jnp.concatenate([x1 * cos - x2 * sin, x1 * sin + x2 * cos, x[..., ROPE_DIMS:]], axis=-1)


def _dilated_branch(q, k, v, dilation, radius):
    B, S, H, dh = q.shape
    L = S // dilation

    def fold(t):
        return t.reshape(B, L, dilation, H, dh).transpose(0, 2, 3, 1, 4)

    blk = radius
    nb = -(-L // blk)
    Lp = nb * blk
    qb = jnp.pad(fold(q), ((0, 0),) * 3 + ((0, Lp - L), (0, 0))).reshape(B, dilation, H, nb, blk, dh)
    pad_kv = ((0, 0),) * 3 + ((blk, Lp - L + blk), (0, 0))

    def neighbours(t):
        tb = jnp.pad(fold(t), pad_kv).reshape(B, dilation, H, nb + 2, blk, dh)
        return jnp.concatenate([tb[:, :, :, :-2], tb[:, :, :, 1:-1], tb[:, :, :, 2:]], axis=4)

    kb, vb = neighbours(k), neighbours(v)
    s = jnp.einsum('bdhnqe,bdhnke->bdhnqk', qb, kb)
    qpos = jnp.arange(nb)[:, None] * blk + jnp.arange(blk)[None, :]
    kpos = (jnp.arange(nb)[:, None] - 1) * blk + jnp.arange(3 * blk)[None, :]
    kp = kpos[:, None, :]
    mask = (jnp.abs(kp - qpos[:, :, None]) <= radius) & (kp >= 0) & (kp < L)
    s = jnp.where(mask, s, NEG_BIG)
    m = s.max(-1, keepdims=True)
    p = jnp.exp(s - m)
    den = p.sum(-1)
    o = jnp.einsum('bdhnqk,bdhnke->bdhnqe', p, vb) / den[..., None]
    lse = m[..., 0] + jnp.log(den)
    o = o.reshape(B, dilation, H, Lp, dh)[:, :, :, :L].transpose(0, 3, 1, 2, 4).reshape(B, S, H, dh)
    lse = lse.reshape(B, dilation, H, Lp)[..., :L].transpose(0, 3, 1, 2).reshape(B, S, H)
    return o, lse


def _dilated_attention_group(aq, ak, av):
    B, S, _ = aq.shape
    f32 = jnp.float32
    pos = jnp.arange(S, dtype=f32)
    shp = (B, S, ATT_HEADS, ATT_DH)
    q = _rope(aq.astype(f32).reshape(shp), pos) * ATT_DH ** -0.5
    k = _rope(ak.astype(f32).reshape(shp), pos)
    v = av.astype(f32).reshape(shp)
    outs, lses = [], []
    for window, dilation in DILATED_PATTERNS:
        o, lse = _dilated_branch(q, k, v, dilation, window // (2 * dilation))
        outs.append(o)
        lses.append(lse)
    w = jax.nn.softmax(jnp.stack(lses), axis=0)
    o = jnp.einsum('pbsh,pbshe->bshe', w, jnp.stack(outs))
    return o.reshape(B, S, ATT_WIDTH)


def _hybrid_mixer(h, w_in, lb, norm_g, w_out):
    proj = jnp.einsum('bsd,dc->bsc', h, w_in)
    cuts = [sum(IN_SPLITS[:i + 1]) for i in range(len(IN_SPLITS) - 1)]
    hq, hf_f, hf_b, hi, hg, aq, ak, av = jnp.split(proj, cuts, axis=-1)
    y_hg = _hgrn2_group(hq, hf_f, hf_b, hi, hg, lb, norm_g)
    y_att = _dilated_attention_group(aq, ak, av)
    y = jnp.concatenate([y_hg, y_att], axis=-1).astype(h.dtype)
    return jnp.einsum('bsc,cd->bsd', y, w_out)


def _hier_moe(h, w_r1, b_r1, w_r2, b_r2, w_gate, w_up, w_down):
    B, S, D = h.shape
    f32 = jnp.float32
    t = h.reshape(-1, D)
    T = t.shape[0]
    p1 = jax.nn.softmax((t @ w_r1 + b_r1).astype(f32), axis=-1)
    grp = jnp.argmax(p1, axis=-1)
    p_grp = jnp.max(p1, axis=-1)
    lg2 = (t @ w_r2 + b_r2).astype(f32).reshape(T, N_GROUPS, EXPERTS_PER_GROUP)
    lg2 = jnp.take_along_axis(lg2, grp[:, None, None], axis=1)[:, 0]
    w2, e2 = lax.top_k(jax.nn.softmax(lg2, axis=-1), TOP_K)
    w2 = w2 / w2.sum(-1, keepdims=True)
    expert = (grp[:, None] * EXPERTS_PER_GROUP + e2).reshape(-1)
    gate = (p_grp[:, None] * w2)
    A = T * TOP_K
    tok = jnp.arange(A, dtype=jnp.int32) // TOP_K
    order = jnp.argsort(expert)
    e_sorted = expert[order]
    counts = jnp.zeros((N_EXPERTS,), jnp.int32).at[expert].add(1)
    starts = jnp.cumsum(counts) - counts
    padded = (counts + MOE_BLOCK - 1) // MOE_BLOCK * MOE_BLOCK
    pends = jnp.cumsum(padded)
    pstarts = pends - padded
    dest_sorted = pstarts[e_sorted] + jnp.arange(A, dtype=jnp.int32) - starts[e_sorted]
    dest = jnp.zeros((A,), jnp.int32).at[order].set(dest_sorted)
    n_blocks = -(-A // MOE_BLOCK) + N_EXPERTS
    P = n_blocks * MOE_BLOCK
    slot_tok = jnp.full((P,), T, jnp.int32).at[dest].set(tok)
    block_exp = jnp.clip(jnp.searchsorted(pends, jnp.arange(n_blocks) * MOE_BLOCK, side='right'), 0, N_EXPERTS - 1)
    t_pad = jnp.concatenate([t, jnp.zeros((1, D), t.dtype)], axis=0)
    xs = t_pad[slot_tok].reshape(n_blocks, MOE_BLOCK, D)

    def expert_block(args):
        xb, e = args
        hid = jax.nn.silu(xb @ w_gate[e]) * (xb @ w_up[e])
        return hid @ w_down[e]

    ys = lax.map(expert_block, (xs, block_exp)).reshape(P, D)
    y = jnp.sum(ys[dest].reshape(T, TOP_K, D) * gate[..., None].astype(ys.dtype), axis=1)
    return y.reshape(B, S, D).astype(h.dtype)


def setup_inputs(seed: int = 0) -> dict:
    key = jax.random.key(seed)
    ks = jax.random.split(key, 16)
    f32 = jnp.float32

    def normal(k, shape, scale):
        return jax.random.normal(k, shape, f32) * scale

    beta = DEEPNORM_BETA
    x = normal(ks[0], (BATCH, SEQ, D_MODEL), 1.0)
    col_scale = jnp.concatenate([
        jnp.ones((3 * HG_WIDTH,), f32), jnp.full((HG_WIDTH,), beta, f32),
        jnp.ones((HG_WIDTH + 2 * ATT_WIDTH,), f32), jnp.full((ATT_WIDTH,), beta, f32)])
    w_in = normal(ks[1], (DEPTH, D_MODEL, IN_COLS), D_MODEL ** -0.5) * col_scale
    hg_lb_logits = normal(ks[2], (DEPTH, 2, HG_WIDTH), 0.5)
    hg_norm_g = 1.0 + normal(ks[3], (DEPTH, HG_WIDTH), 0.02)
    w_out = normal(ks[4], (DEPTH, MIX_WIDTH, D_MODEL), MIX_WIDTH ** -0.5 * beta)
    ln1_g = 1.0 + normal(ks[5], (DEPTH, D_MODEL), 0.02)
    ln1_b = normal(ks[6], (DEPTH, D_MODEL), 0.02)
    router_w1 = normal(ks[7], (DEPTH, D_MODEL, N_GROUPS), D_MODEL ** -0.5)
    router_b1 = normal(ks[8], (DEPTH, N_GROUPS), 0.01)
    router_w2 = normal(ks[9], (DEPTH, D_MODEL, N_EXPERTS), D_MODEL ** -0.5)
    router_b2 = normal(ks[10], (DEPTH, N_EXPERTS), 0.01)
    ex_w_gate = normal(ks[11], (DEPTH, N_EXPERTS, D_MODEL, D_EXPERT), D_MODEL ** -0.5)
    ex_w_up = normal(ks[12], (DEPTH, N_EXPERTS, D_MODEL, D_EXPERT), D_MODEL ** -0.5)
    ex_w_down = normal(ks[13], (DEPTH, N_EXPERTS, D_EXPERT, D_MODEL), D_EXPERT ** -0.5 * beta)
    ln2_g = 1.0 + normal(ks[14], (DEPTH, D_MODEL), 0.02)
    ln2_b = normal(ks[15], (DEPTH, D_MODEL), 0.02)
    return {'x': x, 'w_in': w_in, 'hg_lb_logits': hg_lb_logits, 'hg_norm_g': hg_norm_g,
            'w_out': w_out, 'ln1_g': ln1_g, 'ln1_b': ln1_b,
            'router_w1': router_w1, 'router_b1': router_b1, 'router_w2': router_w2, 'router_b2': router_b2,
            'ex_w_gate': ex_w_gate, 'ex_w_up': ex_w_up, 'ex_w_down': ex_w_down,
            'ln2_g': ln2_g, 'ln2_b': ln2_b}


def reference(x, w_in, hg_lb_logits, hg_norm_g, w_out, ln1_g, ln1_b,
              router_w1, router_b1, router_w2, router_b2,
              ex_w_gate, ex_w_up, ex_w_down, ln2_g, ln2_b):
    lb_all = jnp.cumsum(jax.nn.softmax(hg_lb_logits.astype(jnp.float32), axis=0), axis=0)
    lb_all = lb_all - lb_all[0:1]
    h = x
    for l in range(DEPTH):
        mix = _hybrid_mixer(h, w_in[l], lb_all[l], hg_norm_g[l], w_out[l])
        h = _layernorm(DEEPNORM_ALPHA * h + mix, ln1_g[l], ln1_b[l])
        ffn = _hier_moe(h, router_w1[l], router_b1[l], router_w2[l], router_b2[l],
                        ex_w_gate[l], ex_w_up[l], ex_w_down[l])
        h = _layernorm(DEEPNORM_ALPHA * h + ffn, ln2_g[l], ln2_b[l])
    return h
```

```cpp
#include <hip/hip_runtime.h>
#include <hip/hip_bf16.h>
#include <stdint.h>

#define T_TOK 32768
#define DM 1024
#define SEQ 2048
#define NB 16
#define INC 4096
#define NEXP 32
#define DEXP 512
#define PSLOTS ((T_TOK * 2 / 256 + NEXP) * 256)
#define ALPHA 1.41421356237309515f

typedef unsigned short bf16_t;
__device__ __forceinline__ float bf2f(bf16_t b) { return __uint_as_float(((unsigned)b) << 16); }
__device__ __forceinline__ bf16_t f2bf(float f) { unsigned u = __float_as_uint(f); u += 0x7FFFu + ((u >> 16) & 1u); return (bf16_t)(u >> 16); }
__device__ __forceinline__ float wave_sum(float v) {
#pragma unroll
    for (int o = 32; o >= 1; o >>= 1) v += __shfl_xor(v, o);
    return v;
}
__device__ __forceinline__ float siluf(float x) { return x / (1.0f + __expf(-x)); }

struct GemmP {
    const float* A; int lda; const int* rowidx; int zero_row;
    const float* W; long wstride; const int* tile_exp;
    int M, N, K;
    void* out; int ldo; const float* aux; const float* lb;
};
template <int MODE>
__global__ __launch_bounds__(256) void naive_gemm(GemmP p) {
    __shared__ float As[16][68];
    __shared__ float Ws[16][68];
    const int tid = threadIdx.x, tx = tid & 15, ty = tid >> 4;
    const int m0 = blockIdx.y * 64, n0 = blockIdx.x * 64;
    const float* W = p.W;
    if (p.tile_exp) { int e = p.tile_exp[m0 >> 8]; if (e < 0) return; W += (long)e * p.wstride; }
    float acc[4][4];
#pragma unroll
    for (int i = 0; i < 4; ++i)
#pragma unroll
        for (int j = 0; j < 4; ++j) acc[i][j] = 0.f;
    const int ar = tid >> 2, ak = (tid & 3) * 4;
    long arow = m0 + ar; bool azero = false;
    if (p.rowidx) { int t = p.rowidx[m0 + ar]; if (t >= p.zero_row) { azero = true; t = 0; } arow = t; }
    const float* Ap = p.A + arow * (long)p.lda + ak;
    const int wk = tid >> 4, wc = (tid & 15) * 4;
    const float* Wp = W + (long)wk * p.N + n0 + wc;
    for (int k0 = 0; k0 < p.K; k0 += 16) {
        float4 av = azero ? make_float4(0.f, 0.f, 0.f, 0.f) : *(const float4*)(Ap + k0);
        float4 wv = *(const float4*)(Wp + (long)k0 * p.N);
        __syncthreads();
        As[ak + 0][ar] = av.x; As[ak + 1][ar] = av.y; As[ak + 2][ar] = av.z; As[ak + 3][ar] = av.w;
        *(float4*)&Ws[wk][wc] = wv;
        __syncthreads();
#pragma unroll
        for (int k = 0; k < 16; ++k) {
            float4 a = *(const float4*)&As[k][ty * 4];
            float4 w = *(const float4*)&Ws[k][tx * 4];
            float aa[4] = {a.x, a.y, a.z, a.w}, ww[4] = {w.x, w.y, w.z, w.w};
#pragma unroll
            for (int i = 0; i < 4; ++i)
#pragma unroll
                for (int j = 0; j < 4; ++j) acc[i][j] = fmaf(aa[i], ww[j], acc[i][j]);
        }
    }
#pragma unroll
    for (int i = 0; i < 4; ++i) {
        const long row = m0 + ty * 4 + i;
#pragma unroll
        for (int j = 0; j < 4; ++j) {
            const int col = n0 + tx * 4 + j;
            float v = acc[i][j];
            if (MODE == 0) {
                const int reg = col >> 9;
                if (reg == 0) v *= 0.08838834764831845f;
                else if (reg == 4) v = siluf(v);
                else if (reg == 5) v *= 0.125f;
                ((bf16_t*)p.out)[row * p.ldo + col] = f2bf(v);
            } else if (MODE == 1) {
                ((float*)p.out)[row * p.ldo + col] = ALPHA * p.aux[row * p.ldo + col] + v;
            } else if (MODE == 2) {
                ((float*)p.out)[row * p.ldo + col] = v;
            } else if (MODE == 3) {
                float g = ((float*)p.out)[row * p.ldo + col];
                ((float*)p.out)[row * p.ldo + col] = siluf(g) * v;
            }
        }
    }
}

__global__ void rope_kernel(bf16_t* proj) {
    const long idx = (long)blockIdx.x * blockDim.x + threadIdx.x;
    if (idx >= (long)T_TOK * 2 * 8 * 8) return;
    const int j = idx & 7, head = (idx >> 3) & 7, which = (idx >> 6) & 1; const long tok = idx >> 7;
    const int pos = (int)(tok % SEQ);
    const double inv = pow(500000.0, -(double)j / 8.0);
    const double ang = (double)pos * inv;
    const float c = (float)cos(ang), s = (float)sin(ang);
    bf16_t* base = proj + tok * INC + 2560 + which * 512 + head * 64;
    const float x1 = bf2f(base[j]), x2 = bf2f(base[j + 8]);
    base[j] = f2bf(x1 * c - x2 * s);
    base[j + 8] = f2bf(x1 * s + x2 * c);
}

__global__ __launch_bounds__(256) void hgrn_naive(const bf16_t* proj, const float* lb_logits  , int layer, float* o_f, float* o_b) {
    __shared__ float red[2][4][8];
    const int bid = blockIdx.x; const int dir = bid & 1, h = (bid >> 1) & 3, b = bid >> 3; const int vsl = blockIdx.y;
    const int tid = threadIdx.x, c = tid & 127, vs = tid >> 7, wave = tid >> 6;
    float lb = 0.f;
    if (layer == 1) { const float x0 = lb_logits[(0 * 2 + dir) * 512 + h * 128 + c], x1 = lb_logits[(1 * 2 + dir) * 512 + h * 128 + c]; lb = 1.0f / (1.0f + expf(x0 - x1)); }
    float st[8];
#pragma unroll
    for (int j = 0; j < 8; ++j) st[j] = 0.f;
    float* outp = dir ? o_b : o_f;
    for (int step = 0; step < SEQ; ++step) {
        const int t = dir ? (SEQ - 1 - step) : step;
        const bf16_t* row = proj + ((long)b * SEQ + t) * INC;
        const float q = bf2f(row[h * 128 + c]);
        const float a = bf2f(row[512 + dir * 512 + h * 128 + c]);
        const float sg = 1.0f / (1.0f + expf(-a));
        const float f = lb + (1.0f - lb) * sg;
        const float k = (1.0f - lb) / (1.0f + expf(a));
        float part[8];
#pragma unroll
        for (int j = 0; j < 8; ++j) {
            const float v = bf2f(row[1536 + h * 128 + vsl * 16 + vs * 8 + j]);
            st[j] = f * st[j] + k * v;
            part[j] = wave_sum(st[j] * q);
        }
        if ((tid & 63) == 0) {
#pragma unroll
            for (int j = 0; j < 8; ++j) red[step & 1][wave][j] = part[j];
        }
        __syncthreads();
        if (tid < 16) {
            const int vv = tid >> 3, j = tid & 7;
            const float* r = &red[step & 1][0][0];
            const float s = r[(vv * 2 + 0) * 8 + j] + r[(vv * 2 + 1) * 8 + j];
            outp[((long)b * SEQ + t) * 512 + h * 128 + vsl * 16 + vv * 8 + j] = s;
        }
    }
}

__global__ void hgrn_finalize(const float* o_f, const float* o_b, const bf16_t* proj, const float* norm_g, float* y) {
    const long w = ((long)blockIdx.x * blockDim.x + threadIdx.x) >> 6; const int lane = threadIdx.x & 63;
    if (w >= (long)T_TOK * 4) return;
    const long tok = w >> 2; const int h = w & 3;
    const long base = tok * 512 + h * 128;
    float v0 = o_f[base + lane] + o_b[base + lane], v1 = o_f[base + 64 + lane] + o_b[base + 64 + lane];
    float ss = wave_sum(v0 * v0 + v1 * v1);
    const float r = rsqrtf(ss * (1.0f / 128.0f) + 1e-6f);
    const bf16_t* pr = proj + tok * INC + 2048 + h * 128;
    y[tok * DM + h * 128 + lane] = v0 * r * norm_g[h * 128 + lane] * bf2f(pr[lane]);
    y[tok * DM + h * 128 + 64 + lane] = v1 * r * norm_g[h * 128 + 64 + lane] * bf2f(pr[64 + lane]);
}

__global__ __launch_bounds__(256) void attn_naive(const bf16_t* proj, float* y) {
    const long w = ((long)blockIdx.x * blockDim.x + threadIdx.x) >> 6; const int lane = threadIdx.x & 63;
    if (w >= (long)T_TOK * 8) return;
    const long tok = w >> 3; const int head = w & 7;
    const int b = (int)(tok / SEQ), i = (int)(tok % SEQ);
    const float q = bf2f(proj[tok * INC + 2560 + head * 64 + lane]);
    float m = -1e30f, l = 0.f, o = 0.f;
    const int dil[3] = {1, 4, 16};
    for (int br = 0; br < 3; ++br) {
        const int d = dil[br];
        for (int n = -64; n <= 64; ++n) {
            const int kt = i + n * d;
            if (kt < 0 || kt >= SEQ) continue;
            const bf16_t* row = proj + ((long)b * SEQ + kt) * INC;
            const float kk = bf2f(row[3072 + head * 64 + lane]);
            const float vv = bf2f(row[3584 + head * 64 + lane]);
            const float s = wave_sum(q * kk);
            const float mn = fmaxf(m, s);
            const float sc = __expf(m - mn), pe = __expf(s - mn);
            l = l * sc + pe; o = o * sc + pe * vv; m = mn;
        }
    }
    y[tok * DM + 512 + head * 64 + lane] = o / l;
}

__global__ __launch_bounds__(256) void ln_kernel(float* z, const float* g, const float* bta) {
    const long w = ((long)blockIdx.x * blockDim.x + threadIdx.x) >> 6; const int lane = threadIdx.x & 63;
    if (w >= T_TOK) return;
    float* row = z + w * DM;
    float v[16]; float s = 0.f;
#pragma unroll
    for (int j = 0; j < 16; ++j) { v[j] = row[lane + 64 * j]; s += v[j]; }
    const float mu = wave_sum(s) * (1.0f / 1024.0f);
    float qq = 0.f;
#pragma unroll
    for (int j = 0; j < 16; ++j) { const float d = v[j] - mu; qq += d * d; }
    const float r = rsqrtf(wave_sum(qq) * (1.0f / 1024.0f) + 1e-5f);
#pragma unroll
    for (int j = 0; j < 16; ++j) { const int c = lane + 64 * j; row[c] = (v[j] - mu) * r * g[c] + bta[c]; }
}

__global__ __launch_bounds__(256) void router_kernel(const float* h, const float* w1, const float* b1, const float* w2, const float* b2,
                                                     int* expert  , float* gate  , int* rank  , int* counts  ) {
    const long w = ((long)blockIdx.x * blockDim.x + threadIdx.x) >> 6; const int lane = threadIdx.x & 63;
    if (w >= T_TOK) return;
    const float* row = h + w * DM;
    float v[16];
#pragma unroll
    for (int j = 0; j < 16; ++j) v[j] = row[lane + 64 * j];
    float l1[4];
#pragma unroll
    for (int o = 0; o < 4; ++o) { float s = 0.f;
#pragma unroll
        for (int j = 0; j < 16; ++j) s = fmaf(v[j], w1[(lane + 64 * j) * 4 + o], s);
        l1[o] = wave_sum(s) + b1[o]; }
    int grp = 0; float mx = l1[0];
#pragma unroll
    for (int o = 1; o < 4; ++o) if (l1[o] > mx) { mx = l1[o]; grp = o; }
    float den = 0.f;
#pragma unroll
    for (int o = 0; o < 4; ++o) den += expf(l1[o] - mx);
    const float pgrp = 1.0f / den;
    float l2[8];
#pragma unroll
    for (int o = 0; o < 8; ++o) { float s = 0.f; const int col = grp * 8 + o;
#pragma unroll
        for (int j = 0; j < 16; ++j) s = fmaf(v[j], w2[(lane + 64 * j) * 32 + col], s);
        l2[o] = wave_sum(s) + b2[col]; }
    int e0 = 0; float m0 = l2[0];
#pragma unroll
    for (int o = 1; o < 8; ++o) if (l2[o] > m0) { m0 = l2[o]; e0 = o; }
    int e1 = -1; float m1 = -3.0e38f;
#pragma unroll
    for (int o = 0; o < 8; ++o) if (o != e0 && l2[o] > m1) { m1 = l2[o]; e1 = o; }
    const float r = expf(m1 - m0);
    const float wa = 1.0f / (1.0f + r), wb = r / (1.0f + r);
    if (lane == 0) {
        const int ea = grp * 8 + e0, eb = grp * 8 + e1;
        expert[w * 2] = ea; expert[w * 2 + 1] = eb;
        gate[w * 2] = pgrp * wa; gate[w * 2 + 1] = pgrp * wb;
        rank[w * 2] = atomicAdd(&counts[ea], 1);
        rank[w * 2 + 1] = atomicAdd(&counts[eb], 1);
    }
}
__global__ void moe_scan(const int* counts, int* pstart, int* tile_exp, int ntiles) {
    if (threadIdx.x == 0 && blockIdx.x == 0) {
        int acc = 0;
        for (int e = 0; e < NEXP; ++e) { pstart[e] = acc; const int nt = (counts[e] + 255) >> 8; for (int t = 0; t < nt; ++t) tile_exp[(acc >> 8) + t] = e; acc += nt * 256; }
        for (int t = acc >> 8; t < ntiles; ++t) tile_exp[t] = -1;
    }
}
__global__ void moe_scatter(const int* expert, const int* rank, const int* pstart, int* slot_tok, int* dest) {
    const long i = (long)blockIdx.x * blockDim.x + threadIdx.x;
    if (i >= (long)T_TOK * 2) return;
    const int s = pstart[expert[i]] + rank[i];
    dest[i] = s; slot_tok[s] = (int)(i >> 1);
}
__global__ void fill_int(int* p, int v, long n) { const long i = (long)blockIdx.x * blockDim.x + threadIdx.x; if (i < n) p[i] = v; }

__global__ __launch_bounds__(256) void moe_combine_ln(float* h, const float* ys, const int* dest, const float* gate, const float* g, const float* bta) {
    const long w = ((long)blockIdx.x * blockDim.x + threadIdx.x) >> 6; const int lane = threadIdx.x & 63;
    if (w >= T_TOK) return;
    float* row = h + w * DM;
    const float* y0 = ys + (long)dest[w * 2] * DM; const float* y1 = ys + (long)dest[w * 2 + 1] * DM;
    const float g0 = gate[w * 2], g1 = gate[w * 2 + 1];
    float v[16]; float s = 0.f;
#pragma unroll
    for (int j = 0; j < 16; ++j) { const int c = lane + 64 * j; v[j] = ALPHA * row[c] + g0 * y0[c] + g1 * y1[c]; s += v[j]; }
    const float mu = wave_sum(s) * (1.0f / 1024.0f);
    float qq = 0.f;
#pragma unroll
    for (int j = 0; j < 16; ++j) { const float d = v[j] - mu; qq += d * d; }
    const float r = rsqrtf(wave_sum(qq) * (1.0f / 1024.0f) + 1e-5f);
#pragma unroll
    for (int j = 0; j < 16; ++j) { const int c = lane + 64 * j; row[c] = (v[j] - mu) * r * g[c] + bta[c]; }
}

extern "C" void kernel_launch(void* const* d_in, const int* in_sizes, int n_in, void* d_out, int out_size, void* d_ws, size_t ws_size, hipStream_t stream) {
    const float* x = (const float*)d_in[0];
    const float* w_in = (const float*)d_in[1];
    const float* lb_logits = (const float*)d_in[2];
    const float* norm_g = (const float*)d_in[3];
    const float* w_out = (const float*)d_in[4];
    const float* ln1_g = (const float*)d_in[5];
    const float* ln1_b = (const float*)d_in[6];
    const float* rw1 = (const float*)d_in[7];
    const float* rb1 = (const float*)d_in[8];
    const float* rw2 = (const float*)d_in[9];
    const float* rb2 = (const float*)d_in[10];
    const float* wg = (const float*)d_in[11];
    const float* wu = (const float*)d_in[12];
    const float* wd = (const float*)d_in[13];
    const float* ln2_g = (const float*)d_in[14];
    const float* ln2_b = (const float*)d_in[15];
    float* hbuf = (float*)d_out;
    char* ws = (char*)d_ws;
    size_t off = 0;
    auto take = [&](size_t bytes) { char* p = ws + off; off += (bytes + 255) & ~(size_t)255; return p; };
    int* counts = (int*)take(256);
    int* pstart = (int*)take(256);
    int* tile_exp = (int*)take(4096);
    int* expert = (int*)take((size_t)T_TOK * 2 * 4);
    int* rank = (int*)take((size_t)T_TOK * 2 * 4);
    float* gate = (float*)take((size_t)T_TOK * 2 * 4);
    int* dest = (int*)take((size_t)T_TOK * 2 * 4);
    int* slot_tok = (int*)take((size_t)PSLOTS * 4);
    char* big = take(0);
    bf16_t* proj = (bf16_t*)big;
    float* y = (float*)(big + (size_t)T_TOK * INC * 2);
    float* o_f = (float*)(big + (size_t)T_TOK * INC * 2 + (size_t)T_TOK * DM * 4);
    float* o_b = o_f + (size_t)T_TOK * 512;
    float* hid = (float*)big;
    float* ys = (float*)(big + (size_t)PSLOTS * DEXP * 4);
    const int ntiles = PSLOTS / 256;

    for (int l = 0; l < 2; ++l) {
        const float* hin = (l == 0) ? x : hbuf;
        { GemmP p{}; p.A = hin; p.lda = DM; p.rowidx = nullptr; p.zero_row = 0; p.W = w_in + (size_t)l * DM * INC; p.wstride = 0; p.tile_exp = nullptr; p.M = T_TOK; p.N = INC; p.K = DM; p.out = proj; p.ldo = INC; p.aux = nullptr; p.lb = nullptr;
          naive_gemm<0><<<dim3(INC / 64, T_TOK / 64), 256, 0, stream>>>(p); }
        rope_kernel<<<(T_TOK * 128 + 255) / 256, 256, 0, stream>>>(proj);
        hgrn_naive<<<dim3(NB * 4 * 2, 8), 256, 0, stream>>>(proj, lb_logits, l, o_f, o_b);
        hgrn_finalize<<<(T_TOK * 4 * 64 + 255) / 256, 256, 0, stream>>>(o_f, o_b, proj, norm_g + l * 512, y);
        attn_naive<<<(T_TOK * 8 * 64) / 256, 256, 0, stream>>>(proj, y);
        { GemmP p{}; p.A = y; p.lda = DM; p.rowidx = nullptr; p.zero_row = 0; p.W = w_out + (size_t)l * DM * DM; p.wstride = 0; p.tile_exp = nullptr; p.M = T_TOK; p.N = DM; p.K = DM; p.out = hbuf; p.ldo = DM; p.aux = hin; p.lb = nullptr;
          naive_gemm<1><<<dim3(DM / 64, T_TOK / 64), 256, 0, stream>>>(p); }
        ln_kernel<<<T_TOK * 64 / 256, 256, 0, stream>>>(hbuf, ln1_g + l * DM, ln1_b + l * DM);
        hipMemsetAsync(counts, 0, 256, stream);
        fill_int<<<(PSLOTS + 255) / 256, 256, 0, stream>>>(slot_tok, T_TOK, PSLOTS);
        router_kernel<<<T_TOK * 64 / 256, 256, 0, stream>>>(hbuf, rw1 + l * DM * 4, rb1 + l * 4, rw2 + l * DM * 32, rb2 + l * 32, expert, gate, rank, counts);
        moe_scan<<<1, 64, 0, stream>>>(counts, pstart, tile_exp, ntiles);
        moe_scatter<<<(T_TOK * 2 + 255) / 256, 256, 0, stream>>>(expert, rank, pstart, slot_tok, dest);
        { GemmP p{}; p.A = hbuf; p.lda = DM; p.rowidx = slot_tok; p.zero_row = T_TOK; p.W = wg + (size_t)l * NEXP * DM * DEXP; p.wstride = (long)DM * DEXP; p.tile_exp = tile_exp; p.M = PSLOTS; p.N = DEXP; p.K = DM; p.out = hid; p.ldo = DEXP; p.aux = nullptr; p.lb = nullptr;
          naive_gemm<2><<<dim3(DEXP / 64, PSLOTS / 64), 256, 0, stream>>>(p);
          p.W = wu + (size_t)l * NEXP * DM * DEXP;
          naive_gemm<3><<<dim3(DEXP / 64, PSLOTS / 64), 256, 0, stream>>>(p); }
        { GemmP p{}; p.A = hid; p.lda = DEXP; p.rowidx = nullptr; p.zero_row = 0; p.W = wd + (size_t)l * NEXP * DEXP * DM; p.wstride = (long)DEXP * DM; p.tile_exp = tile_exp; p.M = PSLOTS; p.N = DM; p.K = DEXP; p.out = ys; p.ldo = DM; p.aux = nullptr; p.lb = nullptr;
          naive_gemm<2><<<dim3(DM / 64, PSLOTS / 64), 256, 0, stream>>>(p); }
        moe_combine_ln<<<T_TOK * 64 / 256, 256, 0, stream>>>(hbuf, ys, dest, gate, ln2_g + l * DM, ln2_b + l * DM);
    }
}
```

```cpp
#include <hip/hip_runtime.h>
#include <hip/hip_cooperative_groups.h>
#include <stdint.h>
#include <stdio.h>
namespace cg = cooperative_groups;

#define T_TOK 32768
#define DM 1024
#define SEQ 2048
#define NB 16
#define INC 4096
#define NEXP 32
#define DEXP 512
#define PSLOTS ((T_TOK * 2 / 256 + NEXP) * 256)
#define NTILES (PSLOTS / 256)
#define ALPHA 1.41421356237309515f
#define ATT_VPRE 5
#define NTHREADS 512
#define NWAVES 8
#define LDS_BYTES (152 * 1024)
#define LDS_TAB_OFF (144 * 1024)

typedef unsigned short bf16_t;
__device__ __forceinline__ float bf2f(bf16_t b) { return __uint_as_float(((unsigned)b) << 16); }
__device__ __forceinline__ bf16_t f2bf(float f) { unsigned u = __float_as_uint(f); u += 0x7FFFu + ((u >> 16) & 1u); return (bf16_t)(u >> 16); }
template <int CTRL> __device__ __forceinline__ float dppf(float v) { return __int_as_float(__builtin_amdgcn_update_dpp(0, __float_as_int(v), CTRL, 0xf, 0xf, true)); }
__device__ __forceinline__ float wave_sum(float v) {
    v += dppf<0xB1>(v);
    v += dppf<0x4E>(v);
    v += dppf<0x141>(v);
    v += dppf<0x140>(v);
    const int vi = __float_as_int(v);
    return (__int_as_float(__builtin_amdgcn_readlane(vi, 0)) + __int_as_float(__builtin_amdgcn_readlane(vi, 16))) + (__int_as_float(__builtin_amdgcn_readlane(vi, 32)) + __int_as_float(__builtin_amdgcn_readlane(vi, 48)));
}
__device__ __forceinline__ int o_tid(int wv) { int l; asm volatile("v_mbcnt_lo_u32_b32 %0, -1, 0\n\tv_mbcnt_hi_u32_b32 %0, -1, %0" : "=v"(l)); return wv * 64 + l; }
__device__ __forceinline__ int o_bid() { int b = blockIdx.x; asm volatile("" : "+s"(b)); return b; }
template <int N> __device__ __forceinline__ void wave_sum_n(float (&s)[N]) {
#pragma unroll
    for (int i = 0; i < N; ++i) s[i] = wave_sum(s[i]);
}
__device__ __forceinline__ float siluf(float x) { return x * __builtin_amdgcn_rcpf(1.0f + __expf(-x)); }

struct Params {
    const float* x; const float* w_in; const float* lb_logits; const float* norm_g; const float* w_out; const float* ln1_g; const float* ln1_b;
    const float* rw1; const float* rb1; const float* rw2; const float* rb2; const float* wg; const float* wu; const float* wd; const float* ln2_g; const float* ln2_b;
    float* hbuf;
    int* counts;
    int* hist;
    unsigned* bar;
    float2* rope_tab;
    float* lbtab;
    int* expert; int* rank; float* gate; int* dest; int* slot_tok;
    bf16_t* proj; bf16_t* y; float* o_f; float* o_b; bf16_t* hid; bf16_t* ys;
    bf16_t* xb;
    bf16_t* mix;
    bf16_t* ob;
    int* hdone;
    int* mcnt;
    bf16_t* wt_in;
    bf16_t* wt_out;
    bf16_t* wt_gu;
    bf16_t* wt_dn;
};

#define LAS __attribute__((address_space(3)))
typedef short bf16x8 __attribute__((ext_vector_type(8)));
typedef float f32x4 __attribute__((ext_vector_type(4)));
typedef unsigned u32x4 __attribute__((ext_vector_type(4)));
typedef unsigned u32x2 __attribute__((ext_vector_type(2)));
namespace pg8 {
constexpr int BM = 256, BK = 64, HALF = 128, HTB = HALF * BK * 2, STAGE_BYTES = 8 * HTB, NXCD = 8, WGM = 8;
__device__ __forceinline__ int lds_byte(int r, int c) { const int st = (r >> 4) * 2 + (c >> 5), rr = r & 15, cc = c & 31, ob = rr * 64 + cc * 2; return st * 1024 + (ob ^ (((ob >> 9) & 1) << 5)); }
__device__ __forceinline__ void stage_rc(int b, int& R, int& C) { const int st = b / 1024, sb = b % 1024, swz = sb ^ (((sb >> 9) & 1) << 5); R = (st >> 1) * 16 + swz / 64; C = (st & 1) * 32 + (swz % 64) / 2; }
__device__ __forceinline__ int perm32(int rho) { const int n = rho >> 4, i = rho & 15; return 8 * (i >> 2) + 4 * n + (i & 3); }
__device__ __forceinline__ unsigned cvt_pk_bf16(float lo, float hi) { unsigned r; asm volatile("v_cvt_pk_bf16_f32 %0, %1, %2" : "=v"(r) : "v"(lo), "v"(hi)); return r; }

struct Unit { int pm, pn, e; };
struct Gemm { const bf16_t* A; const bf16_t* Bt; int K; long bstride; const int* rowidx; };

struct StaticOrder {
    int nM, nN, nwg, G, c;
    __device__ void init(int M, int N, int G_, int c_) { nM = M / BM; nN = N / BM; nwg = nM * nN; G = G_; c = c_; }
    __device__ bool next(int i, Unit& u) const {
        const long L = (long)i * G + c; if (L >= nwg) return false;
        int wgid = (int)L; { const int q = nwg / NXCD, r = nwg % NXCD, xcd = wgid % NXCD, off = wgid / NXCD; wgid = (xcd < r ? xcd * (q + 1) : r * (q + 1) + (xcd - r) * q) + off; }
        const int nig = WGM * nN, gid = wgid / nig, fm = gid * WGM, gsz = (nM - fm) < WGM ? (nM - fm) : WGM;
        u.pm = fm + ((wgid % nig) % gsz); u.pn = (wgid % nig) / gsz; u.e = 0; return true;
    }
    static constexpr bool WAITS = false;
    __device__ __forceinline__ void a_ready(const Unit&, int, int) const {}
    __device__ __forceinline__ void done(const Unit&, int) const {}
};
struct MoeOrder {
    static constexpr bool WAITS = false;
    int nN, nwg, G, c, u0; const int* tile_exp;
    __device__ void init(int nact, int nN_, int nloc, int rank, int before, int Gtot, const int* te) {
        const int t0 = (int)((long)nact * before / Gtot), t1 = (int)((long)nact * (before + nloc) / Gtot);
        nN = nN_; u0 = t0 * nN_; nwg = (t1 - t0) * nN_; G = nloc; c = rank; tile_exp = te; }
    __device__ bool next(int i, Unit& u) const {
        const long L = (long)i * G + c; if (L >= nwg) return false;
        const int wgid = u0 + (int)L;
        u.pm = wgid / nN; u.pn = wgid % nN; u.e = tile_exp[u.pm]; return true;
    }
    __device__ __forceinline__ void a_ready(const Unit&, int, int) const {}
    __device__ __forceinline__ void done(const Unit&, int) const {}
};
struct MoeOrderPub : MoeOrder {
    int* cnt;
    __device__ __forceinline__ void done(const Unit& u, int lane) const {
        asm volatile("s_waitcnt vmcnt(0)" ::: "memory");
        if (lane == 0) __hip_atomic_fetch_add(cnt + u.pm, 1, __ATOMIC_RELAXED, __HIP_MEMORY_SCOPE_AGENT);
    }
};
struct MoeOrderWait : MoeOrder {
    static constexpr bool WAITS = true;
    const int* cnt; LAS int* pollw;
    __device__ __forceinline__ void spin(const Unit& u) const {
        unsigned spins = 0;
        while (__builtin_amdgcn_readfirstlane(__hip_atomic_load(cnt + u.pm, __ATOMIC_RELAXED, __HIP_MEMORY_SCOPE_AGENT)) < 32) { __builtin_amdgcn_s_sleep(2); if (++spins > (1u << 22)) break; }
    }
    __device__ __forceinline__ void a_ready(const Unit& u, int wid, int lane) const {
        if (wid == 0) spin(u);
        asm volatile("" ::: "memory"); __builtin_amdgcn_s_barrier(); asm volatile("" ::: "memory");
    }
    __device__ __forceinline__ void poll_issue(const Unit& u, int wid, int lane) const {
        if (wid == 0 && lane == 0) __builtin_amdgcn_global_load_lds((const unsigned*)(cnt + u.pm), (LAS unsigned*)pollw, 4, 0, 16);
    }
    __device__ __forceinline__ void poll_check(const Unit& u, int wid, int lane) const {
        if (wid == 0) { const int v = __builtin_amdgcn_readfirstlane(*(volatile LAS int*)pollw); if (v < 32) spin(u); }
    }
};

struct EpiInProj {
    static constexpr bool PERM = true;
    bf16_t* O; const float2* rope; const float* lbl; const float* ngl;
    __device__ __forceinline__ void operator()(const f32x4 (&acc)[2][2][4][2], const Unit& u, int wr, int wc, int fr, int fq) const {
        const int region = u.pn >> 1;
        const int row0 = u.pm * BM + wr * 64 + fr, col0 = u.pn * BM + wc * 32 + 8 * fq;
        const bool do_rope = (region == 5 || region == 6) && ((wc & 1) == 0);
        const float scale = (region == 0) ? 0.08838834764831845f : ((region == 5) ? 0.125f * 1.4426950408889634f : 1.0f);
#pragma unroll
        for (int ai = 0; ai < 2; ++ai)
#pragma unroll
            for (int m = 0; m < 4; ++m) {
                const int row = row0 + ai * HALF + m * 16;
                bf16_t* rowp = O + (size_t)row * INC + col0;
                f32x4 cs0 = {1.f, 0.f, 1.f, 0.f}, cs1 = cs0, cs2 = cs0, cs3 = cs0;
                if (do_rope) { const f32x4* t = (const f32x4*)(rope + (size_t)(row & (SEQ - 1)) * 8); cs0 = t[0]; cs1 = t[1]; cs2 = t[2]; cs3 = t[3]; }
#pragma unroll
                for (int bj = 0; bj < 2; ++bj) {
                    f32x4 v0 = acc[ai][bj][m][0] * scale, v1 = acc[ai][bj][m][1] * scale;
                    if (region == 4) {
                        const float* np_ = ngl + ((col0 + bj * HALF) & 511);
                        const f32x4 n0 = *(const f32x4*)np_, n1 = *(const f32x4*)(np_ + 4);
#pragma unroll
                        for (int j = 0; j < 4; ++j) { v0[j] = siluf(v0[j]) * n0[j]; v1[j] = siluf(v1[j]) * n1[j]; }
                    }
                    if (region == 1 || region == 2) {
                        const float* lp = lbl + (region - 1) * 512 + ((col0 + bj * HALF) & 511);
                        const f32x4 l0 = *(const f32x4*)lp, l1 = *(const f32x4*)(lp + 4);
#pragma unroll
                        for (int j = 0; j < 4; ++j) {
                            const float a0 = fminf(fmaxf(v0[j], -30.f), 30.f), a1 = fminf(fmaxf(v1[j], -30.f), 30.f);
                            v0[j] = l0[j] + (1.0f - l0[j]) * __builtin_amdgcn_rcpf(1.0f + __expf(-a0));
                            v1[j] = l1[j] + (1.0f - l1[j]) * __builtin_amdgcn_rcpf(1.0f + __expf(-a1)); }
                    }
                    if (do_rope) {
                        const float sgn = (fq == 0) ? -1.f : 1.f;
                        f32x4 o0, o1;
#pragma unroll
                        for (int j = 0; j < 4; ++j) { o0[j] = __shfl_xor(v0[j], 16); o1[j] = __shfl_xor(v1[j], 16); }
                        const float c[8] = {cs0[0], cs0[2], cs1[0], cs1[2], cs2[0], cs2[2], cs3[0], cs3[2]};
                        const float s[8] = {cs0[1], cs0[3], cs1[1], cs1[3], cs2[1], cs2[3], cs3[1], cs3[3]};
                        if (fq < 2) {
#pragma unroll
                            for (int j = 0; j < 4; ++j) { v0[j] = v0[j] * c[j] + sgn * o0[j] * s[j]; v1[j] = v1[j] * c[4 + j] + sgn * o1[j] * s[4 + j]; }
                        }
                    }
                    u32x4 w; w.x = cvt_pk_bf16(v0[0], v0[1]); w.y = cvt_pk_bf16(v0[2], v0[3]); w.z = cvt_pk_bf16(v1[0], v1[1]); w.w = cvt_pk_bf16(v1[2], v1[3]);
                    *(u32x4*)(rowp + bj * HALF) = w;
                }
            }
    }
};
struct EpiOutProj {
    static constexpr bool PERM = false;
    const float* H; float* Z;
    __device__ __forceinline__ void operator()(const f32x4 (&acc)[2][2][4][2], const Unit& u, int wr, int wc, int fr, int fq) const {
        const int row0 = u.pm * BM + wr * 64 + fr, col0 = u.pn * BM + wc * 32 + 4 * fq;
#pragma unroll
        for (int ai = 0; ai < 2; ++ai)
#pragma unroll
            for (int m = 0; m < 4; ++m) { const size_t off = (size_t)(row0 + ai * HALF + m * 16) * DM + col0;
#pragma unroll
                for (int bj = 0; bj < 2; ++bj)
#pragma unroll
                    for (int n = 0; n < 2; ++n) { const f32x4 hv = *(const f32x4*)(H + off + bj * HALF + n * 16); *(f32x4*)(Z + off + bj * HALF + n * 16) = hv * ALPHA + acc[ai][bj][m][n]; } }
    }
};
struct EpiGateUp {
    static constexpr bool PERM = true;
    bf16_t* O;
    __device__ __forceinline__ void operator()(const f32x4 (&acc)[2][2][4][2], const Unit& u, int wr, int wc, int fr, int fq) const {
        const int row0 = u.pm * BM + wr * 64 + fr, col0 = u.pn * 128 + wc * 16 + 4 * fq;
#pragma unroll
        for (int ai = 0; ai < 2; ++ai)
#pragma unroll
            for (int m = 0; m < 4; ++m) { bf16_t* rowp = O + (size_t)(row0 + ai * HALF + m * 16) * DEXP + col0;
#pragma unroll
                for (int bj = 0; bj < 2; ++bj) { const f32x4 v0 = acc[ai][bj][m][0], v1 = acc[ai][bj][m][1];
                    u32x2 w; w.x = cvt_pk_bf16(siluf(v0[0]) * v0[1], siluf(v0[2]) * v0[3]); w.y = cvt_pk_bf16(siluf(v1[0]) * v1[1], siluf(v1[2]) * v1[3]);
                    *(u32x2*)(rowp + bj * 64) = w; } }
    }
};
struct EpiBf16Plain {
    static constexpr bool PERM = true;
    bf16_t* O; int ldc;
    __device__ __forceinline__ void operator()(const f32x4 (&acc)[2][2][4][2], const Unit& u, int wr, int wc, int fr, int fq) const {
        const int row0 = u.pm * BM + wr * 64 + fr, col0 = u.pn * BM + wc * 32 + 8 * fq;
#pragma unroll
        for (int ai = 0; ai < 2; ++ai)
#pragma unroll
            for (int m = 0; m < 4; ++m) { bf16_t* rowp = O + (size_t)(row0 + ai * HALF + m * 16) * ldc + col0;
#pragma unroll
                for (int bj = 0; bj < 2; ++bj) { const f32x4 v0 = acc[ai][bj][m][0], v1 = acc[ai][bj][m][1];
                    u32x4 w; w.x = cvt_pk_bf16(v0[0], v0[1]); w.y = cvt_pk_bf16(v0[2], v0[3]); w.z = cvt_pk_bf16(v1[0], v1[1]); w.w = cvt_pk_bf16(v1[2], v1[3]);
                    *(u32x4*)(rowp + bj * HALF) = w; } }
    }
};

template <class Epi, class Sched, bool GATHER>
__device__ __forceinline__ void gemm_phase(int WV, LAS unsigned char* lds, const Gemm g, const Sched& S, const Epi& E, const LAS int* tokl, int krot = 0) {
    const int tid = o_tid(WV), wid = __builtin_amdgcn_readfirstlane(tid >> 6), lane = tid & 63, wr = wid >> 2, wc = wid & 3, fr = lane & 15, fq = lane >> 4;
    const int K = g.K, nt = K / BK;
    int RA[2]; unsigned voffA[2], voffB[2];
#pragma unroll
    for (int i = 0; i < 2; ++i) { int R, C; stage_rc(tid * 16 + i * 8192, R, C); const int Rb = Epi::PERM ? ((R & ~31) + perm32(R & 31)) : R;
        RA[i] = R; voffA[i] = GATHER ? (unsigned)C * 2u : (unsigned)(R * K + C) * 2u; voffB[i] = (unsigned)(Rb * K + C) * 2u; }
    const size_t kstep = (size_t)(BK * 2);
    const size_t hstep = (size_t)HALF * K * 2;
    const size_t tstep = 2 * hstep;
    const unsigned ldsw = (unsigned)wid * 1024u;
    const int aoff = lds_byte(wr * 64 + fr, fq * 8), boff = lds_byte(wc * 32 + fr, fq * 8);
#define PG8_SA(b, h) (((b) * 2 + (h)) * HTB)
#define PG8_SB(b, h) ((4 + (b) * 2 + (h)) * HTB)
#define PG8_STAGE(bufoff, gbase, voff) do { _Pragma("unroll") for (int _i = 0; _i < 2; ++_i) \
        __builtin_amdgcn_global_load_lds((const unsigned*)((const char*)(gbase) + (voff)[_i]), (LAS unsigned*)(lds + (bufoff) + ldsw + _i * 8192), 16, 0, 0); } while (0)
#define PG8_STAGE_A(bufoff, kp, h) do { if constexpr (GATHER) { PG8_STAGE(bufoff, kp, gA[h]); } else { PG8_STAGE(bufoff, (kp) + (h) * hstep, voffA); } } while (0)
#define PG8_GATHER_OFFS(ui_) do { if constexpr (GATHER) { _Pragma("unroll") for (int _h = 0; _h < 2; ++_h) _Pragma("unroll") for (int _i = 0; _i < 2; ++_i) { \
        int _row = tokl[(ui_) * BM + _h * HALF + RA[_i]]; _row = (_row >= T_TOK) ? 0 : _row; gA[_h][_i] = (unsigned)(_row * K) * 2u + voffA[_i]; } } } while (0)
#define PG8_LDA(dst, b, h) do { _Pragma("unroll") for (int m = 0; m < 4; ++m) _Pragma("unroll") for (int k = 0; k < 2; ++k) dst[m][k] = *(const LAS bf16x8*)(lds + PG8_SA(b, h) + aoff + m * 2048 + k * 1024); } while (0)
#define PG8_LDB(dst, b, h) do { _Pragma("unroll") for (int n = 0; n < 2; ++n) _Pragma("unroll") for (int k = 0; k < 2; ++k) dst[n][k] = *(const LAS bf16x8*)(lds + PG8_SB(b, h) + boff + n * 2048 + k * 1024); } while (0)
#define PG8_MMA(ai, bj, At, Bt) do { __builtin_amdgcn_s_setprio(1); _Pragma("unroll") for (int m = 0; m < 4; ++m) _Pragma("unroll") for (int n = 0; n < 2; ++n) _Pragma("unroll") for (int k = 0; k < 2; ++k) \
        acc[ai][bj][m][n] = __builtin_amdgcn_mfma_f32_16x16x32_bf16(Bt[n][k], At[m][k], acc[ai][bj][m][n], 0, 0, 0); __builtin_amdgcn_s_setprio(0); } while (0)
#define PG8_WAIT_V(n) asm volatile("s_waitcnt vmcnt(" #n ")" ::: "memory")
#define PG8_WAIT_L(n) asm volatile("s_waitcnt lgkmcnt(" #n ")" ::: "memory")
#define PG8_BAR __builtin_amdgcn_s_barrier()
#define PG8_SCHED __builtin_amdgcn_sched_barrier(0)
#define PG8_ZERO_ACC() do { float _z; asm volatile("v_mov_b32 %0, 0" : "=v"(_z)); _Pragma("unroll") for (int a = 0; a < 2; ++a) _Pragma("unroll") for (int b = 0; b < 2; ++b) _Pragma("unroll") for (int m = 0; m < 4; ++m) \
        _Pragma("unroll") for (int n = 0; n < 2; ++n) acc[a][b][m][n] = (f32x4){_z, _z, _z, _z}; } while (0)
    Unit cur, nxt; int ui = 0;
    if (!S.next(0, cur)) return;
    f32x4 acc[2][2][4][2];
    PG8_ZERO_ACC();
    bf16x8 At[4][2], B0[2][2], B1[2][2];
    unsigned gA[2][2];
    PG8_GATHER_OFFS(0);
    S.a_ready(cur, wid, lane);
    const char* cA = GATHER ? (const char*)g.A : (const char*)g.A + (size_t)cur.pm * tstep;
    const char* cB = (const char*)g.Bt + ((size_t)cur.e * g.bstride) * 2 + (size_t)cur.pn * tstep;
    const size_t rot0 = (size_t)krot * kstep;
    PG8_STAGE(PG8_SB(0, 0), cB + rot0, voffB); PG8_STAGE_A(PG8_SA(0, 0), cA + rot0, 0); PG8_STAGE(PG8_SB(0, 1), cB + rot0 + hstep, voffB); PG8_STAGE_A(PG8_SA(0, 1), cA + rot0, 1);
    if (wr == 1) PG8_BAR;
    PG8_WAIT_V(4); PG8_BAR;
    PG8_STAGE(PG8_SB(1, 0), cB + rot0 + kstep, voffB); PG8_STAGE_A(PG8_SA(1, 0), cA + rot0 + kstep, 0); PG8_STAGE(PG8_SB(1, 1), cB + rot0 + hstep + kstep, voffB);
    PG8_WAIT_V(6); PG8_BAR;
    for (;;) {
        const bool has_next = S.next(ui + 1, nxt);
        const char* nA = (GATHER || !has_next) ? cA : (const char*)g.A + (size_t)nxt.pm * tstep;
        const char* nB = has_next ? (const char*)g.Bt + ((size_t)nxt.e * g.bstride) * 2 + (size_t)nxt.pn * tstep : cB;
        for (int t = 0; t < nt; t += 2) {
            const bool last = (t == nt - 2);
            const char* a1 = cA + (size_t)((t + krot) & (nt - 1)) * kstep + kstep;
            const size_t o2 = (size_t)((t + 2 + krot) & (nt - 1)) * kstep;
            const char* a2 = (last ? nA : cA) + o2; const char* b2 = (last ? nB : cB) + o2;
            const char* a3 = a2 + kstep; const char* b3 = b2 + kstep;
            if constexpr (Sched::WAITS) { if (has_next) { if (t == nt - 4) S.poll_issue(nxt, wid, lane); if (last) S.poll_check(nxt, wid, lane); } }
            PG8_LDB(B0, 0, 0); PG8_SCHED; PG8_LDA(At, 0, 0); PG8_STAGE_A(PG8_SA(1, 1), a1, 1);
            PG8_WAIT_L(8); PG8_BAR; PG8_WAIT_L(0); PG8_MMA(0, 0, At, B0); PG8_BAR; PG8_SCHED;
            if (last && has_next) { PG8_GATHER_OFFS(ui + 1); }
            PG8_LDB(B1, 0, 1); PG8_STAGE(PG8_SB(0, 0), b2, voffB);
            PG8_BAR; PG8_WAIT_L(0); PG8_MMA(0, 1, At, B1); PG8_BAR;
            PG8_LDA(At, 0, 1); PG8_STAGE_A(PG8_SA(0, 0), a2, 0);
            PG8_BAR; PG8_WAIT_L(0); PG8_MMA(1, 0, At, B0); PG8_BAR; PG8_SCHED;
            PG8_STAGE(PG8_SB(0, 1), b2 + hstep, voffB);
            PG8_WAIT_V(6); PG8_BAR; PG8_MMA(1, 1, At, B1); PG8_BAR;
            PG8_LDB(B0, 1, 0); PG8_SCHED; PG8_LDA(At, 1, 0); PG8_STAGE_A(PG8_SA(0, 1), a2, 1);
            PG8_WAIT_L(8); PG8_BAR; PG8_WAIT_L(0); PG8_MMA(0, 0, At, B0); PG8_BAR; PG8_SCHED;
            PG8_LDB(B1, 1, 1); PG8_STAGE(PG8_SB(1, 0), b3, voffB);
            PG8_BAR; PG8_WAIT_L(0); PG8_MMA(0, 1, At, B1); PG8_BAR;
            PG8_LDA(At, 1, 1); PG8_STAGE_A(PG8_SA(1, 0), a3, 0);
            PG8_BAR; PG8_WAIT_L(0); PG8_MMA(1, 0, At, B0); PG8_BAR; PG8_SCHED;
            PG8_STAGE(PG8_SB(1, 1), b3 + hstep, voffB);
            PG8_WAIT_V(6); PG8_BAR; PG8_MMA(1, 1, At, B1); PG8_BAR;
        }
        E(acc, cur, wr, wc, fr, fq);
        S.done(cur, lane);
        if (!has_next) break;
        PG8_ZERO_ACC();
        cur = nxt; cA = nA; cB = nB; ++ui;
    }
    PG8_WAIT_V(0);
    if (wr == 0) PG8_BAR;
    PG8_BAR;
#undef PG8_SA
#undef PG8_SB
#undef PG8_STAGE
#undef PG8_STAGE_A
#undef PG8_GATHER_OFFS
#undef PG8_LDA
#undef PG8_LDB
#undef PG8_MMA
#undef PG8_WAIT_V
#undef PG8_WAIT_L
#undef PG8_BAR
#undef PG8_SCHED
#undef PG8_ZERO_ACC
}
}

__device__ __forceinline__ unsigned pk2(float lo, float hi) { return (unsigned)f2bf(lo) | ((unsigned)f2bf(hi) << 16); }
struct TrItem { const float* W; bf16_t* WT; int K, N, row_off, rmul, item; };
__device__ __forceinline__ void transpose_load(const TrItem& t, int lane, f32x4 (&v)[8]) {
    const int nblk = t.N / 32, kb = t.item / nblk, nb = t.item % nblk, k0 = 64 * kb, n0 = 32 * nb;
#pragma unroll
    for (int i = 0; i < 8; ++i) v[i] = *(const f32x4*)(t.W + (size_t)(k0 + (lane >> 3) + 8 * i) * t.N + n0 + 4 * (lane & 7));
}
__device__ __forceinline__ void transpose_emit(const TrItem& t, int lane, const f32x4 (&v)[8], LAS float* scr) {
    const int nblk = t.N / 32, kb = t.item / nblk, nb = t.item % nblk, k0 = 64 * kb, n0 = 32 * nb;
#pragma unroll
    for (int i = 0; i < 8; ++i) { const int kk = (lane >> 3) + 8 * i; LAS float* d = scr + kk * 33 + 4 * (lane & 7); d[0] = v[i][0]; d[1] = v[i][1]; d[2] = v[i][2]; d[3] = v[i][3]; }
    asm volatile("s_waitcnt lgkmcnt(0)" ::: "memory");
    const int c = lane & 7;
#pragma unroll
    for (int j = 0; j < 4; ++j) { const int n = (lane >> 3) + 8 * j; const LAS float* s = scr + (8 * c) * 33 + n;
        u32x4 o; o.x = pg8::cvt_pk_bf16(s[0 * 33], s[1 * 33]); o.y = pg8::cvt_pk_bf16(s[2 * 33], s[3 * 33]); o.z = pg8::cvt_pk_bf16(s[4 * 33], s[5 * 33]); o.w = pg8::cvt_pk_bf16(s[6 * 33], s[7 * 33]);
        *(u32x4*)(t.WT + (size_t)(t.row_off + t.rmul * (n0 + n)) * t.K + k0 + 8 * c) = o; }
    asm volatile("s_waitcnt lgkmcnt(0)" ::: "memory");
}
__device__ __forceinline__ void transpose_item(const float* W, int K, int N, bf16_t* WT, int row_off, int rmul, LAS float* scr, int item, int lane) {
    TrItem t{W, WT, K, N, row_off, rmul, item}; f32x4 v[8]; transpose_load(t, lane, v); transpose_emit(t, lane, v, scr);
}
__device__ void convert_dense_phase(int WV, const Params& p, LAS unsigned char* lds) {
    const int TID = o_tid(WV), BID = o_bid();
    const int lane = TID & 63, wave = TID >> 6, gw = BID * NWAVES + wave, ngw = gridDim.x * NWAVES;
    LAS float* scr = (LAS float*)(lds + wave * 16384);
    constexpr int I_IN = (DM / 64) * (INC / 32), I_OUT = (DM / 64) * (DM / 32);
    for (int it = gw; it < 2 * (I_IN + I_OUT); it += ngw) {
        int r = it; const int l = r / (I_IN + I_OUT); r -= l * (I_IN + I_OUT);
        if (r < I_IN) transpose_item(p.w_in + (size_t)l * DM * INC, DM, INC, p.wt_in + (size_t)l * INC * DM, 0, 1, scr, r, lane);
        else transpose_item(p.w_out + (size_t)l * DM * DM, DM, DM, p.wt_out + (size_t)l * DM * DM, 0, 1, scr, r - I_IN, lane);
    }
    const f32x4* xs = (const f32x4*)p.x; u32x2* xd = (u32x2*)p.xb;
    for (long i = (long)BID * NTHREADS + TID; i < (long)T_TOK * DM / 4; i += (long)gridDim.x * NTHREADS) { const f32x4 v = xs[i]; u32x2 o; o.x = pk2(v[0], v[1]); o.y = pk2(v[2], v[3]); xd[i] = o; }
}
#define CONV_CHUNKS (NEXP * 768 / 32)
__device__ __forceinline__ void convert_expert_chunk(int WV, const Params& p, int l, int chunk, LAS unsigned char* lds, int lane) {
    LAS float* scr = (LAS float*)(lds + WV * 12288);
    constexpr int I_G = (DM / 64) * (DEXP / 32), I_D = (DEXP / 64) * (DM / 32);
    constexpr int PER_E = 2 * I_G + I_D;
    const int it0 = chunk * 32 + WV * 4;
    const int e = it0 / PER_E; const int r0 = it0 - e * PER_E;
    const size_t eo = ((size_t)l * NEXP + e) * DM * DEXP;
    TrItem t;
    if (r0 < I_G) t = TrItem{p.wg + eo, p.wt_gu + (size_t)e * DM * DM, DM, DEXP, 0, 2, r0};
    else if (r0 < 2 * I_G) t = TrItem{p.wu + eo, p.wt_gu + (size_t)e * DM * DM, DM, DEXP, 1, 2, r0 - I_G};
    else t = TrItem{p.wd + eo, p.wt_dn + (size_t)e * DM * DEXP, DEXP, DM, 0, 1, r0 - 2 * I_G};
    f32x4 va[8], vb[8];
    TrItem ta = t, tb = t; tb.item = t.item + 1;
    transpose_load(ta, lane, va); transpose_load(tb, lane, vb);
    transpose_emit(ta, lane, va, scr);
    ta.item = t.item + 2; transpose_load(ta, lane, va);
    transpose_emit(tb, lane, vb, scr);
    tb.item = t.item + 3; transpose_load(tb, lane, vb);
    ta.item = t.item + 2; transpose_emit(ta, lane, va, scr);
    transpose_emit(tb, lane, vb, scr);
}
__device__ void convert_expert_phase(int WV, const Params& p, int l, LAS unsigned char* lds) {
    const int TID = o_tid(WV), BID = o_bid();
    const int lane = TID & 63, wave = TID >> 6, gw = BID * NWAVES + wave, ngw = gridDim.x * NWAVES;
    LAS float* scr = (LAS float*)(lds + wave * 16384);
    constexpr int I_G = (DM / 64) * (DEXP / 32), I_D = (DEXP / 64) * (DM / 32);
    constexpr int PER_E = 2 * I_G + I_D;
    for (int it = gw; it < NEXP * PER_E; it += ngw) {
        const int e = it / PER_E; int r = it - e * PER_E;
        const size_t eo = ((size_t)l * NEXP + e) * DM * DEXP;
        if (r < I_G) transpose_item(p.wg + eo, DM, DEXP, p.wt_gu + (size_t)e * DM * DM, 0, 2, scr, r, lane);
        else if (r < 2 * I_G) transpose_item(p.wu + eo, DM, DEXP, p.wt_gu + (size_t)e * DM * DM, 1, 2, scr, r - I_G, lane);
        else transpose_item(p.wd + eo, DEXP, DM, p.wt_dn + (size_t)e * DM * DEXP, 0, 1, scr, r - 2 * I_G, lane);
    }
}

__device__ __forceinline__ void sincos_poly(double ang, float& c, float& s) {
    const double TWO_PI = 6.283185307179586476925, INV_2PI = 0.15915494309189533577;
    const double k = __builtin_rint(ang * INV_2PI); const double r = ang - k * TWO_PI; const double r2 = r * r;
    double sn = 1.0 / 51090942171709440000.0;
    sn = sn * r2 * -1.0 + 1.0 / 121645100408832000.0;
    sn = sn * -r2 + 1.0 / 355687428096000.0;
    sn = sn * -r2 + 1.0 / 1307674368000.0;
    sn = sn * -r2 + 1.0 / 6227020800.0;
    sn = sn * -r2 + 1.0 / 39916800.0;
    sn = sn * -r2 + 1.0 / 362880.0;
    sn = sn * -r2 + 1.0 / 5040.0;
    sn = sn * -r2 + 1.0 / 120.0;
    sn = sn * -r2 + 1.0 / 6.0;
    sn = sn * -r2 + 1.0;
    sn = sn * r;
    double cs = 1.0 / 2432902008176640000.0;
    cs = cs * -r2 + 1.0 / 6402373705728000.0;
    cs = cs * -r2 + 1.0 / 20922789888000.0;
    cs = cs * -r2 + 1.0 / 87178291200.0;
    cs = cs * -r2 + 1.0 / 479001600.0;
    cs = cs * -r2 + 1.0 / 3628800.0;
    cs = cs * -r2 + 1.0 / 40320.0;
    cs = cs * -r2 + 1.0 / 720.0;
    cs = cs * -r2 + 1.0 / 24.0;
    cs = cs * -r2 + 0.5;
    cs = cs * -r2 + 1.0;
    c = (float)cs; s = (float)sn;
}
__device__ void rope_table_phase(int WV, float2* tab, float* lbtab, const float* lb_logits) {
    const int TID = o_tid(WV), BID = o_bid();
    if (BID == 0) { for (int i = TID; i < 1024; i += NTHREADS) { lbtab[i] = 0.f; lbtab[1024 + i] = 1.0f / (1.0f + __expf(lb_logits[i] - lb_logits[1024 + i])); } }
    const double invf[8] = {1.0, 0.19392274474868576, 0.03760603093086393, 0.007292664737217109, 0.001414213562373095, 0.0002742481756762073, 5.318295896944988e-05, 1.031338537721246e-05};
    for (int idx = BID * NTHREADS + TID; idx < SEQ * 8; idx += gridDim.x * NTHREADS) {
        const int j = idx & 7, pos = idx >> 3;
        double f = invf[0];
#pragma unroll
        for (int q = 1; q < 8; ++q) f = (j == q) ? invf[q] : f;
        float c, s; sincos_poly((double)pos * f, c, s);
        tab[idx] = make_float2(c, s);
    }
}
typedef short s16x4 __attribute__((ext_vector_type(4)));
#define ATT_ST_STRIDE 68
#define ATT_ST_BYTES (256 * ATT_ST_STRIDE * 4)
#define ATT_VROW 160
#define ATT_VB_BYTES (32 * ATT_VROW)
__device__ void attn_phase(int WV, const Params& p, int layer, const bf16_t* proj, bf16_t* y, LAS unsigned char* lds, int* ctr) {
    const int tid = o_tid(WV), lane = tid & 63, g = lane >> 4, ql = lane & 15, BID = o_bid();
    LAS float* st = (LAS float*)lds;
    LAS unsigned char* vbp = lds + ATT_ST_BYTES + WV * ATT_VB_BYTES;
    const int vrd = (int)(uintptr_t)vbp + (4 * g + ((lane >> 2) & 3)) * ATT_VROW + (lane & 3) * 8;
    const float L2E = 1.4426950408889634f;
    LAS int* qslot = (LAS int*)(lds + 120 * 1024);
#pragma unroll 1
    for (;;) {
        if (tid == 0) *qslot = atomicAdd(ctr, 1);
        __syncthreads();
        const int item = __builtin_amdgcn_readfirstlane(*qslot);
        if (item >= NB * 8 * 8 + CONV_CHUNKS) break;
        if (item >= NB * 8 * 8) {
            convert_expert_chunk(WV, p, layer, item - NB * 8 * 8, lds, lane);
            __syncthreads();
            continue;
        }
        const int blk = item & 7, head = (item >> 3) & 7, b = item >> 6;
        const int i0 = blk * 256;
        const bf16_t* base = proj + (size_t)b * SEQ * INC; const char* baseb = (const char*)base;
        const int qcol = 2560 + head * 64, kcol = 3072 + head * 64, vcol = 3584 + head * 64;
#define ATT_GEOM(n_, d_, L_, p0_, r_) do { const int br_ = (n_) >> 1, w_ = WV + 8 * ((n_) & 1); d_ = (br_ == 0) ? 1 : ((br_ == 1) ? 4 : 16); L_ = SEQ / d_; \
            if (br_ == 0) { p0_ = i0 + 16 * w_; r_ = 0; } else if (br_ == 1) { r_ = w_ & 3; p0_ = (i0 >> 2) + 16 * (w_ >> 2); } else { r_ = w_; p0_ = i0 >> 4; } } while (0)
#define ATT_LOAD_KQ(d_, L_, p0_, r_) do { const int tq_ = d_ * (p0_ + ql) + r_; \
            { const unsigned qo_ = (unsigned)(tq_ * INC + qcol + 8 * g) * 2u; _Pragma("unroll") for (int ks = 0; ks < 2; ++ks) qf[ks] = *(const bf16x8*)(baseb + qo_ + 64 * ks); } \
            _Pragma("unroll") for (int kt = 0; kt < 9; ++kt) { int pk = p0_ - 64 + 16 * kt + ql; pk = pk < 0 ? 0 : (pk > L_ - 1 ? L_ - 1 : pk); \
                const unsigned ko_ = (unsigned)((d_ * pk + r_) * INC + kcol + 8 * g) * 2u; kf[kt][0] = *(const bf16x8*)(baseb + ko_); kf[kt][1] = *(const bf16x8*)(baseb + ko_ + 64); } } while (0)
#define ATT_LOAD_V(d_, L_, p0_, r_, K0_, K1_) do { _Pragma("unroll") for (int k2 = K0_; k2 < K1_; ++k2) _Pragma("unroll") for (int j = 0; j < 4; ++j) { const int rr = (lane >> 3) + 8 * j; \
            int pk = p0_ - 64 + 32 * k2 + rr; pk = pk < 0 ? 0 : (pk > L_ - 1 ? L_ - 1 : pk); vv[k2][j] = *(const u32x4*)(baseb + (unsigned)((d_ * pk + r_) * INC + vcol + 8 * (lane & 7)) * 2u); } } while (0)
        bf16x8 qf[2], kf[9][2]; u32x4 vv[5][4];
        { int d, L, p0, r; ATT_GEOM(0, d, L, p0, r); ATT_LOAD_KQ(d, L, p0, r); ATT_LOAD_V(d, L, p0, r, 0, ATT_VPRE); }
#pragma unroll 1
        for (int n = 0; n < 6; ++n) {
            const int lane = o_tid(WV) & 63, g = lane >> 4, ql = lane & 15;
            const int vrd = (int)(uintptr_t)vbp + (4 * g + ((lane >> 2) & 3)) * ATT_VROW + (lane & 3) * 8;
            const int br = n >> 1;
            int d, L, p0, r; ATT_GEOM(n, d, L, p0, r);
            const int tq = d * (p0 + ql) + r;
            f32x4 s[9];
#pragma unroll
            for (int kt = 0; kt < 9; ++kt) {
                f32x4 z = {0.f, 0.f, 0.f, 0.f};
                z = __builtin_amdgcn_mfma_f32_16x16x32_bf16(kf[kt][0], qf[0], z, 0, 0, 0);
                s[kt] = __builtin_amdgcn_mfma_f32_16x16x32_bf16(kf[kt][1], qf[1], z, 0, 0, 0);
            }
            __builtin_amdgcn_sched_barrier(0);
            ATT_LOAD_V(d, L, p0, r, ATT_VPRE, 5);
            if (n < 5) { int d2, L2, p02, r2; ATT_GEOM(n + 1, d2, L2, p02, r2); ATT_LOAD_KQ(d2, L2, p02, r2); }
            __builtin_amdgcn_sched_barrier(0);
            const int klo = max(ql, 64 - p0), khi = min(ql + 128, L + 63 - p0);
            float m = -3.0e38f;
#pragma unroll
            for (int kt = 0; kt < 9; ++kt)
#pragma unroll
                for (int j = 0; j < 4; ++j) { const int kk = 16 * kt + 4 * g + j; const bool ok = (kk >= klo) && (kk <= khi); s[kt][j] = ok ? s[kt][j] : -INFINITY; m = fmaxf(m, s[kt][j]); }
            m = fmaxf(m, __shfl_xor(m, 16)); m = fmaxf(m, __shfl_xor(m, 32));
            float lsum = 0.f;
#pragma unroll
            for (int kt = 0; kt < 9; ++kt)
#pragma unroll
                for (int j = 0; j < 4; ++j) { const float pe = __builtin_amdgcn_exp2f(s[kt][j] - m); s[kt][j] = pe; lsum += pe; }
            lsum += __shfl_xor(lsum, 16); lsum += __shfl_xor(lsum, 32);
            f32x4 o[4];
#pragma unroll
            for (int c = 0; c < 4; ++c) o[c] = (f32x4){0.f, 0.f, 0.f, 0.f};
#pragma unroll
            for (int k2 = 0; k2 < 5; ++k2) {
#pragma unroll
                for (int j = 0; j < 4; ++j) { const int rr = (lane >> 3) + 8 * j; *(LAS u32x4*)(vbp + rr * ATT_VROW + (lane & 7) * 16) = vv[k2][j]; }
                bf16x8 pf;
                { const f32x4 pa = s[2 * k2]; const f32x4 pb = (k2 < 4) ? s[2 * k2 + 1 < 9 ? 2 * k2 + 1 : 8] : (f32x4){0.f, 0.f, 0.f, 0.f};
                  u32x4 pw; pw.x = pg8::cvt_pk_bf16(pa[0], pa[1]); pw.y = pg8::cvt_pk_bf16(pa[2], pa[3]); pw.z = pg8::cvt_pk_bf16(pb[0], pb[1]); pw.w = pg8::cvt_pk_bf16(pb[2], pb[3]);
                  pf = __builtin_bit_cast(bf16x8, pw); }
                s16x4 lo[4], hi[4];
#pragma unroll
                for (int c = 0; c < 4; ++c) {
                    asm volatile("ds_read_b64_tr_b16 %0, %1 offset:%2" : "=&v"(lo[c]) : "v"(vrd), "i"(32 * c) : "memory");
                    asm volatile("ds_read_b64_tr_b16 %0, %1 offset:%2" : "=&v"(hi[c]) : "v"(vrd), "i"(16 * ATT_VROW + 32 * c) : "memory");
                }
                asm volatile("s_waitcnt lgkmcnt(0)" ::: "memory"); __builtin_amdgcn_sched_barrier(0);
#pragma unroll
                for (int c = 0; c < 4; ++c) {
                    const bf16x8 af = (bf16x8){lo[c][0], lo[c][1], lo[c][2], lo[c][3], hi[c][0], hi[c][1], hi[c][2], hi[c][3]};
                    o[c] = __builtin_amdgcn_mfma_f32_16x16x32_bf16(af, pf, o[c], 0, 0, 0);
                }
            }
            __builtin_amdgcn_sched_barrier(0);
            if (n < 5) { int d2, L2, p02, r2; ATT_GEOM(n + 1, d2, L2, p02, r2); ATT_LOAD_V(d2, L2, p02, r2, 0, ATT_VPRE); }
            __builtin_amdgcn_sched_barrier(0);
            const int tl = tq - i0;
            LAS float* sp = st + tl * ATT_ST_STRIDE;
            if (br == 0) {
#pragma unroll
                for (int c = 0; c < 4; ++c) *(LAS f32x4*)(sp + 16 * c + 4 * g) = o[c];
                if (g == 0) { sp[64] = m; sp[65] = lsum; }
            } else {
                const float mo = sp[64], lo_ = sp[65];
                f32x4 oo[4];
#pragma unroll
                for (int c = 0; c < 4; ++c) oo[c] = *(const LAS f32x4*)(sp + 16 * c + 4 * g);
                const float mn = fmaxf(mo, m);
                const float fa = __builtin_amdgcn_exp2f(mo - mn), fb = __builtin_amdgcn_exp2f(m - mn);
                const float ln = fa * lo_ + fb * lsum;
                if (br == 1) {
#pragma unroll
                    for (int c = 0; c < 4; ++c) *(LAS f32x4*)(sp + 16 * c + 4 * g) = oo[c] * fa + o[c] * fb;
                    if (g == 0) { sp[64] = mn; sp[65] = ln; }
                } else {
                    const float inv = 1.0f / ln;
                    bf16_t* yp = y + ((size_t)b * SEQ + tq) * DM + 512 + head * 64 + 4 * g;
#pragma unroll
                    for (int c = 0; c < 4; ++c) { const f32x4 ov = (oo[c] * fa + o[c] * fb) * inv;
                        u32x2 wv2; wv2.x = pg8::cvt_pk_bf16(ov[0], ov[1]); wv2.y = pg8::cvt_pk_bf16(ov[2], ov[3]); *(u32x2*)(yp + 16 * c) = wv2; }
                }
            }
            if (n & 1) __syncthreads();
        }
#undef ATT_GEOM
#undef ATT_LOAD_KQ
    }
}

#define HG_QS 272
#define HG_SS 144
#define HG_QT 0
#define HG_KT 17408
#define HG_VT 34816
#define HG_ST 52224
#define HG_OST 34816
#define HG_MISC 68608
#define HG_GRP 70656
#define HG_OS 528
typedef float f32x16 __attribute__((ext_vector_type(16)));
#define TR_READ(dst, base, off) asm volatile("ds_read_b64_tr_b16 %0, %1 offset:%2" : "=&v"(dst) : "v"(base), "i"(off) : "memory")
#define HG_BAR() do { asm volatile("s_waitcnt lgkmcnt(0)" ::: "memory"); __builtin_amdgcn_s_barrier(); asm volatile("" ::: "memory"); } while (0)
__device__ void hgrn_phase(int WV, const Params& p, int layer, LAS unsigned char* lds) {
    const int BID = o_bid();
    const int grp = WV >> 2, w = WV & 3;
    LAS unsigned char* gl = lds + grp * HG_GRP;
    LAS float* tot = (LAS float*)(gl + HG_MISC); LAS float* sref = tot + 256; LAS float* send = tot + 384;
    const int half = (WV >> 1) & 1;
#pragma unroll 1
    for (int item = BID; item < NB * 4; item += gridDim.x) {
        const int h = item & 3, b = item >> 2;
        const int c = (WV & 1) * 64 + (o_tid(WV) & 63);
        const bf16_t* pb = p.proj + (size_t)b * SEQ * INC;
        f32x16 stt[4];
#pragma unroll
        for (int ct = 0; ct < 4; ++ct)
#pragma unroll
            for (int i = 0; i < 16; ++i) stt[ct][i] = 0.f;
        { const int lane0 = o_tid(WV) & 63, cw0 = WV & 1, cf0 = grp ? 31 * 64 : 0;
#pragma unroll
          for (int k = 0; k < 4; ++k) { const int id = lane0 + 64 * k, tau = 32 * half + (id >> 3), ch = id & 7; const int t = grp ? (cf0 + 63 - tau) : (cf0 + tau);
              const bf16_t* row = pb + (size_t)t * INC + h * 128 + 64 * cw0 + 8 * ch; const u32x4 q0 = *(const u32x4*)row, a0 = *(const u32x4*)(row + 512 + grp * 512);
              *(LAS u32x4*)(gl + HG_QT + tau * HG_QS + (64 * cw0 + 8 * ch) * 2) = q0; *(LAS u32x4*)(gl + HG_KT + tau * HG_QS + (64 * cw0 + 8 * ch) * 2) = a0; } }
        u32x4 vld[4];
        { const int gt0 = (WV & 3) * 64 + (o_tid(WV) & 63), cf0 = grp ? 31 * 64 : 0;
#pragma unroll
          for (int i = 0; i < 4; ++i) { const int id = gt0 + 256 * i, tau = id >> 4, ch = id & 15; const int t = grp ? (cf0 + 63 - tau) : (cf0 + tau);
              vld[i] = *(const u32x4*)(pb + (size_t)t * INC + 1536 + h * 128 + 8 * ch); } }
#pragma unroll 1
        for (int j = 0; j < 32; ++j) {
            const int ci = grp ? (31 - j) : j, c0 = ci * 64;
            const int lane = o_tid(WV) & 63, gt = w * 64 + lane, r = lane & 31, hh = lane >> 5;
            const int gi = lane >> 4, li = lane & 15, tq = li >> 2, tp = li & 3;
            const int trV = (int)(uintptr_t)(gl + HG_VT) + (8 * hh + tq) * HG_QS + (32 * w + 16 * (gi & 1) + 4 * tp) * 2;
            const int trK = (int)(uintptr_t)(gl + HG_KT) + (8 * hh + tq) * HG_QS + (16 * (gi & 1) + 4 * tp) * 2;
            if (j > 0) {
#pragma unroll
                for (int i = 0; i < 4; ++i) { const int id = gt + 256 * i, tau = id >> 4, ch = id & 15; const int t = grp ? (c0 + 63 - tau) : (c0 + tau);
                    vld[i] = *(const u32x4*)(pb + (size_t)t * INC + 1536 + h * 128 + 8 * ch); }
            }
            const int cw = WV & 1;
            unsigned kq[32];
            {
                float pl = 1.0f;
#pragma unroll
                for (int i = 0; i < 32; ++i) { const int tau = 32 * half + i;
                    const unsigned qraw = *(const LAS bf16_t*)(gl + HG_QT + tau * HG_QS + c * 2), fraw = *(const LAS bf16_t*)(gl + HG_KT + tau * HG_QS + c * 2);
                    pl = fmaxf(pl * __uint_as_float(fraw << 16), 1e-30f);
                    kq[i] = fraw | (qraw << 16);
                    if ((i & 7) == 7) __builtin_amdgcn_sched_barrier(0);
                }
                tot[half * 128 + c] = pl;
            }
            asm volatile("s_waitcnt vmcnt(0)" ::: "memory");
            HG_BAR();
            {
                const float t0 = tot[c], t1 = tot[128 + c];
                const float fa = half ? 1.0f : __builtin_amdgcn_rcpf(t0), fb = half ? 1.0f : t0;
                float pl = 1.0f;
#pragma unroll
                for (int i = 0; i < 32; ++i) { const int tau = 32 * half + i;
                    const float f = __uint_as_float(kq[i] << 16), qq = __uint_as_float(kq[i] & 0xffff0000u);
                    pl = fmaxf(pl * f, 1e-30f);
                    const float eq = pl * fa, ek = fb * __builtin_amdgcn_rcpf(pl);
                    const unsigned pk = pg8::cvt_pk_bf16(qq * eq, (1.0f - f) * ek);
                    *(LAS bf16_t*)(gl + HG_QT + tau * HG_QS + c * 2) = (bf16_t)(pk & 0xffffu);
                    *(LAS bf16_t*)(gl + HG_KT + tau * HG_QS + c * 2) = (bf16_t)(pk >> 16);
                    if ((i & 7) == 7) __builtin_amdgcn_sched_barrier(0); }
                if (half == 0) sref[c] = t0; else send[c] = t1;
#pragma unroll
                for (int i = 0; i < 4; ++i) { const int id = gt + 256 * i, tau = id >> 4, ch = id & 15; *(LAS u32x4*)(gl + HG_VT + tau * HG_QS + ch * 16) = vld[i]; }
            }
            HG_BAR();
            u32x4 rq[4], ra[4];
            if (j < 31) {
                const int cn = grp ? (30 - j) : (j + 1), cn0 = cn * 64;
#pragma unroll
                for (int k = 0; k < 4; ++k) { const int id = lane + 64 * k, tau = 32 * half + (id >> 3), ch = id & 7; const int t = grp ? (cn0 + 63 - tau) : (cn0 + tau);
                    const bf16_t* row = pb + (size_t)t * INC + h * 128 + 64 * cw + 8 * ch; rq[k] = *(const u32x4*)row; ra[k] = *(const u32x4*)(row + 512 + grp * 512); }
            }
#pragma unroll
            for (int ct = 0; ct < 4; ++ct)
#pragma unroll
                for (int s = 0; s < 2; ++s) { const f32x4 s0 = *(const LAS f32x4*)(sref + 32 * ct + 16 * s + 4 * hh), s1 = *(const LAS f32x4*)(sref + 32 * ct + 16 * s + 8 + 4 * hh);
#pragma unroll
                    for (int i = 0; i < 4; ++i) { stt[ct][8 * s + i] *= s0[i]; stt[ct][8 * s + 4 + i] *= s1[i]; } }
            if (w != 1) {
                const int st_ = (w == 3) ? 1 : 0, tt_ = (w == 0) ? 0 : 1;
                f32x16 sa;
#pragma unroll
                for (int i = 0; i < 16; ++i) sa[i] = 0.f;
#pragma unroll
                for (int ks = 0; ks < 8; ++ks) {
                    const bf16x8 ka = *(const LAS bf16x8*)(gl + HG_KT + (32 * st_ + r) * HG_QS + (16 * ks + 8 * hh) * 2);
                    const bf16x8 qb = *(const LAS bf16x8*)(gl + HG_QT + (32 * tt_ + r) * HG_QS + (16 * ks + 8 * hh) * 2);
                    sa = __builtin_amdgcn_mfma_f32_32x32x16_bf16(ka, qb, sa, 0, 0, 0);
                }
                const int tau_abs = 32 * tt_ + r;
#pragma unroll
                for (int rg = 0; rg < 4; ++rg) { float v4[4];
#pragma unroll
                    for (int i = 0; i < 4; ++i) { const int sig_abs = 32 * st_ + 8 * rg + 4 * hh + i; v4[i] = (sig_abs <= tau_abs) ? sa[4 * rg + i] : 0.f; }
                    u32x2 wv2; wv2.x = pg8::cvt_pk_bf16(v4[0], v4[1]); wv2.y = pg8::cvt_pk_bf16(v4[2], v4[3]);
                    *(LAS u32x2*)(gl + HG_ST + tau_abs * HG_SS + (32 * st_ + 8 * rg + 4 * hh) * 2) = wv2; }
            }
            __builtin_amdgcn_sched_barrier(0);
            f32x16 oacc[2];
#pragma unroll
            for (int tt = 0; tt < 2; ++tt)
#pragma unroll
                for (int i = 0; i < 16; ++i) oacc[tt][i] = 0.f;
#pragma unroll
            for (int ct = 0; ct < 4; ++ct)
#pragma unroll
                for (int s = 0; s < 2; ++s) {
                    u32x4 bw; bw.x = pg8::cvt_pk_bf16(stt[ct][8 * s + 0], stt[ct][8 * s + 1]); bw.y = pg8::cvt_pk_bf16(stt[ct][8 * s + 2], stt[ct][8 * s + 3]);
                    bw.z = pg8::cvt_pk_bf16(stt[ct][8 * s + 4], stt[ct][8 * s + 5]); bw.w = pg8::cvt_pk_bf16(stt[ct][8 * s + 6], stt[ct][8 * s + 7]);
                    const bf16x8 bfr = __builtin_bit_cast(bf16x8, bw);
#pragma unroll
                    for (int tt = 0; tt < 2; ++tt) {
                        const LAS unsigned char* qa = gl + HG_QT + (32 * tt + r) * HG_QS + (32 * ct + 16 * s + 4 * hh) * 2;
                        const u32x2 a0 = *(const LAS u32x2*)qa, a1 = *(const LAS u32x2*)(qa + 16);
                        u32x4 aw; aw.x = a0.x; aw.y = a0.y; aw.z = a1.x; aw.w = a1.y;
                        oacc[tt] = __builtin_amdgcn_mfma_f32_32x32x16_bf16(__builtin_bit_cast(bf16x8, aw), bfr, oacc[tt], 0, 0, 0);
                    }
                    __builtin_amdgcn_sched_barrier(0);
                }
            HG_BAR();
            bf16x8 vf[4];
            { s16x4 lo[4], hi[4];
#pragma unroll
              for (int ks = 0; ks < 4; ++ks) { TR_READ(lo[ks], trV, (16 * ks) * HG_QS); TR_READ(hi[ks], trV, (16 * ks + 4) * HG_QS); }
              asm volatile("s_waitcnt lgkmcnt(0)" : "+v"(lo[0]), "+v"(hi[0]), "+v"(lo[1]), "+v"(hi[1]), "+v"(lo[2]), "+v"(hi[2]), "+v"(lo[3]), "+v"(hi[3]) :: "memory");
#pragma unroll
              for (int ks = 0; ks < 4; ++ks) vf[ks] = (bf16x8){lo[ks][0], lo[ks][1], lo[ks][2], lo[ks][3], hi[ks][0], hi[ks][1], hi[ks][2], hi[ks][3]}; }
            __builtin_amdgcn_sched_barrier(0);
#pragma unroll
            for (int tt = 0; tt < 2; ++tt)
#pragma unroll
                for (int ks = 0; ks < 4; ++ks) { if (tt == 0 && ks >= 2) continue;
                    const bf16x8 sfr = *(const LAS bf16x8*)(gl + HG_ST + (32 * tt + r) * HG_SS + (16 * ks + 8 * hh) * 2);
                    oacc[tt] = __builtin_amdgcn_mfma_f32_32x32x16_bf16(sfr, vf[ks], oacc[tt], 0, 0, 0); }
#pragma unroll
            for (int ct = 0; ct < 4; ++ct) {
                bf16x8 kf[4];
                { s16x4 lo[4], hi[4];
#pragma unroll
                  for (int ks = 0; ks < 4; ++ks) { TR_READ(lo[ks], trK, (16 * ks) * HG_QS + 64 * ct); TR_READ(hi[ks], trK, (16 * ks + 4) * HG_QS + 64 * ct); }
                  asm volatile("s_waitcnt lgkmcnt(0)" : "+v"(lo[0]), "+v"(hi[0]), "+v"(lo[1]), "+v"(hi[1]), "+v"(lo[2]), "+v"(hi[2]), "+v"(lo[3]), "+v"(hi[3]) :: "memory");
#pragma unroll
                  for (int ks = 0; ks < 4; ++ks) kf[ks] = (bf16x8){lo[ks][0], lo[ks][1], lo[ks][2], lo[ks][3], hi[ks][0], hi[ks][1], hi[ks][2], hi[ks][3]}; }
                __builtin_amdgcn_sched_barrier(0);
#pragma unroll
                for (int ks = 0; ks < 4; ++ks) stt[ct] = __builtin_amdgcn_mfma_f32_32x32x16_bf16(kf[ks], vf[ks], stt[ct], 0, 0, 0);
#pragma unroll
                for (int s = 0; s < 2; ++s) { const f32x4 s0 = *(const LAS f32x4*)(send + 32 * ct + 16 * s + 4 * hh), s1 = *(const LAS f32x4*)(send + 32 * ct + 16 * s + 8 + 4 * hh);
#pragma unroll
                    for (int i = 0; i < 4; ++i) { stt[ct][8 * s + i] *= s0[i]; stt[ct][8 * s + 4 + i] *= s1[i]; } }
            }
            HG_BAR();
            if (j < 31) {
#pragma unroll
                for (int k = 0; k < 4; ++k) { const int id = lane + 64 * k, tau = 32 * half + (id >> 3), ch = id & 7;
                    *(LAS u32x4*)(gl + HG_QT + tau * HG_QS + (64 * cw + 8 * ch) * 2) = rq[k]; *(LAS u32x4*)(gl + HG_KT + tau * HG_QS + (64 * cw + 8 * ch) * 2) = ra[k]; }
            }
#pragma unroll
            for (int tt = 0; tt < 2; ++tt)
#pragma unroll
                for (int i = 0; i < 16; ++i) { const int tau = 32 * tt + (i & 3) + 8 * (i >> 2) + 4 * hh; *(LAS float*)(gl + HG_OST + tau * HG_OS + (32 * w + r) * 4) = oacc[tt][i]; }
            HG_BAR();
            {
                const int tau = gt >> 2, seg = gt & 3; const int t = grp ? (c0 + 63 - tau) : (c0 + tau);
                const LAS f32x4* orow = (const LAS f32x4*)(gl + HG_OST + tau * HG_OS + seg * 128);
                bf16_t* yp = p.y + ((size_t)b * SEQ + t) * DM + h * 128 + seg * 32;
                if (j < 16) {
#pragma unroll
                    for (int i = 0; i < 4; ++i) { const f32x4 oa = orow[2 * i], ob = orow[2 * i + 1];
                        u32x4 o4; o4.x = pg8::cvt_pk_bf16(oa[0], oa[1]); o4.y = pg8::cvt_pk_bf16(oa[2], oa[3]); o4.z = pg8::cvt_pk_bf16(ob[0], ob[1]); o4.w = pg8::cvt_pk_bf16(ob[2], ob[3]); *(u32x4*)(yp + 8 * i) = o4; }
                } else {
                    const bf16_t* hg = p.proj + ((size_t)b * SEQ + t) * INC + 2048 + h * 128 + seg * 32;
                    LAS f32x4* erow = (LAS f32x4*)(gl + HG_OST + tau * HG_OS + seg * 128);
                    float ss = 0.f;
                    { u32x4 fpv[4];
#pragma unroll
                      for (int i = 0; i < 4; ++i) fpv[i] = *(const u32x4*)(yp + 8 * i);
                      __builtin_amdgcn_sched_barrier(0);
#pragma unroll
                      for (int i = 0; i < 4; ++i) { f32x4 oa = erow[2 * i], ob = erow[2 * i + 1]; const u32x4 pv = fpv[i];
                          oa[0] += __uint_as_float(pv.x << 16); oa[1] += __uint_as_float(pv.x & 0xffff0000u); oa[2] += __uint_as_float(pv.y << 16); oa[3] += __uint_as_float(pv.y & 0xffff0000u);
                          ob[0] += __uint_as_float(pv.z << 16); ob[1] += __uint_as_float(pv.z & 0xffff0000u); ob[2] += __uint_as_float(pv.w << 16); ob[3] += __uint_as_float(pv.w & 0xffff0000u);
                          erow[2 * i] = oa; erow[2 * i + 1] = ob;
                          const f32x4 qa = oa * oa, qb = ob * ob; ss += (qa[0] + qa[1]) + (qa[2] + qa[3]) + (qb[0] + qb[1]) + (qb[2] + qb[3]); } }
                    __builtin_amdgcn_sched_barrier(0);
                    u32x4 fgv[4];
#pragma unroll
                    for (int i = 0; i < 4; ++i) fgv[i] = *(const u32x4*)(hg + 8 * i);
                    ss += __shfl_xor(ss, 1); ss += __shfl_xor(ss, 2);
                    const float rn = rsqrtf(ss * (1.0f / 128.0f) + 1e-6f);
                    __builtin_amdgcn_sched_barrier(0);
#pragma unroll
                    for (int i = 0; i < 4; ++i) { const f32x4 oa = erow[2 * i] * rn, ob = erow[2 * i + 1] * rn; const u32x4 gv = fgv[i];
                        u32x4 o4;
                        o4.x = pg8::cvt_pk_bf16(oa[0] * __uint_as_float(gv.x << 16), oa[1] * __uint_as_float(gv.x & 0xffff0000u));
                        o4.y = pg8::cvt_pk_bf16(oa[2] * __uint_as_float(gv.y << 16), oa[3] * __uint_as_float(gv.y & 0xffff0000u));
                        o4.z = pg8::cvt_pk_bf16(ob[0] * __uint_as_float(gv.z << 16), ob[1] * __uint_as_float(gv.z & 0xffff0000u));
                        o4.w = pg8::cvt_pk_bf16(ob[2] * __uint_as_float(gv.w << 16), ob[3] * __uint_as_float(gv.w & 0xffff0000u));
                        *(u32x4*)(yp + 8 * i) = o4; }
                }
            }
        }
        asm volatile("s_waitcnt vmcnt(0)" ::: "memory");
        __syncthreads();
    }
}

#define H2_QT 0
#define H2_KT 17408
#define H2_VT 34816
#define H2_ST 52224
#define H2_MISC 61440
#define H2_BUF 62464
#define H2_OST (2 * H2_BUF)
#define H2_FLAG (H2_OST + 17408)
__device__ void hgrn2_phase(int WV, const Params& p, int layer, LAS unsigned char* lds) {
    const int BID = o_bid();
    const int w = WV & 3;
#pragma unroll 1
    for (int item = BID; item < NB * 4 * 2; item += gridDim.x) {
        const int dir = item & 1, h = (item >> 1) & 3, b = item >> 3;
        const bf16_t* pb = p.proj + (size_t)b * SEQ * INC;
        bf16_t* odst = dir ? (p.ob + (size_t)b * SEQ * 512 + h * 128) : (p.y + (size_t)b * SEQ * DM + h * 128);
        const int ostride = dir ? 512 : DM;
        if (WV < 4) {
            f32x16 stt[4];
#pragma unroll
            for (int ct = 0; ct < 4; ++ct)
#pragma unroll
                for (int i = 0; i < 16; ++i) stt[ct][i] = 0.f;
#pragma unroll 1
            for (int k = -1; k <= 32; ++k) {
                const int lane = o_tid(WV) & 63, r = lane & 31, hh = lane >> 5;
                if (k >= 1) {
                    const int st_ = w * 64 + lane; const int cp0 = (dir ? (31 - (k - 1)) : (k - 1)) * 64; const int row = st_ >> 2, seg = st_ & 3; const int t = dir ? (cp0 + 63 - row) : (cp0 + row);
                    const LAS u32x4* sp = (const LAS u32x4*)(lds + H2_OST + row * HG_QS + seg * 64);
                    u32x4* dp = (u32x4*)(odst + (size_t)t * ostride + seg * 32);
#pragma unroll
                    for (int i = 0; i < 4; ++i) dp[i] = sp[i];
                }
                if (k < 0 || k > 31) { HG_BAR(); HG_BAR(); continue; }
                const int gi = lane >> 4, li = lane & 15, tq = li >> 2, tp = li & 3;
                LAS unsigned char* gl = lds + (k & 1) * H2_BUF;
                LAS float* sref = (LAS float*)(gl + H2_MISC); LAS float* send = sref + 128;
                const int trV = (int)(uintptr_t)(gl + H2_VT) + (8 * hh + tq) * HG_QS + (32 * w + 16 * (gi & 1) + 4 * tp) * 2;
                const int trK = (int)(uintptr_t)(gl + H2_KT) + (8 * hh + tq) * HG_QS + (16 * (gi & 1) + 4 * tp) * 2;
#pragma unroll
                for (int ct = 0; ct < 4; ++ct)
#pragma unroll
                    for (int s = 0; s < 2; ++s) { const f32x4 s0 = *(const LAS f32x4*)(sref + 32 * ct + 16 * s + 4 * hh), s1 = *(const LAS f32x4*)(sref + 32 * ct + 16 * s + 8 + 4 * hh);
#pragma unroll
                        for (int i = 0; i < 4; ++i) { stt[ct][8 * s + i] *= s0[i]; stt[ct][8 * s + 4 + i] *= s1[i]; } }
                f32x16 oacc[2];
#pragma unroll
                for (int tt = 0; tt < 2; ++tt)
#pragma unroll
                    for (int i = 0; i < 16; ++i) oacc[tt][i] = 0.f;
#pragma unroll
                for (int ct = 0; ct < 4; ++ct)
#pragma unroll
                    for (int s = 0; s < 2; ++s) {
                        u32x4 bw; bw.x = pg8::cvt_pk_bf16(stt[ct][8 * s + 0], stt[ct][8 * s + 1]); bw.y = pg8::cvt_pk_bf16(stt[ct][8 * s + 2], stt[ct][8 * s + 3]);
                        bw.z = pg8::cvt_pk_bf16(stt[ct][8 * s + 4], stt[ct][8 * s + 5]); bw.w = pg8::cvt_pk_bf16(stt[ct][8 * s + 6], stt[ct][8 * s + 7]);
                        const bf16x8 bfr = __builtin_bit_cast(bf16x8, bw);
#pragma unroll
                        for (int tt = 0; tt < 2; ++tt) {
                            const LAS unsigned char* qa = gl + H2_QT + (32 * tt + r) * HG_QS + (32 * ct + 16 * s + 4 * hh) * 2;
                            const u32x2 a0 = *(const LAS u32x2*)qa, a1 = *(const LAS u32x2*)(qa + 16);
                            u32x4 aw; aw.x = a0.x; aw.y = a0.y; aw.z = a1.x; aw.w = a1.y;
                            oacc[tt] = __builtin_amdgcn_mfma_f32_32x32x16_bf16(__builtin_bit_cast(bf16x8, aw), bfr, oacc[tt], 0, 0, 0);
                        }
                        __builtin_amdgcn_sched_barrier(0);
                    }
                HG_BAR();
                bf16x8 vf[4];
                { s16x4 lo[4], hi[4];
#pragma unroll
                  for (int ks = 0; ks < 4; ++ks) { TR_READ(lo[ks], trV, (16 * ks) * HG_QS); TR_READ(hi[ks], trV, (16 * ks + 4) * HG_QS); }
                  asm volatile("s_waitcnt lgkmcnt(0)" : "+v"(lo[0]), "+v"(hi[0]), "+v"(lo[1]), "+v"(hi[1]), "+v"(lo[2]), "+v"(hi[2]), "+v"(lo[3]), "+v"(hi[3]) :: "memory");
#pragma unroll
                  for (int ks = 0; ks < 4; ++ks) vf[ks] = (bf16x8){lo[ks][0], lo[ks][1], lo[ks][2], lo[ks][3], hi[ks][0], hi[ks][1], hi[ks][2], hi[ks][3]}; }
                __builtin_amdgcn_sched_barrier(0);
#pragma unroll
                for (int tt = 0; tt < 2; ++tt)
#pragma unroll
                    for (int ks = 0; ks < 4; ++ks) { if (tt == 0 && ks >= 2) continue;
                        const bf16x8 sfr = *(const LAS bf16x8*)(gl + H2_ST + (32 * tt + r) * HG_SS + (16 * ks + 8 * hh) * 2);
                        oacc[tt] = __builtin_amdgcn_mfma_f32_32x32x16_bf16(sfr, vf[ks], oacc[tt], 0, 0, 0); }
#pragma unroll
                for (int ct = 0; ct < 4; ++ct) {
                    bf16x8 kf[4];
                    { s16x4 lo[4], hi[4];
#pragma unroll
                      for (int ks = 0; ks < 4; ++ks) { TR_READ(lo[ks], trK, (16 * ks) * HG_QS + 64 * ct); TR_READ(hi[ks], trK, (16 * ks + 4) * HG_QS + 64 * ct); }
                      asm volatile("s_waitcnt lgkmcnt(0)" : "+v"(lo[0]), "+v"(hi[0]), "+v"(lo[1]), "+v"(hi[1]), "+v"(lo[2]), "+v"(hi[2]), "+v"(lo[3]), "+v"(hi[3]) :: "memory");
#pragma unroll
                      for (int ks = 0; ks < 4; ++ks) kf[ks] = (bf16x8){lo[ks][0], lo[ks][1], lo[ks][2], lo[ks][3], hi[ks][0], hi[ks][1], hi[ks][2], hi[ks][3]}; }
                    __builtin_amdgcn_sched_barrier(0);
#pragma unroll
                    for (int ks = 0; ks < 4; ++ks) stt[ct] = __builtin_amdgcn_mfma_f32_32x32x16_bf16(kf[ks], vf[ks], stt[ct], 0, 0, 0);
#pragma unroll
                    for (int s = 0; s < 2; ++s) { const f32x4 s0 = *(const LAS f32x4*)(send + 32 * ct + 16 * s + 4 * hh), s1 = *(const LAS f32x4*)(send + 32 * ct + 16 * s + 8 + 4 * hh);
#pragma unroll
                        for (int i = 0; i < 4; ++i) { stt[ct][8 * s + i] *= s0[i]; stt[ct][8 * s + 4 + i] *= s1[i]; } }
                }
#pragma unroll
                for (int tt = 0; tt < 2; ++tt)
#pragma unroll
                    for (int i = 0; i < 16; i += 2) { const int tau = 32 * tt + (i & 3) + 8 * (i >> 2) + 4 * hh;
                        const unsigned pk = pg8::cvt_pk_bf16(oacc[tt][i], oacc[tt][i + 1]);
                        *(LAS bf16_t*)(lds + H2_OST + tau * HG_QS + (32 * w + r) * 2) = (bf16_t)(pk & 0xffffu);
                        *(LAS bf16_t*)(lds + H2_OST + (tau + 1) * HG_QS + (32 * w + r) * 2) = (bf16_t)(pk >> 16); }
                HG_BAR();
            }
        } else {
            const int pw = WV - 4;
            u32x4 rq[4], rf[4], rv[4];
            {
                const int lane = o_tid(WV) & 63, pt = pw * 64 + lane; const int c0 = (dir ? 31 : 0) * 64;
#pragma unroll
                for (int i = 0; i < 4; ++i) { const int id = lane + 64 * i, row = id >> 2, ch = id & 3; const int t = dir ? (c0 + 63 - row) : (c0 + row);
                    const bf16_t* src = pb + (size_t)t * INC + h * 128 + 32 * pw + 8 * ch; rq[i] = *(const u32x4*)src; rf[i] = *(const u32x4*)(src + 512 + dir * 512); }
#pragma unroll
                for (int i = 0; i < 4; ++i) { const int id = pt + 256 * i, tau = id >> 4, ch = id & 15; const int t = dir ? (c0 + 63 - tau) : (c0 + tau);
                    rv[i] = *(const u32x4*)(pb + (size_t)t * INC + 1536 + h * 128 + 8 * ch); }
            }
#pragma unroll 1
            for (int k = -1; k <= 32; ++k) {
                const int lane = o_tid(WV) & 63, pt = pw * 64 + lane, cl = lane & 31, half = lane >> 5, c = 32 * pw + cl;
                LAS unsigned char* gn = lds + ((k + 1) & 1) * H2_BUF;
                if (k + 1 <= 31) {
#pragma unroll
                    for (int i = 0; i < 4; ++i) { const int id = lane + 64 * i, row = id >> 2, ch = id & 3;
                        *(LAS u32x4*)(gn + H2_QT + row * HG_QS + (32 * pw + 8 * ch) * 2) = rq[i]; *(LAS u32x4*)(gn + H2_KT + row * HG_QS + (32 * pw + 8 * ch) * 2) = rf[i]; }
#pragma unroll
                    for (int i = 0; i < 4; ++i) { const int id = pt + 256 * i, tau = id >> 4, ch = id & 15; *(LAS u32x4*)(gn + H2_VT + tau * HG_QS + ch * 16) = rv[i]; }
                    float pl = 1.0f;
#pragma unroll
                    for (int i = 0; i < 32; ++i) { const unsigned fraw = *(const LAS bf16_t*)(gn + H2_KT + (32 * half + i) * HG_QS + c * 2); pl = fmaxf(pl * __uint_as_float(fraw << 16), 1e-30f); }
                    const float po = __shfl_xor(pl, 32);
                    const float t0 = half ? po : pl, t1 = half ? pl : po;
                    const float fa = half ? 1.0f : __builtin_amdgcn_rcpf(t0), fb = half ? 1.0f : t0;
                    pl = 1.0f;
#pragma unroll
                    for (int i = 0; i < 32; ++i) { const int tau = 32 * half + i;
                        const unsigned qraw = *(const LAS bf16_t*)(gn + H2_QT + tau * HG_QS + c * 2), fraw = *(const LAS bf16_t*)(gn + H2_KT + tau * HG_QS + c * 2);
                        const float f = __uint_as_float(fraw << 16), qq = __uint_as_float(qraw << 16);
                        pl = fmaxf(pl * f, 1e-30f);
                        const float eq = pl * fa, ek = fb * __builtin_amdgcn_rcpf(pl);
                        const unsigned pk = pg8::cvt_pk_bf16(qq * eq, (1.0f - f) * ek);
                        *(LAS bf16_t*)(gn + H2_QT + tau * HG_QS + c * 2) = (bf16_t)(pk & 0xffffu);
                        *(LAS bf16_t*)(gn + H2_KT + tau * HG_QS + c * 2) = (bf16_t)(pk >> 16);
                        if ((i & 7) == 7) __builtin_amdgcn_sched_barrier(0); }
                    LAS float* srefn = (LAS float*)(gn + H2_MISC);
                    if (half == 0) srefn[c] = t0; else srefn[128 + c] = t1;
                }
                if (k + 2 <= 31) {
                    const int c0 = (dir ? (31 - (k + 2)) : (k + 2)) * 64;
#pragma unroll
                    for (int i = 0; i < 4; ++i) { const int id = lane + 64 * i, row = id >> 2, ch = id & 3; const int t = dir ? (c0 + 63 - row) : (c0 + row);
                        const bf16_t* src = pb + (size_t)t * INC + h * 128 + 32 * pw + 8 * ch; rq[i] = *(const u32x4*)src; rf[i] = *(const u32x4*)(src + 512 + dir * 512); }
#pragma unroll
                    for (int i = 0; i < 4; ++i) { const int id = pt + 256 * i, tau = id >> 4, ch = id & 15; const int t = dir ? (c0 + 63 - tau) : (c0 + tau);
                        rv[i] = *(const u32x4*)(pb + (size_t)t * INC + 1536 + h * 128 + 8 * ch); }
                }
                HG_BAR();
                if (k + 1 <= 31 && pw < 3) {
                    const int r = lane & 31, hh = lane >> 5;
                    const int st_ = (pw == 2) ? 1 : 0, tt_ = (pw == 0) ? 0 : 1;
                    f32x16 sa;
#pragma unroll
                    for (int i = 0; i < 16; ++i) sa[i] = 0.f;
#pragma unroll
                    for (int ks = 0; ks < 8; ++ks) {
                        const bf16x8 ka = *(const LAS bf16x8*)(gn + H2_KT + (32 * st_ + r) * HG_QS + (16 * ks + 8 * hh) * 2);
                        const bf16x8 qb = *(const LAS bf16x8*)(gn + H2_QT + (32 * tt_ + r) * HG_QS + (16 * ks + 8 * hh) * 2);
                        sa = __builtin_amdgcn_mfma_f32_32x32x16_bf16(ka, qb, sa, 0, 0, 0);
                    }
                    const int tau_abs = 32 * tt_ + r;
#pragma unroll
                    for (int rg = 0; rg < 4; ++rg) { float v4[4];
#pragma unroll
                        for (int i = 0; i < 4; ++i) { const int sig_abs = 32 * st_ + 8 * rg + 4 * hh + i; v4[i] = (sig_abs <= tau_abs) ? sa[4 * rg + i] : 0.f; }
                        u32x2 wv2; wv2.x = pg8::cvt_pk_bf16(v4[0], v4[1]); wv2.y = pg8::cvt_pk_bf16(v4[2], v4[3]);
                        *(LAS u32x2*)(gn + H2_ST + tau_abs * HG_SS + (32 * st_ + 8 * rg + 4 * hh) * 2) = wv2; }
                }
                HG_BAR();
            }
        }
        asm volatile("s_waitcnt vmcnt(0)" ::: "memory");
        __syncthreads();
        LAS int* flagp = (LAS int*)(lds + H2_FLAG);
        if (o_tid(WV) == 0) {
            __builtin_amdgcn_fence(__ATOMIC_RELEASE, "agent");
            asm volatile("s_waitcnt vmcnt(0)" ::: "memory");
            const int old = __hip_atomic_fetch_add(p.hdone + layer * 64 + b * 4 + h, 1, __ATOMIC_RELAXED, __HIP_MEMORY_SCOPE_AGENT);
            if (old == 1) { __builtin_amdgcn_fence(__ATOMIC_ACQUIRE, "agent"); asm volatile("s_waitcnt vmcnt(0)" ::: "memory"); }
            *flagp = old;
        }
        __syncthreads();
        if (*flagp == 1) {
            const int tid = o_tid(WV);
            bf16_t* yb = p.y + (size_t)b * SEQ * DM + h * 128; const bf16_t* obb = p.ob + (size_t)b * SEQ * 512 + h * 128; const bf16_t* gb = pb + 2048 + h * 128;
#pragma unroll 1
            for (int it = 0; it < (SEQ * 4) / NTHREADS; ++it) {
                const int piece = tid + NTHREADS * it, row = piece >> 2, seg = piece & 3;
                u32x4* yp = (u32x4*)(yb + (size_t)row * DM + seg * 32); const u32x4* op = (const u32x4*)(obb + (size_t)row * 512 + seg * 32); const u32x4* gp = (const u32x4*)(gb + (size_t)row * INC + seg * 32);
                u32x4 fv[4], bv[4], gv[4];
#pragma unroll
                for (int i = 0; i < 4; ++i) { fv[i] = yp[i]; bv[i] = op[i]; gv[i] = gp[i]; }
                __builtin_amdgcn_sched_barrier(0);
                f32x4 e[8]; float ss = 0.f;
#pragma unroll
                for (int i = 0; i < 4; ++i) {
                    e[2 * i][0] = __uint_as_float(fv[i].x << 16) + __uint_as_float(bv[i].x << 16); e[2 * i][1] = __uint_as_float(fv[i].x & 0xffff0000u) + __uint_as_float(bv[i].x & 0xffff0000u);
                    e[2 * i][2] = __uint_as_float(fv[i].y << 16) + __uint_as_float(bv[i].y << 16); e[2 * i][3] = __uint_as_float(fv[i].y & 0xffff0000u) + __uint_as_float(bv[i].y & 0xffff0000u);
                    e[2 * i + 1][0] = __uint_as_float(fv[i].z << 16) + __uint_as_float(bv[i].z << 16); e[2 * i + 1][1] = __uint_as_float(fv[i].z & 0xffff0000u) + __uint_as_float(bv[i].z & 0xffff0000u);
                    e[2 * i + 1][2] = __uint_as_float(fv[i].w << 16) + __uint_as_float(bv[i].w << 16); e[2 * i + 1][3] = __uint_as_float(fv[i].w & 0xffff0000u) + __uint_as_float(bv[i].w & 0xffff0000u);
                    const f32x4 q0 = e[2 * i] * e[2 * i], q1 = e[2 * i + 1] * e[2 * i + 1]; ss += (q0[0] + q0[1]) + (q0[2] + q0[3]) + (q1[0] + q1[1]) + (q1[2] + q1[3]); }
                ss += __shfl_xor(ss, 1); ss += __shfl_xor(ss, 2);
                const float rn = rsqrtf(ss * (1.0f / 128.0f) + 1e-6f);
#pragma unroll
                for (int i = 0; i < 4; ++i) { u32x4 o4;
                    o4.x = pg8::cvt_pk_bf16(e[2 * i][0] * rn * __uint_as_float(gv[i].x << 16), e[2 * i][1] * rn * __uint_as_float(gv[i].x & 0xffff0000u));
                    o4.y = pg8::cvt_pk_bf16(e[2 * i][2] * rn * __uint_as_float(gv[i].y << 16), e[2 * i][3] * rn * __uint_as_float(gv[i].y & 0xffff0000u));
                    o4.z = pg8::cvt_pk_bf16(e[2 * i + 1][0] * rn * __uint_as_float(gv[i].z << 16), e[2 * i + 1][1] * rn * __uint_as_float(gv[i].z & 0xffff0000u));
                    o4.w = pg8::cvt_pk_bf16(e[2 * i + 1][2] * rn * __uint_as_float(gv[i].w << 16), e[2 * i + 1][3] * rn * __uint_as_float(gv[i].w & 0xffff0000u));
                    yp[i] = o4; }
            }
        }
        __syncthreads();
    }
}

#define RT_STRIDE 1028
__device__ void ln_router_phase(int WV, const bf16_t* mix, bf16_t* xb, const float* g, const float* bta, const float* w1, const float* b1, const float* w2, const float* b2,
                                int* expert, float* gate, int* rank, int* hist  , int* slot_tok, LAS float* wl) {
    const int TID = o_tid(WV), BID = o_bid();
    LAS int* lhist = (LAS int*)((LAS unsigned char*)wl + 150 * 1024);
    if (TID < NEXP) lhist[TID] = 0;
    for (long i = (long)BID * NTHREADS + TID; i < PSLOTS; i += (long)gridDim.x * NTHREADS) slot_tok[i] = T_TOK;
    {
        f32x4 t1[2], t2[16];
#pragma unroll
        for (int m = 0; m < 2; ++m) t1[m] = ((const f32x4*)w1)[TID + NTHREADS * m];
#pragma unroll
        for (int m = 0; m < 16; ++m) t2[m] = ((const f32x4*)w2)[TID + NTHREADS * m];
        __builtin_amdgcn_sched_barrier(0);
#pragma unroll
        for (int m = 0; m < 2; ++m) { const int k = TID + NTHREADS * m;
#pragma unroll
            for (int i = 0; i < 4; ++i) wl[i * RT_STRIDE + k] = t1[m][i]; }
#pragma unroll
        for (int m = 0; m < 16; ++m) { const int q = TID + NTHREADS * m, k = q >> 3, o4 = (q & 7) * 4;
#pragma unroll
            for (int i = 0; i < 4; ++i) wl[(4 + o4 + i) * RT_STRIDE + k] = t2[m][i]; }
        if (TID < 32) wl[36 * RT_STRIDE + TID] = b2[TID];
    }
    __syncthreads();
    const int lane = TID & 63, gw = BID * NWAVES + (TID >> 6), ngw = gridDim.x * NWAVES;
    const LAS float* wlane = wl + 4 * lane;
    f32x4 gg[4], bb[4];
#pragma unroll
    for (int j = 0; j < 4; ++j) { gg[j] = ((const f32x4*)g)[lane + 64 * j]; bb[j] = ((const f32x4*)bta)[lane + 64 * j]; }
    float b1v[4];
#pragma unroll
    for (int o = 0; o < 4; ++o) b1v[o] = b1[o];
    long w = gw;
    u32x2 hb_[4], mx_[4];
    if (w < T_TOK) {
#pragma unroll
        for (int j = 0; j < 4; ++j) { hb_[j] = ((const u32x2*)(xb + w * DM))[lane + 64 * j]; mx_[j] = ((const u32x2*)(mix + w * DM))[lane + 64 * j]; } }
    for (; w < T_TOK; w += ngw) {
        u32x2 hn_[4], mn_[4]; const long wn = w + ngw;
        if (wn < T_TOK) {
#pragma unroll
            for (int j = 0; j < 4; ++j) { hn_[j] = ((const u32x2*)(xb + wn * DM))[lane + 64 * j]; mn_[j] = ((const u32x2*)(mix + wn * DM))[lane + 64 * j]; } }
        __builtin_amdgcn_sched_barrier(0);
        f32x4 v[4];
#pragma unroll
        for (int j = 0; j < 4; ++j) { v[j][0] = ALPHA * __uint_as_float(hb_[j].x << 16) + __uint_as_float(mx_[j].x << 16); v[j][1] = ALPHA * __uint_as_float(hb_[j].x & 0xffff0000u) + __uint_as_float(mx_[j].x & 0xffff0000u);
            v[j][2] = ALPHA * __uint_as_float(hb_[j].y << 16) + __uint_as_float(mx_[j].y << 16); v[j][3] = ALPHA * __uint_as_float(hb_[j].y & 0xffff0000u) + __uint_as_float(mx_[j].y & 0xffff0000u); }
        float s = 0.f;
#pragma unroll
        for (int j = 0; j < 4; ++j) s += (v[j][0] + v[j][1]) + (v[j][2] + v[j][3]);
        const float mu = wave_sum(s) * (1.0f / 1024.0f);
        float qq = 0.f;
#pragma unroll
        for (int j = 0; j < 4; ++j) { const f32x4 d = v[j] - mu; qq += (d[0] * d[0] + d[1] * d[1]) + (d[2] * d[2] + d[3] * d[3]); }
        const float r = rsqrtf(wave_sum(qq) * (1.0f / 1024.0f) + 1e-5f);
        u32x2* xp = (u32x2*)(xb + w * DM) + lane;
#pragma unroll
        for (int j = 0; j < 4; ++j) { v[j] = (v[j] - mu) * r * gg[j] + bb[j];
            u32x2 o; o.x = pg8::cvt_pk_bf16(v[j][0], v[j][1]); o.y = pg8::cvt_pk_bf16(v[j][2], v[j][3]); xp[64 * j] = o; }
        float l1[4];
#pragma unroll
        for (int o = 0; o < 4; ++o) { float sx = 0.f;
#pragma unroll
            for (int j = 0; j < 4; ++j) { const f32x4 ww = *(const LAS f32x4*)(wlane + o * RT_STRIDE + 256 * j); sx += (v[j][0] * ww[0] + v[j][1] * ww[1]) + (v[j][2] * ww[2] + v[j][3] * ww[3]); }
            l1[o] = sx; }
        wave_sum_n<4>(l1);
        int grp = 0; float mx = l1[0] + b1v[0];
#pragma unroll
        for (int o = 0; o < 4; ++o) l1[o] += b1v[o];
#pragma unroll
        for (int o = 1; o < 4; ++o) if (l1[o] > mx) { mx = l1[o]; grp = o; }
        grp = __builtin_amdgcn_readfirstlane(grp);
        float den = 0.f;
#pragma unroll
        for (int o = 0; o < 4; ++o) den += __expf(l1[o] - mx);
        const float pgrp = 1.0f / den;
        float l2[8];
        const LAS float* wg2 = wlane + (4 + grp * 8) * RT_STRIDE;
#pragma unroll
        for (int o = 0; o < 8; ++o) { float sx = 0.f;
#pragma unroll
            for (int j = 0; j < 4; ++j) { const f32x4 ww = *(const LAS f32x4*)(wg2 + o * RT_STRIDE + 256 * j); sx += (v[j][0] * ww[0] + v[j][1] * ww[1]) + (v[j][2] * ww[2] + v[j][3] * ww[3]); }
            l2[o] = sx; }
        wave_sum_n<8>(l2);
#pragma unroll
        for (int o = 0; o < 8; ++o) l2[o] += wl[36 * RT_STRIDE + grp * 8 + o];
        int e0 = 0; float m0 = l2[0];
#pragma unroll
        for (int o = 1; o < 8; ++o) if (l2[o] > m0) { m0 = l2[o]; e0 = o; }
        int e1 = -1; float m1 = -3.0e38f;
#pragma unroll
        for (int o = 0; o < 8; ++o) if (o != e0 && l2[o] > m1) { m1 = l2[o]; e1 = o; }
        const float rr = __expf(m1 - m0);
        const float wa = 1.0f / (1.0f + rr), wb = rr / (1.0f + rr);
        if (lane == 0) {
            const int ea = grp * 8 + e0, eb = grp * 8 + e1;
            expert[w * 2] = ea; expert[w * 2 + 1] = eb;
            gate[w * 2] = pgrp * wa; gate[w * 2 + 1] = pgrp * wb;
            rank[w * 2] = __hip_atomic_fetch_add(lhist + ea, 1, __ATOMIC_RELAXED, __HIP_MEMORY_SCOPE_WORKGROUP);
            rank[w * 2 + 1] = __hip_atomic_fetch_add(lhist + eb, 1, __ATOMIC_RELAXED, __HIP_MEMORY_SCOPE_WORKGROUP);
        }
#pragma unroll
        for (int j = 0; j < 4; ++j) { hb_[j] = hn_[j]; mx_[j] = mn_[j]; }
    }
    __syncthreads();
    if (TID < NEXP) hist[BID * NEXP + TID] = lhist[TID];
}
__device__ void moe_tables(int WV, const int* hist, int* lds_pstart, int* lds_tile_exp) {
    const int TID = o_tid(WV), BID = o_bid();
    int* tot = lds_pstart + 384; int* part = lds_pstart + 416; int* base = lds_pstart + 448;
    if (TID < 64) tot[TID] = 0;
    __syncthreads();
    const int nent = gridDim.x * NEXP;
    int tl = 0, pl = 0;
    for (int i0 = TID; i0 < nent; i0 += 16 * NTHREADS) {
        int vv_[16];
#pragma unroll
        for (int k = 0; k < 16; ++k) { const int i = i0 + k * NTHREADS; vv_[k] = (i < nent) ? __hip_atomic_load(hist + i, __ATOMIC_RELAXED, __HIP_MEMORY_SCOPE_AGENT) : 0; }
#pragma unroll
        for (int k = 0; k < 16; ++k) { const int i = i0 + k * NTHREADS; tl += vv_[k]; if ((i >> 5) < BID) pl += vv_[k]; }
    }
    __hip_atomic_fetch_add(tot + (TID & 31), tl, __ATOMIC_RELAXED, __HIP_MEMORY_SCOPE_WORKGROUP);
    __hip_atomic_fetch_add(part + (TID & 31), pl, __ATOMIC_RELAXED, __HIP_MEMORY_SCOPE_WORKGROUP);
    __syncthreads();
    if (TID == 0) {
        int acc = 0;
#pragma unroll 1
        for (int e = 0; e < NEXP; ++e) { lds_pstart[e] = acc; base[e] = acc + part[e]; const int nt = (tot[e] + 255) >> 8;
#pragma unroll 1
            for (int t = 0; t < nt; ++t) lds_tile_exp[(acc >> 8) + t] = e; acc += nt * 256; }
#pragma unroll 1
        for (int t = acc >> 8; t < NTILES; ++t) lds_tile_exp[t] = -1;
        lds_pstart[32] = acc >> 8;
    }
    __syncthreads();
}
__device__ void moe_scatter_phase(int WV, const int* expert, const int* rank, const int* lds_pstart, int* slot_tok, int* dest) {
    const int TID = o_tid(WV), BID = o_bid();
    const int* base = lds_pstart + 448;
    const int ngw = gridDim.x * NWAVES;
    for (int a = TID; a < 2 * NWAVES * ((T_TOK + ngw - 1) / ngw); a += NTHREADS) {
        const int r = a >> 1, k = a & 1;
        const long w = (long)(BID * NWAVES + (r & 7)) + (long)ngw * (r >> 3);
        if (w < T_TOK) { const long i = w * 2 + k; const int s = base[expert[i]] + rank[i]; dest[i] = s; slot_tok[s] = (int)w; }
    }
}
__device__ void moe_combine_ln_phase(int WV, float* h, bf16_t* xb, const bf16_t* ys, const int* dest, const float* gate, const float* g, const float* bta, bool write_xb) {
    const int TID = o_tid(WV), BID = o_bid();
    const int lane = TID & 63, gw = BID * NWAVES + (TID >> 6), ngw = gridDim.x * NWAVES;
    f32x4 gg[4], bb[4];
#pragma unroll
    for (int j = 0; j < 4; ++j) { gg[j] = ((const f32x4*)g)[lane + 64 * j]; bb[j] = ((const f32x4*)bta)[lane + 64 * j]; }
    if (ngw * 16 != T_TOK) {
        long w = gw;
        int d0n = 0, d1n = 0; float g0n = 0.f, g1n = 0.f;
        u32x2 hv[4]; u32x2 ya[4], yb[4]; float g0 = 0.f, g1 = 0.f;
        if (w < T_TOK) { const int d0 = dest[w * 2], d1 = dest[w * 2 + 1]; g0 = gate[w * 2]; g1 = gate[w * 2 + 1];
    #pragma unroll
            for (int j = 0; j < 4; ++j) { hv[j] = ((const u32x2*)(xb + w * DM))[lane + 64 * j]; ya[j] = ((const u32x2*)(ys + (long)d0 * DM))[lane + 64 * j]; yb[j] = ((const u32x2*)(ys + (long)d1 * DM))[lane + 64 * j]; } }
        if (w + ngw < T_TOK) { d0n = dest[(w + ngw) * 2]; d1n = dest[(w + ngw) * 2 + 1]; g0n = gate[(w + ngw) * 2]; g1n = gate[(w + ngw) * 2 + 1]; }
        for (; w < T_TOK; w += ngw) {
            u32x2 hn[4]; u32x2 yan[4], ybn[4]; const float g0c = g0n, g1c = g1n;
            const long wn = w + ngw, wnn = w + 2 * (long)ngw;
            if (wn < T_TOK) {
    #pragma unroll
                for (int j = 0; j < 4; ++j) { hn[j] = ((const u32x2*)(xb + wn * DM))[lane + 64 * j]; yan[j] = ((const u32x2*)(ys + (long)d0n * DM))[lane + 64 * j]; ybn[j] = ((const u32x2*)(ys + (long)d1n * DM))[lane + 64 * j]; } }
            if (wnn < T_TOK) { d0n = dest[wnn * 2]; d1n = dest[wnn * 2 + 1]; g0n = gate[wnn * 2]; g1n = gate[wnn * 2 + 1]; }
            __builtin_amdgcn_sched_barrier(0);
            f32x4 v[4]; float s = 0.f;
    #pragma unroll
            for (int j = 0; j < 4; ++j) {
                v[j][0] = ALPHA * __uint_as_float(hv[j].x << 16) + g0 * __uint_as_float(ya[j].x << 16) + g1 * __uint_as_float(yb[j].x << 16);
                v[j][1] = ALPHA * __uint_as_float(hv[j].x & 0xffff0000u) + g0 * __uint_as_float(ya[j].x & 0xffff0000u) + g1 * __uint_as_float(yb[j].x & 0xffff0000u);
                v[j][2] = ALPHA * __uint_as_float(hv[j].y << 16) + g0 * __uint_as_float(ya[j].y << 16) + g1 * __uint_as_float(yb[j].y << 16);
                v[j][3] = ALPHA * __uint_as_float(hv[j].y & 0xffff0000u) + g0 * __uint_as_float(ya[j].y & 0xffff0000u) + g1 * __uint_as_float(yb[j].y & 0xffff0000u);
                s += (v[j][0] + v[j][1]) + (v[j][2] + v[j][3]); }
            const float mu = wave_sum(s) * (1.0f / 1024.0f);
            float qq = 0.f;
    #pragma unroll
            for (int j = 0; j < 4; ++j) { const f32x4 d = v[j] - mu; qq += (d[0] * d[0] + d[1] * d[1]) + (d[2] * d[2] + d[3] * d[3]); }
            const float r = rsqrtf(wave_sum(qq) * (1.0f / 1024.0f) + 1e-5f);
    #pragma unroll
            for (int j = 0; j < 4; ++j) { const f32x4 o = (v[j] - mu) * r * gg[j] + bb[j]; if (!write_xb) ((f32x4*)(h + w * DM))[lane + 64 * j] = o;
                if (write_xb) { u32x2 ob; ob.x = pg8::cvt_pk_bf16(o[0], o[1]); ob.y = pg8::cvt_pk_bf16(o[2], o[3]); ((u32x2*)(xb + w * DM))[lane + 64 * j] = ob; } }
    #pragma unroll
            for (int j = 0; j < 4; ++j) { hv[j] = hn[j]; ya[j] = yan[j]; yb[j] = ybn[j]; }
            g0 = g0c; g1 = g1c;
        }
        return;
    }
    int dv0 = 0, dv1 = 0; float gv0 = 0.f, gv1 = 0.f;
    { const long wr = gw + (long)(lane & 15) * ngw; if (wr < T_TOK) { dv0 = dest[wr * 2]; dv1 = dest[wr * 2 + 1]; gv0 = gate[wr * 2]; gv1 = gate[wr * 2 + 1]; } }
    u32x2 hv[2][4]; u32x2 ya[2][4], yb[2][4];
#define CMB_LOAD(HV, YA, YB, i_) do { _Pragma("unroll") for (int q_ = 0; q_ < 2; ++q_) { const int ii_ = (i_) + 8 * q_; const long wq_ = gw + (long)ii_ * ngw; \
        const int d0_ = __builtin_amdgcn_readlane(dv0, ii_), d1_ = __builtin_amdgcn_readlane(dv1, ii_); \
        _Pragma("unroll") for (int j = 0; j < 4; ++j) { HV[q_][j] = ((const u32x2*)(xb + wq_ * DM))[lane + 64 * j]; YA[q_][j] = ((const u32x2*)(ys + (long)d0_ * DM))[lane + 64 * j]; YB[q_][j] = ((const u32x2*)(ys + (long)d1_ * DM))[lane + 64 * j]; } } } while (0)
    CMB_LOAD(hv, ya, yb, 0);
#pragma unroll 1
    for (int i = 0; i < 8; ++i) {
        u32x2 hn[2][4]; u32x2 yan[2][4], ybn[2][4];
        if (i < 7) CMB_LOAD(hn, yan, ybn, i + 1);
        __builtin_amdgcn_sched_barrier(0);
#pragma unroll
        for (int q = 0; q < 2; ++q) {
            const int ii = i + 8 * q; const long w = gw + (long)ii * ngw;
            const float g0 = __int_as_float(__builtin_amdgcn_readlane(__float_as_int(gv0), ii)), g1 = __int_as_float(__builtin_amdgcn_readlane(__float_as_int(gv1), ii));
            f32x4 v[4]; float s = 0.f;
#pragma unroll
            for (int j = 0; j < 4; ++j) {
                v[j][0] = ALPHA * __uint_as_float(hv[q][j].x << 16) + g0 * __uint_as_float(ya[q][j].x << 16) + g1 * __uint_as_float(yb[q][j].x << 16);
                v[j][1] = ALPHA * __uint_as_float(hv[q][j].x & 0xffff0000u) + g0 * __uint_as_float(ya[q][j].x & 0xffff0000u) + g1 * __uint_as_float(yb[q][j].x & 0xffff0000u);
                v[j][2] = ALPHA * __uint_as_float(hv[q][j].y << 16) + g0 * __uint_as_float(ya[q][j].y << 16) + g1 * __uint_as_float(yb[q][j].y << 16);
                v[j][3] = ALPHA * __uint_as_float(hv[q][j].y & 0xffff0000u) + g0 * __uint_as_float(ya[q][j].y & 0xffff0000u) + g1 * __uint_as_float(yb[q][j].y & 0xffff0000u);
                s += (v[j][0] + v[j][1]) + (v[j][2] + v[j][3]); }
            const float mu = wave_sum(s) * (1.0f / 1024.0f);
            float qq = 0.f;
#pragma unroll
            for (int j = 0; j < 4; ++j) { const f32x4 d = v[j] - mu; qq += (d[0] * d[0] + d[1] * d[1]) + (d[2] * d[2] + d[3] * d[3]); }
            const float r = rsqrtf(wave_sum(qq) * (1.0f / 1024.0f) + 1e-5f);
#pragma unroll
            for (int j = 0; j < 4; ++j) { const f32x4 o = (v[j] - mu) * r * gg[j] + bb[j]; if (!write_xb) ((f32x4*)(h + w * DM))[lane + 64 * j] = o;
                if (write_xb) { u32x2 ob; ob.x = pg8::cvt_pk_bf16(o[0], o[1]); ob.y = pg8::cvt_pk_bf16(o[2], o[3]); ((u32x2*)(xb + w * DM))[lane + 64 * j] = ob; } }
        }
#pragma unroll
        for (int q = 0; q < 2; ++q)
#pragma unroll
            for (int j = 0; j < 4; ++j) { hv[q][j] = hn[q][j]; ya[q][j] = yan[q][j]; yb[q][j] = ybn[q][j]; }
    }
#undef CMB_LOAD
}

#define XB_TMO      128
#define XB_XCNT(j)  (256  + 64 * (j))
#define XB_XSUB(j)  (1280 + 64 * (j))
#define XB_XGEN(j)  (2304 + 64 * (j))
#define XB_TOP      3328
#define XB_TOPGEN   3392
#define XCD_BAR_WORDS 3456
#define XB_SPIN_CAP (1u << 22)
__device__ __forceinline__ unsigned xb_ld(unsigned* p)              { return __hip_atomic_load(p, __ATOMIC_RELAXED, __HIP_MEMORY_SCOPE_AGENT); }
__device__ __forceinline__ unsigned xb_add(unsigned* p, unsigned v) { return __hip_atomic_fetch_add(p, v, __ATOMIC_RELAXED, __HIP_MEMORY_SCOPE_AGENT); }
__device__ __forceinline__ unsigned xb_xcc_id() { return (unsigned)__builtin_amdgcn_s_getreg((3 << 11) | 20) & 0xFu; }
#define XB_SPIN(cond, bar) do { unsigned _sp = 0; while (cond) { __builtin_amdgcn_s_sleep(1); \
    if ((++_sp & 255u) == 0u) { if (xb_ld(&(bar)[XB_TMO])) break; if (_sp > XB_SPIN_CAP) { atomicAdd(&(bar)[XB_TMO], 1u); break; } } } } while (0)
struct XcdBarrier { unsigned* bar; unsigned x; volatile LAS unsigned* st; };
__device__ __forceinline__ XcdBarrier xcd_barrier_post(unsigned* bar, volatile LAS unsigned* st, bool leader) {
    XcdBarrier b; b.bar = bar; b.x = xb_xcc_id(); b.st = st;
    if (leader) st[2] = xb_add(&bar[XB_XCNT(b.x)], 1u);
    return b;
}
__device__ __forceinline__ void xcd_barrier_complete(unsigned* bar, unsigned x, unsigned& nloc, unsigned& nx, unsigned& before) {
    const unsigned G = gridDim.x * gridDim.y * gridDim.z;
    unsigned sum, cnt, mine, bef, sp = 0u;
    for (;;) {
        sum = 0u; cnt = 0u; mine = 0u; bef = 0u;
#pragma unroll
        for (unsigned j = 0; j < 16; ++j) { const unsigned c = xb_ld(&bar[XB_XCNT(j)]); sum += c; cnt += (c > 0u) ? 1u : 0u; mine = (j == x) ? c : mine; bef += (j < x) ? c : 0u; }
        if (sum == G) break;
        __builtin_amdgcn_s_sleep(1);
        if ((++sp & 255u) == 0u) { if (xb_ld(&bar[XB_TMO])) break; if (sp > XB_SPIN_CAP) { atomicAdd(&bar[XB_TMO], 1u); break; } }
    }
    nloc = mine > 0u ? mine : 1u; nx = cnt > 0u ? cnt : 1u; before = bef;
}
__device__ __forceinline__ void xcd_barrier(const XcdBarrier& b, bool leader) {
    asm volatile("s_waitcnt vmcnt(0)" ::: "memory");
    __syncthreads();
    if (leader) {
        unsigned* bar = b.bar;
        __builtin_amdgcn_s_waitcnt(0);
        unsigned nloc = b.st[0], nx = b.st[1];
        if (nloc == 0u) { unsigned bef; xcd_barrier_complete(bar, b.x, nloc, nx, bef); b.st[0] = nloc; b.st[1] = nx; b.st[3] = bef; }
        const unsigned old = xb_add(&bar[XB_XSUB(b.x)], 1u);
        const unsigned gen = old / nloc;
        if (old + 1u == (gen + 1u) * nloc) {
            __builtin_amdgcn_fence(__ATOMIC_RELEASE, "agent");
            asm volatile("s_waitcnt vmcnt(0)" ::: "memory");
            const unsigned og = xb_add(&bar[XB_TOP], 1u);
            const unsigned tg = og / nx;
            if (og + 1u == (tg + 1u) * nx) xb_add(&bar[XB_TOPGEN], 1u);
            else XB_SPIN(xb_ld(&bar[XB_TOPGEN]) == tg, bar);
            __builtin_amdgcn_fence(__ATOMIC_ACQUIRE, "agent");
            xb_add(&bar[XB_XGEN(b.x)], 1u);
            asm volatile("s_waitcnt vmcnt(0)" ::: "memory");
        } else {
            XB_SPIN(xb_ld(&bar[XB_XGEN(b.x)]) == gen, bar);
            __builtin_amdgcn_fence(__ATOMIC_ACQUIRE, "agent");
            asm volatile("s_waitcnt vmcnt(0)" ::: "memory");
        }
    }
    __syncthreads();
}

__global__ void __launch_bounds__(NTHREADS, 2) fwd_megakernel(Params p) {
    extern __shared__ __attribute__((aligned(16))) unsigned char lds_raw[];
    cg::grid_group grid = cg::this_grid();
    const int WV = __builtin_amdgcn_readfirstlane(threadIdx.x >> 6);
    float* lds = (float*)lds_raw;
    LAS unsigned char* ldsl = (LAS unsigned char*)lds_raw;
    int* lds_pstart = (int*)(lds_raw + LDS_TAB_OFF);
    int* lds_tile_exp = lds_pstart + 64;
    int* lds_tok = lds_pstart + 512;
    volatile LAS unsigned* xst = (volatile LAS unsigned*)(lds_raw + LDS_BYTES - 16);
    const bool xlead = (o_tid(WV) == 0);
    if (xlead) { xst[0] = 0u; xst[1] = 0u; }
    __syncthreads();
    const XcdBarrier xb = xcd_barrier_post(p.bar, xst, xlead);
    rope_table_phase(WV, p.rope_tab, p.lbtab, p.lb_logits);
    convert_dense_phase(WV, p, ldsl);
    grid.sync();
#pragma unroll 1
    for (int l = 0; l < 2; ++l) {
        { pg8::Gemm g{p.xb, p.wt_in + (size_t)l * INC * DM, DM, 0, nullptr}; pg8::StaticOrder S; S.init(T_TOK, INC, gridDim.x, o_bid());
          pg8::EpiInProj E{p.proj, p.rope_tab, p.lbtab + l * 1024, p.norm_g + l * 512};
          pg8::gemm_phase<pg8::EpiInProj, pg8::StaticOrder, false>(WV, ldsl, g, S, E, nullptr, (int)((2u * xb.x) & 15u)); }
        xcd_barrier(xb, o_tid(WV) == 0);
        hgrn2_phase(WV, p, l, ldsl);
        attn_phase(WV, p, l, p.proj, p.y, ldsl, p.counts + 128 + l);
        xcd_barrier(xb, o_tid(WV) == 0);
        { pg8::Gemm g{p.y, p.wt_out + (size_t)l * DM * DM, DM, 0, nullptr}; pg8::StaticOrder S; S.init(T_TOK, DM, gridDim.x, o_bid());
          pg8::EpiBf16Plain E{p.mix, DM};
          pg8::gemm_phase<pg8::EpiBf16Plain, pg8::StaticOrder, false>(WV, ldsl, g, S, E, nullptr, (int)((2u * xb.x) & 15u)); }
        xcd_barrier(xb, o_tid(WV) == 0);
        ln_router_phase(WV, p.mix, p.xb, p.ln1_g + l * DM, p.ln1_b + l * DM, p.rw1 + l * DM * 4, p.rb1 + l * 4, p.rw2 + l * DM * 32, p.rb2 + l * 32, p.expert, p.gate, p.rank, p.hist, p.slot_tok, (LAS float*)ldsl);
        xcd_barrier(xb, o_tid(WV) == 0);
        moe_tables(WV, p.hist, lds_pstart, lds_tile_exp);
        moe_scatter_phase(WV, p.expert, p.rank, lds_pstart, p.slot_tok, p.dest);
        xcd_barrier(xb, o_tid(WV) == 0);
        { const int xn = (int)xst[0], xr = (int)xst[2], xbef = (int)xst[3];
          { pg8::Gemm g{p.xb, p.wt_gu, DM, (long)DM * DM, p.slot_tok}; pg8::MoeOrderPub S; S.init(lds_pstart[32], 4, xn, xr, xbef, gridDim.x, lds_tile_exp); S.cnt = p.mcnt + l * NTILES;
            pg8::EpiGateUp E{p.hid};
            { const int t0 = o_tid(WV); pg8::Unit u; for (int i = 0; S.next(i, u); ++i) { if (t0 < 256) lds_tok[i * 256 + t0] = p.slot_tok[u.pm * 256 + t0]; } }
            __syncthreads();
            pg8::gemm_phase<pg8::EpiGateUp, pg8::MoeOrderPub, true>(WV, ldsl, g, S, E, (const LAS int*)lds_tok); }
          { pg8::Gemm g{p.hid, p.wt_dn, DEXP, (long)DM * DEXP, nullptr}; pg8::MoeOrderWait S; S.init(lds_pstart[32], 4, xn, (xr + xn / 2) % xn, xbef, gridDim.x, lds_tile_exp); S.cnt = p.mcnt + l * NTILES;
            S.pollw = (LAS int*)(lds_raw + LDS_BYTES - 32);
            pg8::EpiBf16Plain E{p.ys, DM};
            pg8::gemm_phase<pg8::EpiBf16Plain, pg8::MoeOrderWait, false>(WV, ldsl, g, S, E, nullptr); } }
        xcd_barrier(xb, o_tid(WV) == 0);
        moe_combine_ln_phase(WV, p.hbuf, p.xb, p.ys, p.dest, p.gate, p.ln2_g + l * DM, p.ln2_b + l * DM, l == 0);
        if (l == 0) xcd_barrier(xb, o_tid(WV) == 0);
    }
}

extern "C" void kernel_launch(void* const* d_in, const int* in_sizes, int n_in, void* d_out, int out_size, void* d_ws, size_t ws_size, hipStream_t stream) {
    static int grid_blocks = 0;
    if (!grid_blocks) {
        int dev = 0, cus = 0, per_cu = 0;
        (void)hipGetDevice(&dev);
        (void)hipDeviceGetAttribute(&cus, hipDeviceAttributeMultiprocessorCount, dev);
        (void)hipFuncSetAttribute((const void*)fwd_megakernel, hipFuncAttributeMaxDynamicSharedMemorySize, LDS_BYTES);
        (void)hipOccupancyMaxActiveBlocksPerMultiprocessor(&per_cu, (const void*)fwd_megakernel, NTHREADS, LDS_BYTES);
        if (per_cu < 1) { fprintf(stderr, "occupancy query says %d blocks/CU\n", per_cu); per_cu = 1; }
        grid_blocks = cus;
        fprintf(stderr, "megakernel: cus=%d per_cu=%d grid=%d\n", cus, per_cu, grid_blocks);
    }
    Params p{};
    p.x = (const float*)d_in[0]; p.w_in = (const float*)d_in[1]; p.lb_logits = (const float*)d_in[2]; p.norm_g = (const float*)d_in[3]; p.w_out = (const float*)d_in[4];
    p.ln1_g = (const float*)d_in[5]; p.ln1_b = (const float*)d_in[6]; p.rw1 = (const float*)d_in[7]; p.rb1 = (const float*)d_in[8]; p.rw2 = (const float*)d_in[9]; p.rb2 = (const float*)d_in[10];
    p.wg = (const float*)d_in[11]; p.wu = (const float*)d_in[12]; p.wd = (const float*)d_in[13]; p.ln2_g = (const float*)d_in[14]; p.ln2_b = (const float*)d_in[15];
    p.hbuf = (float*)d_out;
    char* ws = (char*)d_ws;
    size_t off = 0;
    auto take = [&](size_t bytes) { char* q = ws + off; off += (bytes + 255) & ~(size_t)255; return q; };
    p.counts = (int*)take(4096);
    p.bar = (unsigned*)take((size_t)XCD_BAR_WORDS * 4);
    p.hist = (int*)take((size_t)1024 * NEXP * 4);
    p.rope_tab = (float2*)take((size_t)SEQ * 8 * 8);
    p.lbtab = (float*)take((size_t)2 * 2 * 512 * 4);
    p.expert = (int*)take((size_t)T_TOK * 2 * 4);
    p.rank = (int*)take((size_t)T_TOK * 2 * 4);
    p.gate = (float*)take((size_t)T_TOK * 2 * 4);
    p.dest = (int*)take((size_t)T_TOK * 2 * 4);
    p.slot_tok = (int*)take((size_t)PSLOTS * 4);
    p.wt_in = (bf16_t*)take((size_t)2 * INC * DM * 2);
    p.wt_out = (bf16_t*)take((size_t)2 * DM * DM * 2);
    p.xb = (bf16_t*)take((size_t)T_TOK * DM * 2);
    char* big = take(0);
    p.proj = (bf16_t*)big;
    p.y = (bf16_t*)(big + (size_t)T_TOK * INC * 2);
    p.o_f = (float*)(big + (size_t)T_TOK * INC * 2 + (size_t)T_TOK * DM * 2);
    p.o_b = p.o_f + (size_t)T_TOK * 512;
    char* moe = big + (size_t)T_TOK * INC * 2 + (size_t)T_TOK * DM * 2;
    p.wt_gu = (bf16_t*)moe;
    p.wt_dn = (bf16_t*)(moe + (size_t)NEXP * DM * DM * 2);
    p.ob = (bf16_t*)(moe + (size_t)NEXP * DM * DM * 2 + (size_t)NEXP * DM * DEXP * 2);
    p.hdone = p.counts;
    p.mcnt = p.counts + 256;
    p.hid = (bf16_t*)big;
    p.mix = (bf16_t*)big;
    p.ys = (bf16_t*)(big + (size_t)PSLOTS * DEXP * 2);
    if (off + (size_t)T_TOK * INC * 2 + (size_t)T_TOK * DM * 2 + (size_t)T_TOK * 512 * 8 > ws_size) fprintf(stderr, "workspace too small: %zu\n", ws_size);
    (void)hipMemsetAsync(p.counts, 0, 4096 + (((size_t)XCD_BAR_WORDS * 4 + 255) & ~(size_t)255), stream);
    void* args[] = {&p};
    hipError_t e = hipLaunchCooperativeKernel((const void*)fwd_megakernel, dim3(grid_blocks), dim3(NTHREADS), args, LDS_BYTES, stream);
    if (e != hipSuccess) fprintf(stderr, "cooperative launch failed: %s (grid %d)\n", hipGetErrorString(e), grid_blocks);
}
```

```cpp
#include <hip/hip_runtime.h>
#include <hip/hip_cooperative_groups.h>
#include <stdint.h>
#include <stdio.h>
namespace cg = cooperative_groups;

#define T_TOK 32768
#define DM 1024
#define SEQ 2048
#define NB 16
#define INC 4096
#define NEXP 32
#define DEXP 512
#define PSLOTS ((T_TOK * 2 / 256 + NEXP) * 256)
#define NTILES (PSLOTS / 256)
#define ALPHA 1.41421356237309515f
#define ATT_VPRE 5
#define NTHREADS 512
#define NWAVES 8
#define LDS_BYTES (152 * 1024)
#define LDS_TAB_OFF (144 * 1024)

typedef unsigned short bf16_t;
__device__ __forceinline__ float bf2f(bf16_t b) { return __uint_as_float(((unsigned)b) << 16); }
__device__ __forceinline__ bf16_t f2bf(float f) { unsigned u = __float_as_uint(f); u += 0x7FFFu + ((u >> 16) & 1u); return (bf16_t)(u >> 16); }
template <int CTRL> __device__ __forceinline__ float dppf(float v) { return __int_as_float(__builtin_amdgcn_update_dpp(0, __float_as_int(v), CTRL, 0xf, 0xf, true)); }
__device__ __forceinline__ float wave_sum(float v) {
    v += dppf<0xB1>(v);
    v += dppf<0x4E>(v);
    v += dppf<0x141>(v);
    v += dppf<0x140>(v);
    const int vi = __float_as_int(v);
    return (__int_as_float(__builtin_amdgcn_readlane(vi, 0)) + __int_as_float(__builtin_amdgcn_readlane(vi, 16))) + (__int_as_float(__builtin_amdgcn_readlane(vi, 32)) + __int_as_float(__builtin_amdgcn_readlane(vi, 48)));
}
__device__ __forceinline__ int o_tid(int wv) { int l; asm volatile("v_mbcnt_lo_u32_b32 %0, -1, 0\n\tv_mbcnt_hi_u32_b32 %0, -1, %0" : "=v"(l)); return wv * 64 + l; }
__device__ __forceinline__ int o_bid() { int b = blockIdx.x; asm volatile("" : "+s"(b)); return b; }
template <int N> __device__ __forceinline__ void wave_sum_n(float (&s)[N]) {
#pragma unroll
    for (int i = 0; i < N; ++i) s[i] = wave_sum(s[i]);
}
__device__ __forceinline__ float siluf(float x) { return x * __builtin_amdgcn_rcpf(1.0f + __expf(-x)); }

struct Params {
    const float* x; const float* w_in; const float* lb_logits; const float* norm_g; const float* w_out; const float* ln1_g; const float* ln1_b;
    const float* rw1; const float* rb1; const float* rw2; const float* rb2; const float* wg; const float* wu; const float* wd; const float* ln2_g; const float* ln2_b;
    float* hbuf;
    int* counts;
    int* hist;
    unsigned* bar;
    float2* rope_tab;
    float* lbtab;
    int* expert; int* rank; float* gate; int* dest; int* slot_tok;
    bf16_t* proj; bf16_t* y; float* o_f; float* o_b; bf16_t* hid; bf16_t* ys;
    bf16_t* xb;
    bf16_t* mix;
    bf16_t* ob;
    int* hdone;
    int* mcnt;
    bf16_t* wt_in;
    bf16_t* wt_out;
    bf16_t* wt_gu;
    bf16_t* wt_dn;
};

#define LAS __attribute__((address_space(3)))
typedef short bf16x8 __attribute__((ext_vector_type(8)));
typedef float f32x4 __attribute__((ext_vector_type(4)));
typedef unsigned u32x4 __attribute__((ext_vector_type(4)));
typedef unsigned u32x2 __attribute__((ext_vector_type(2)));
namespace pg8 {
constexpr int BM = 256, BK = 64, HALF = 128, HTB = HALF * BK * 2, STAGE_BYTES = 8 * HTB, NXCD = 8, WGM = 8;
__device__ __forceinline__ int lds_byte(int r, int c) { const int st = (r >> 4) * 2 + (c >> 5), rr = r & 15, cc = c & 31, ob = rr * 64 + cc * 2; return st * 1024 + (ob ^ (((ob >> 9) & 1) << 5)); }
__device__ __forceinline__ void stage_rc(int b, int& R, int& C) { const int st = b / 1024, sb = b % 1024, swz = sb ^ (((sb >> 9) & 1) << 5); R = (st >> 1) * 16 + swz / 64; C = (st & 1) * 32 + (swz % 64) / 2; }
__device__ __forceinline__ int perm32(int rho) { const int n = rho >> 4, i = rho & 15; return 8 * (i >> 2) + 4 * n + (i & 3); }
__device__ __forceinline__ unsigned cvt_pk_bf16(float lo, float hi) { unsigned r; asm volatile("v_cvt_pk_bf16_f32 %0, %1, %2" : "=v"(r) : "v"(lo), "v"(hi)); return r; }

struct Unit { int pm, pn, e; };
struct Gemm { const bf16_t* A; const bf16_t* Bt; int K; long bstride; const int* rowidx; };

struct StaticOrder {
    int nM, nN, nwg, G, c;
    __device__ void init(int M, int N, int G_, int c_) { nM = M / BM; nN = N / BM; nwg = nM * nN; G = G_; c = c_; }
    __device__ bool next(int i, Unit& u) const {
        const long L = (long)i * G + c; if (L >= nwg) return false;
        int wgid = (int)L; { const int q = nwg / NXCD, r = nwg % NXCD, xcd = wgid % NXCD, off = wgid / NXCD; wgid = (xcd < r ? xcd * (q + 1) : r * (q + 1) + (xcd - r) * q) + off; }
        const int nig = WGM * nN, gid = wgid / nig, fm = gid * WGM, gsz = (nM - fm) < WGM ? (nM - fm) : WGM;
        u.pm = fm + ((wgid % nig) % gsz); u.pn = (wgid % nig) / gsz; u.e = 0; return true;
    }
    static constexpr bool WAITS = false;
    __device__ __forceinline__ void a_ready(const Unit&, int, int) const {}
    __device__ __forceinline__ void done(const Unit&, int) const {}
};
struct MoeOrder {
    static constexpr bool WAITS = false;
    int nN, nwg, G, c, u0; const int* tile_exp;
    __device__ void init(int nact, int nN_, int nloc, int rank, int before, int Gtot, const int* te) {
        const int t0 = (int)((long)nact * before / Gtot), t1 = (int)((long)nact * (before + nloc) / Gtot);
        nN = nN_; u0 = t0 * nN_; nwg = (t1 - t0) * nN_; G = nloc; c = rank; tile_exp = te; }
    __device__ bool next(int i, Unit& u) const {
        const long L = (long)i * G + c; if (L >= nwg) return false;
        const int wgid = u0 + (int)L;
        u.pm = wgid / nN; u.pn = wgid % nN; u.e = tile_exp[u.pm]; return true;
    }
    __device__ __forceinline__ void a_ready(const Unit&, int, int) const {}
    __device__ __forceinline__ void done(const Unit&, int) const {}
};
struct MoeOrderPub : MoeOrder {
    int* cnt;
    __device__ __forceinline__ void done(const Unit& u, int lane) const {
        asm volatile("s_waitcnt vmcnt(0)" ::: "memory");
        if (lane == 0) __hip_atomic_fetch_add(cnt + u.pm, 1, __ATOMIC_RELAXED, __HIP_MEMORY_SCOPE_AGENT);
    }
};
struct MoeOrderWait : MoeOrder {
    static constexpr bool WAITS = true;
    const int* cnt; LAS int* pollw;
    __device__ __forceinline__ void spin(const Unit& u) const {
        unsigned spins = 0;
        while (__builtin_amdgcn_readfirstlane(__hip_atomic_load(cnt + u.pm, __ATOMIC_RELAXED, __HIP_MEMORY_SCOPE_AGENT)) < 32) { __builtin_amdgcn_s_sleep(2); if (++spins > (1u << 22)) break; }
    }
    __device__ __forceinline__ void a_ready(const Unit& u, int wid, int lane) const {
        if (wid == 0) spin(u);
        asm volatile("" ::: "memory"); __builtin_amdgcn_s_barrier(); asm volatile("" ::: "memory");
    }
    __device__ __forceinline__ void poll_issue(const Unit& u, int wid, int lane) const {
        if (wid == 0 && lane == 0) __builtin_amdgcn_global_load_lds((const unsigned*)(cnt + u.pm), (LAS unsigned*)pollw, 4, 0, 16);
    }
    __device__ __forceinline__ void poll_check(const Unit& u, int wid, int lane) const {
        if (wid == 0) { const int v = __builtin_amdgcn_readfirstlane(*(volatile LAS int*)pollw); if (v < 32) spin(u); }
    }
};

struct EpiInProj {
    static constexpr bool PERM = true;
    bf16_t* O; const float2* rope; const float* lbl; const float* ngl;
    __device__ __forceinline__ void operator()(const f32x4 (&acc)[2][2][4][2], const Unit& u, int wr, int wc, int fr, int fq) const {
        const int region = u.pn >> 1;
        const int row0 = u.pm * BM + wr * 64 + fr, col0 = u.pn * BM + wc * 32 + 8 * fq;
        const bool do_rope = (region == 5 || region == 6) && ((wc & 1) == 0);
        const float scale = (region == 0) ? 0.08838834764831845f : ((region == 5) ? 0.125f * 1.4426950408889634f : 1.0f);
#pragma unroll
        for (int ai = 0; ai < 2; ++ai)
#pragma unroll
            for (int m = 0; m < 4; ++m) {
                const int row = row0 + ai * HALF + m * 16;
                bf16_t* rowp = O + (size_t)row * INC + col0;
                f32x4 cs0 = {1.f, 0.f, 1.f, 0.f}, cs1 = cs0, cs2 = cs0, cs3 = cs0;
                if (do_rope) { const f32x4* t = (const f32x4*)(rope + (size_t)(row & (SEQ - 1)) * 8); cs0 = t[0]; cs1 = t[1]; cs2 = t[2]; cs3 = t[3]; }
#pragma unroll
                for (int bj = 0; bj < 2; ++bj) {
                    f32x4 v0 = acc[ai][bj][m][0] * scale, v1 = acc[ai][bj][m][1] * scale;
                    if (region == 4) {
                        const float* np_ = ngl + ((col0 + bj * HALF) & 511);
                        const f32x4 n0 = *(const f32x4*)np_, n1 = *(const f32x4*)(np_ + 4);
#pragma unroll
                        for (int j = 0; j < 4; ++j) { v0[j] = siluf(v0[j]) * n0[j]; v1[j] = siluf(v1[j]) * n1[j]; }
                    }
                    if (region == 1 || region == 2) {
                        const float* lp = lbl + (region - 1) * 512 + ((col0 + bj * HALF) & 511);
                        const f32x4 l0 = *(const f32x4*)lp, l1 = *(const f32x4*)(lp + 4);
#pragma unroll
                        for (int j = 0; j < 4; ++j) {
                            const float a0 = fminf(fmaxf(v0[j], -30.f), 30.f), a1 = fminf(fmaxf(v1[j], -30.f), 30.f);
                            v0[j] = l0[j] + (1.0f - l0[j]) * __builtin_amdgcn_rcpf(1.0f + __expf(-a0));
                            v1[j] = l1[j] + (1.0f - l1[j]) * __builtin_amdgcn_rcpf(1.0f + __expf(-a1)); }
                    }
                    if (do_rope) {
                        const float sgn = (fq == 0) ? -1.f : 1.f;
                        f32x4 o0, o1;
#pragma unroll
                        for (int j = 0; j < 4; ++j) { o0[j] = __shfl_xor(v0[j], 16); o1[j] = __shfl_xor(v1[j], 16); }
                        const float c[8] = {cs0[0], cs0[2], cs1[0], cs1[2], cs2[0], cs2[2], cs3[0], cs3[2]};
                        const float s[8] = {cs0[1], cs0[3], cs1[1], cs1[3], cs2[1], cs2[3], cs3[1], cs3[3]};
                        if (fq < 2) {
#pragma unroll
                            for (int j = 0; j < 4; ++j) { v0[j] = v0[j] * c[j] + sgn * o0[j] * s[j]; v1[j] = v1[j] * c[4 + j] + sgn * o1[j] * s[4 + j]; }
                        }
                    }
                    u32x4 w; w.x = cvt_pk_bf16(v0[0], v0[1]); w.y = cvt_pk_bf16(v0[2], v0[3]); w.z = cvt_pk_bf16(v1[0], v1[1]); w.w = cvt_pk_bf16(v1[2], v1[3]);
                    *(u32x4*)(rowp + bj * HALF) = w;
                }
            }
    }
};
struct EpiOutProj {
    static constexpr bool PERM = false;
    const float* H; float* Z;
    __device__ __forceinline__ void operator()(const f32x4 (&acc)[2][2][4][2], const Unit& u, int wr, int wc, int fr, int fq) const {
        const int row0 = u.pm * BM + wr * 64 + fr, col0 = u.pn * BM + wc * 32 + 4 * fq;
#pragma unroll
        for (int ai = 0; ai < 2; ++ai)
#pragma unroll
            for (int m = 0; m < 4; ++m) { const size_t off = (size_t)(row0 + ai * HALF + m * 16) * DM + col0;
#pragma unroll
                for (int bj = 0; bj < 2; ++bj)
#pragma unroll
                    for (int n = 0; n < 2; ++n) { const f32x4 hv = *(const f32x4*)(H + off + bj * HALF + n * 16); *(f32x4*)(Z + off + bj * HALF + n * 16) = hv * ALPHA + acc[ai][bj][m][n]; } }
    }
};
struct EpiGateUp {
    static constexpr bool PERM = true;
    bf16_t* O;
    __device__ __forceinline__ void operator()(const f32x4 (&acc)[2][2][4][2], const Unit& u, int wr, int wc, int fr, int fq) const {
        const int row0 = u.pm * BM + wr * 64 + fr, col0 = u.pn * 128 + wc * 16 + 4 * fq;
#pragma unroll
        for (int ai = 0; ai < 2; ++ai)
#pragma unroll
            for (int m = 0; m < 4; ++m) { bf16_t* rowp = O + (size_t)(row0 + ai * HALF + m * 16) * DEXP + col0;
#pragma unroll
                for (int bj = 0; bj < 2; ++bj) { const f32x4 v0 = acc[ai][bj][m][0], v1 = acc[ai][bj][m][1];
                    u32x2 w; w.x = cvt_pk_bf16(siluf(v0[0]) * v0[1], siluf(v0[2]) * v0[3]); w.y = cvt_pk_bf16(siluf(v1[0]) * v1[1], siluf(v1[2]) * v1[3]);
                    *(u32x2*)(rowp + bj * 64) = w; } }
    }
};
struct EpiBf16Plain {
    static constexpr bool PERM = true;
    bf16_t* O; int ldc;
    __device__ __forceinline__ void operator()(const f32x4 (&acc)[2][2][4][2], const Unit& u, int wr, int wc, int fr, int fq) const {
        const int row0 = u.pm * BM + wr * 64 + fr, col0 = u.pn * BM + wc * 32 + 8 * fq;
#pragma unroll
        for (int ai = 0; ai < 2; ++ai)
#pragma unroll
            for (int m = 0; m < 4; ++m) { bf16_t* rowp = O + (size_t)(row0 + ai * HALF + m * 16) * ldc + col0;
#pragma unroll
                for (int bj = 0; bj < 2; ++bj) { const f32x4 v0 = acc[ai][bj][m][0], v1 = acc[ai][bj][m][1];
                    u32x4 w; w.x = cvt_pk_bf16(v0[0], v0[1]); w.y = cvt_pk_bf16(v0[2], v0[3]); w.z = cvt_pk_bf16(v1[0], v1[1]); w.w = cvt_pk_bf16(v1[2], v1[3]);
                    *(u32x4*)(rowp + bj * HALF) = w; } }
    }
};

template <class Epi, class Sched, bool GATHER>
__device__ __forceinline__ void gemm_phase(int WV, LAS unsigned char* lds, const Gemm g, const Sched& S, const Epi& E, const LAS int* tokl, int krot = 0) {
    const int tid = o_tid(WV), wid = __builtin_amdgcn_readfirstlane(tid >> 6), lane = tid & 63, wr = wid >> 2, wc = wid & 3, fr = lane & 15, fq = lane >> 4;
    const int K = g.K, nt = K / BK;
    int RA[2]; unsigned voffA[2], voffB[2];
#pragma unroll
    for (int i = 0; i < 2; ++i) { int R, C; stage_rc(tid * 16 + i * 8192, R, C); const int Rb = Epi::PERM ? ((R & ~31) + perm32(R & 31)) : R;
        RA[i] = R; voffA[i] = GATHER ? (unsigned)C * 2u : (unsigned)(R * K + C) * 2u; voffB[i] = (unsigned)(Rb * K + C) * 2u; }
    const size_t kstep = (size_t)(BK * 2);
    const size_t hstep = (size_t)HALF * K * 2;
    const size_t tstep = 2 * hstep;
    const unsigned ldsw = (unsigned)wid * 1024u;
    const int aoff = lds_byte(wr * 64 + fr, fq * 8), boff = lds_byte(wc * 32 + fr, fq * 8);
#define PG8_SA(b, h) (((b) * 2 + (h)) * HTB)
#define PG8_SB(b, h) ((4 + (b) * 2 + (h)) * HTB)
#define PG8_STAGE(bufoff, gbase, voff) do { _Pragma("unroll") for (int _i = 0; _i < 2; ++_i) \
        __builtin_amdgcn_global_load_lds((const unsigned*)((const char*)(gbase) + (voff)[_i]), (LAS unsigned*)(lds + (bufoff) + ldsw + _i * 8192), 16, 0, 0); } while (0)
#define PG8_STAGE_A(bufoff, kp, h) do { if constexpr (GATHER) { PG8_STAGE(bufoff, kp, gA[h]); } else { PG8_STAGE(bufoff, (kp) + (h) * hstep, voffA); } } while (0)
#define PG8_GATHER_OFFS(ui_) do { if constexpr (GATHER) { _Pragma("unroll") for (int _h = 0; _h < 2; ++_h) _Pragma("unroll") for (int _i = 0; _i < 2; ++_i) { \
        int _row = tokl[(ui_) * BM + _h * HALF + RA[_i]]; _row = (_row >= T_TOK) ? 0 : _row; gA[_h][_i] = (unsigned)(_row * K) * 2u + voffA[_i]; } } } while (0)
#define PG8_LDA(dst, b, h) do { _Pragma("unroll") for (int m = 0; m < 4; ++m) _Pragma("unroll") for (int k = 0; k < 2; ++k) dst[m][k] = *(const LAS bf16x8*)(lds + PG8_SA(b, h) + aoff + m * 2048 + k * 1024); } while (0)
#define PG8_LDB(dst, b, h) do { _Pragma("unroll") for (int n = 0; n < 2; ++n) _Pragma("unroll") for (int k = 0; k < 2; ++k) dst[n][k] = *(const LAS bf16x8*)(lds + PG8_SB(b, h) + boff + n * 2048 + k * 1024); } while (0)
#define PG8_MMA(ai, bj, At, Bt) do { __builtin_amdgcn_s_setprio(1); _Pragma("unroll") for (int m = 0; m < 4; ++m) _Pragma("unroll") for (int n = 0; n < 2; ++n) _Pragma("unroll") for (int k = 0; k < 2; ++k) \
        acc[ai][bj][m][n] = __builtin_amdgcn_mfma_f32_16x16x32_bf16(Bt[n][k], At[m][k], acc[ai][bj][m][n], 0, 0, 0); __builtin_amdgcn_s_setprio(0); } while (0)
#define PG8_WAIT_V(n) asm volatile("s_waitcnt vmcnt(" #n ")" ::: "memory")
#define PG8_WAIT_L(n) asm volatile("s_waitcnt lgkmcnt(" #n ")" ::: "memory")
#define PG8_BAR __builtin_amdgcn_s_barrier()
#define PG8_SCHED __builtin_amdgcn_sched_barrier(0)
#define PG8_ZERO_ACC() do { float _z; asm volatile("v_mov_b32 %0, 0" : "=v"(_z)); _Pragma("unroll") for (int a = 0; a < 2; ++a) _Pragma("unroll") for (int b = 0; b < 2; ++b) _Pragma("unroll") for (int m = 0; m < 4; ++m) \
        _Pragma("unroll") for (int n = 0; n < 2; ++n) acc[a][b][m][n] = (f32x4){_z, _z, _z, _z}; } while (0)
    Unit cur, nxt; int ui = 0;
    if (!S.next(0, cur)) return;
    f32x4 acc[2][2][4][2];
    PG8_ZERO_ACC();
    bf16x8 At[4][2], B0[2][2], B1[2][2];
    unsigned gA[2][2];
    PG8_GATHER_OFFS(0);
    S.a_ready(cur, wid, lane);
    const char* cA = GATHER ? (const char*)g.A : (const char*)g.A + (size_t)cur.pm * tstep;
    const char* cB = (const char*)g.Bt + ((size_t)cur.e * g.bstride) * 2 + (size_t)cur.pn * tstep;
    const size_t rot0 = (size_t)krot * kstep;
    PG8_STAGE(PG8_SB(0, 0), cB + rot0, voffB); PG8_STAGE_A(PG8_SA(0, 0), cA + rot0, 0); PG8_STAGE(PG8_SB(0, 1), cB + rot0 + hstep, voffB); PG8_STAGE_A(PG8_SA(0, 1), cA + rot0, 1);
    if (wr == 1) PG8_BAR;
    PG8_WAIT_V(4); PG8_BAR;
    PG8_STAGE(PG8_SB(1, 0), cB + rot0 + kstep, voffB); PG8_STAGE_A(PG8_SA(1, 0), cA + rot0 + kstep, 0); PG8_STAGE(PG8_SB(1, 1), cB + rot0 + hstep + kstep, voffB);
    PG8_WAIT_V(6); PG8_BAR;
    for (;;) {
        const bool has_next = S.next(ui + 1, nxt);
        const char* nA = (GATHER || !has_next) ? cA : (const char*)g.A + (size_t)nxt.pm * tstep;
        const char* nB = has_next ? (const char*)g.Bt + ((size_t)nxt.e * g.bstride) * 2 + (size_t)nxt.pn * tstep : cB;
        for (int t = 0; t < nt; t += 2) {
            const bool last = (t == nt - 2);
            const char* a1 = cA + (size_t)((t + krot) & (nt - 1)) * kstep + kstep;
            const size_t o2 = (size_t)((t + 2 + krot) & (nt - 1)) * kstep;
            const char* a2 = (last ? nA : cA) + o2; const char* b2 = (last ? nB : cB) + o2;
            const char* a3 = a2 + kstep; const char* b3 = b2 + kstep;
            if constexpr (Sched::WAITS) { if (has_next) { if (t == nt - 4) S.poll_issue(nxt, wid, lane); if (last) S.poll_check(nxt, wid, lane); } }
            PG8_LDB(B0, 0, 0); PG8_SCHED; PG8_LDA(At, 0, 0); PG8_STAGE_A(PG8_SA(1, 1), a1, 1);
            PG8_WAIT_L(8); PG8_BAR; PG8_WAIT_L(0); PG8_MMA(0, 0, At, B0); PG8_BAR; PG8_SCHED;
            if (last && has_next) { PG8_GATHER_OFFS(ui + 1); }
            PG8_LDB(B1, 0, 1); PG8_STAGE(PG8_SB(0, 0), b2, voffB);
            PG8_BAR; PG8_WAIT_L(0); PG8_MMA(0, 1, At, B1); PG8_BAR;
            PG8_LDA(At, 0, 1); PG8_STAGE_A(PG8_SA(0, 0), a2, 0);
            PG8_BAR; PG8_WAIT_L(0); PG8_MMA(1, 0, At, B0); PG8_BAR; PG8_SCHED;
            PG8_STAGE(PG8_SB(0, 1), b2 + hstep, voffB);
            PG8_WAIT_V(6); PG8_BAR; PG8_MMA(1, 1, At, B1); PG8_BAR;
            PG8_LDB(B0, 1, 0); PG8_SCHED; PG8_LDA(At, 1, 0); PG8_STAGE_A(PG8_SA(0, 1), a2, 1);
            PG8_WAIT_L(8); PG8_BAR; PG8_WAIT_L(0); PG8_MMA(0, 0, At, B0); PG8_BAR; PG8_SCHED;
            PG8_LDB(B1, 1, 1); PG8_STAGE(PG8_SB(1, 0), b3, voffB);
            PG8_BAR; PG8_WAIT_L(0); PG8_MMA(0, 1, At, B1); PG8_BAR;
            PG8_LDA(At, 1, 1); PG8_STAGE_A(PG8_SA(1, 0), a3, 0);
            PG8_BAR; PG8_WAIT_L(0); PG8_MMA(1, 0, At, B0); PG8_BAR; PG8_SCHED;
            PG8_STAGE(PG8_SB(1, 1), b3 + hstep, voffB);
            PG8_WAIT_V(6); PG8_BAR; PG8_MMA(1, 1, At, B1); PG8_BAR;
        }
        E(acc, cur, wr, wc, fr, fq);
        S.done(cur, lane);
        if (!has_next) break;
        PG8_ZERO_ACC();
        cur = nxt; cA = nA; cB = nB; ++ui;
    }
    PG8_WAIT_V(0);
    if (wr == 0) PG8_BAR;
    PG8_BAR;
#undef PG8_SA
#undef PG8_SB
#undef PG8_STAGE
#undef PG8_STAGE_A
#undef PG8_GATHER_OFFS
#undef PG8_LDA
#undef PG8_LDB
#undef PG8_MMA
#undef PG8_WAIT_V
#undef PG8_WAIT_L
#undef PG8_BAR
#undef PG8_SCHED
#undef PG8_ZERO_ACC
}
}

__device__ __forceinline__ unsigned pk2(float lo, float hi) { return (unsigned)f2bf(lo) | ((unsigned)f2bf(hi) << 16); }
struct TrItem { const float* W; bf16_t* WT; int K, N, row_off, rmul, item; };
__device__ __forceinline__ void transpose_load(const TrItem& t, int lane, f32x4 (&v)[8]) {
    const int nblk = t.N / 32, kb = t.item / nblk, nb = t.item % nblk, k0 = 64 * kb, n0 = 32 * nb;
#pragma unroll
    for (int i = 0; i < 8; ++i) v[i] = *(const f32x4*)(t.W + (size_t)(k0 + (lane >> 3) + 8 * i) * t.N + n0 + 4 * (lane & 7));
}
__device__ __forceinline__ void transpose_emit(const TrItem& t, int lane, const f32x4 (&v)[8], LAS float* scr) {
    const int nblk = t.N / 32, kb = t.item / nblk, nb = t.item % nblk, k0 = 64 * kb, n0 = 32 * nb;
#pragma unroll
    for (int i = 0; i < 8; ++i) { const int kk = (lane >> 3) + 8 * i; LAS float* d = scr + kk * 33 + 4 * (lane & 7); d[0] = v[i][0]; d[1] = v[i][1]; d[2] = v[i][2]; d[3] = v[i][3]; }
    asm volatile("s_waitcnt lgkmcnt(0)" ::: "memory");
    const int c = lane & 7;
#pragma unroll
    for (int j = 0; j < 4; ++j) { const int n = (lane >> 3) + 8 * j; const LAS float* s = scr + (8 * c) * 33 + n;
        u32x4 o; o.x = pg8::cvt_pk_bf16(s[0 * 33], s[1 * 33]); o.y = pg8::cvt_pk_bf16(s[2 * 33], s[3 * 33]); o.z = pg8::cvt_pk_bf16(s[4 * 33], s[5 * 33]); o.w = pg8::cvt_pk_bf16(s[6 * 33], s[7 * 33]);
        *(u32x4*)(t.WT + (size_t)(t.row_off + t.rmul * (n0 + n)) * t.K + k0 + 8 * c) = o; }
    asm volatile("s_waitcnt lgkmcnt(0)" ::: "memory");
}
__device__ __forceinline__ void transpose_item(const float* W, int K, int N, bf16_t* WT, int row_off, int rmul, LAS float* scr, int item, int lane) {
    TrItem t{W, WT, K, N, row_off, rmul, item}; f32x4 v[8]; transpose_load(t, lane, v); transpose_emit(t, lane, v, scr);
}
__device__ void convert_dense_phase(int WV, const Params& p, LAS unsigned char* lds) {
    const int TID = o_tid(WV), BID = o_bid();
    const int lane = TID & 63, wave = TID >> 6, gw = BID * NWAVES + wave, ngw = gridDim.x * NWAVES;
    LAS float* scr = (LAS float*)(lds + wave * 16384);
    constexpr int I_IN = (DM / 64) * (INC / 32), I_OUT = (DM / 64) * (DM / 32);
    for (int it = gw; it < 2 * (I_IN + I_OUT); it += ngw) {
        int r = it; const int l = r / (I_IN + I_OUT); r -= l * (I_IN + I_OUT);
        if (r < I_IN) transpose_item(p.w_in + (size_t)l * DM * INC, DM, INC, p.wt_in + (size_t)l * INC * DM, 0, 1, scr, r, lane);
        else transpose_item(p.w_out + (size_t)l * DM * DM, DM, DM, p.wt_out + (size_t)l * DM * DM, 0, 1, scr, r - I_IN, lane);
    }
    const f32x4* xs = (const f32x4*)p.x; u32x2* xd = (u32x2*)p.xb;
    for (long i = (long)BID * NTHREADS + TID; i < (long)T_TOK * DM / 4; i += (long)gridDim.x * NTHREADS) { const f32x4 v = xs[i]; u32x2 o; o.x = pk2(v[0], v[1]); o.y = pk2(v[2], v[3]); xd[i] = o; }
}
#define CONV_CHUNKS (NEXP * 768 / 32)
__device__ __forceinline__ void convert_expert_chunk(int WV, const Params& p, int l, int chunk, LAS unsigned char* lds, int lane) {
    LAS float* scr = (LAS float*)(lds + WV * 12288);
    constexpr int I_G = (DM / 64) * (DEXP / 32), I_D = (DEXP / 64) * (DM / 32);
    constexpr int PER_E = 2 * I_G + I_D;
    const int it0 = chunk * 32 + WV * 4;
    const int e = it0 / PER_E; const int r0 = it0 - e * PER_E;
    const size_t eo = ((size_t)l * NEXP + e) * DM * DEXP;
    TrItem t;
    if (r0 < I_G) t = TrItem{p.wg + eo, p.wt_gu + (size_t)e * DM * DM, DM, DEXP, 0, 2, r0};
    else if (r0 < 2 * I_G) t = TrItem{p.wu + eo, p.wt_gu + (size_t)e * DM * DM, DM, DEXP, 1, 2, r0 - I_G};
    else t = TrItem{p.wd + eo, p.wt_dn + (size_t)e * DM * DEXP, DEXP, DM, 0, 1, r0 - 2 * I_G};
    f32x4 va[8], vb[8];
    TrItem ta = t, tb = t; tb.item = t.item + 1;
    transpose_load(ta, lane, va); transpose_load(tb, lane, vb);
    transpose_emit(ta, lane, va, scr);
    ta.item = t.item + 2; transpose_load(ta, lane, va);
    transpose_emit(tb, lane, vb, scr);
    tb.item = t.item + 3; transpose_load(tb, lane, vb);
    ta.item = t.item + 2; transpose_emit(ta, lane, va, scr);
    transpose_emit(tb, lane, vb, scr);
}
__device__ void convert_expert_phase(int WV, const Params& p, int l, LAS unsigned char* lds) {
    const int TID = o_tid(WV), BID = o_bid();
    const int lane = TID & 63, wave = TID >> 6, gw = BID * NWAVES + wave, ngw = gridDim.x * NWAVES;
    LAS float* scr = (LAS float*)(lds + wave * 16384);
    constexpr int I_G = (DM / 64) * (DEXP / 32), I_D = (DEXP / 64) * (DM / 32);
    constexpr int PER_E = 2 * I_G + I_D;
    for (int it = gw; it < NEXP * PER_E; it += ngw) {
        const int e = it / PER_E; int r = it - e * PER_E;
        const size_t eo = ((size_t)l * NEXP + e) * DM * DEXP;
        if (r < I_G) transpose_item(p.wg + eo, DM, DEXP, p.wt_gu + (size_t)e * DM * DM, 0, 2, scr, r, lane);
        else if (r < 2 * I_G) transpose_item(p.wu + eo, DM, DEXP, p.wt_gu + (size_t)e * DM * DM, 1, 2, scr, r - I_G, lane);
        else transpose_item(p.wd + eo, DEXP, DM, p.wt_dn + (size_t)e * DM * DEXP, 0, 1, scr, r - 2 * I_G, lane);
    }
}

__device__ __forceinline__ void sincos_poly(double ang, float& c, float& s) {
    const double TWO_PI = 6.283185307179586476925, INV_2PI = 0.15915494309189533577;
    const double k = __builtin_rint(ang * INV_2PI); const double r = ang - k * TWO_PI; const double r2 = r * r;
    double sn = 1.0 / 51090942171709440000.0;
    sn = sn * r2 * -1.0 + 1.0 / 121645100408832000.0;
    sn = sn * -r2 + 1.0 / 355687428096000.0;
    sn = sn * -r2 + 1.0 / 1307674368000.0;
    sn = sn * -r2 + 1.0 / 6227020800.0;
    sn = sn * -r2 + 1.0 / 39916800.0;
    sn = sn * -r2 + 1.0 / 362880.0;
    sn = sn * -r2 + 1.0 / 5040.0;
    sn = sn * -r2 + 1.0 / 120.0;
    sn = sn * -r2 + 1.0 / 6.0;
    sn = sn * -r2 + 1.0;
    sn = sn * r;
    double cs = 1.0 / 2432902008176640000.0;
    cs = cs * -r2 + 1.0 / 6402373705728000.0;
    cs = cs * -r2 + 1.0 / 20922789888000.0;
    cs = cs * -r2 + 1.0 / 87178291200.0;
    cs = cs * -r2 + 1.0 / 479001600.0;
    cs = cs * -r2 + 1.0 / 3628800.0;
    cs = cs * -r2 + 1.0 / 40320.0;
    cs = cs * -r2 + 1.0 / 720.0;
    cs = cs * -r2 + 1.0 / 24.0;
    cs = cs * -r2 + 0.5;
    cs = cs * -r2 + 1.0;
    c = (float)cs; s = (float)sn;
}
__device__ void rope_table_phase(int WV, float2* tab, float* lbtab, const float* lb_logits) {
    const int TID = o_tid(WV), BID = o_bid();
    if (BID == 0) { for (int i = TID; i < 1024; i += NTHREADS) { lbtab[i] = 0.f; lbtab[1024 + i] = 1.0f / (1.0f + __expf(lb_logits[i] - lb_logits[1024 + i])); } }
    const double invf[8] = {1.0, 0.19392274474868576, 0.03760603093086393, 0.007292664737217109, 0.001414213562373095, 0.0002742481756762073, 5.318295896944988e-05, 1.031338537721246e-05};
    for (int idx = BID * NTHREADS + TID; idx < SEQ * 8; idx += gridDim.x * NTHREADS) {
        const int j = idx & 7, pos = idx >> 3;
        double f = invf[0];
#pragma unroll
        for (int q = 1; q < 8; ++q) f = (j == q) ? invf[q] : f;
        float c, s; sincos_poly((double)pos * f, c, s);
        tab[idx] = make_float2(c, s);
    }
}
typedef short s16x4 __attribute__((ext_vector_type(4)));
#define ATT_ST_STRIDE 68
#define ATT_ST_BYTES (256 * ATT_ST_STRIDE * 4)
#define ATT_VROW 160
#define ATT_KROW 144
#define ATT_VB_BYTES (3 * 16 * ATT_KROW)
__device__ void attn_phase(int WV, const Params& p, int layer, const bf16_t* proj, bf16_t* y, LAS unsigned char* lds, int* ctr) {
    const int tid = o_tid(WV), lane = tid & 63, g = lane >> 4, ql = lane & 15, BID = o_bid();
    LAS float* st = (LAS float*)lds;
    LAS unsigned char* vbp = lds + ATT_ST_BYTES + WV * ATT_VB_BYTES;
    const int vrd = (int)(uintptr_t)vbp + (4 * g + ((lane >> 2) & 3)) * ATT_VROW + (lane & 3) * 8;
    const float L2E = 1.4426950408889634f;
    LAS int* qslot = (LAS int*)(lds + 150 * 1024);
#pragma unroll 1
    for (;;) {
        if (tid == 0) *qslot = atomicAdd(ctr, 1);
        __syncthreads();
        const int item = __builtin_amdgcn_readfirstlane(*qslot);
        if (item >= NB * 8 * 8 + CONV_CHUNKS) break;
        if (item >= NB * 8 * 8) {
            convert_expert_chunk(WV, p, layer, item - NB * 8 * 8, lds, lane);
            __syncthreads();
            continue;
        }
        const int blk = item & 7, head = (item >> 3) & 7, b = item >> 6;
        const int i0 = blk * 256;
        const bf16_t* base = proj + (size_t)b * SEQ * INC; const char* baseb = (const char*)base;
        const int qcol = 2560 + head * 64, kcol = 3072 + head * 64, vcol = 3584 + head * 64;
#define ATT_GEOM(n_, d_, L_, p0_, r_) do { const int br_ = (n_) >> 1, w_ = WV + 8 * ((n_) & 1); d_ = (br_ == 0) ? 1 : ((br_ == 1) ? 4 : 16); L_ = SEQ / d_; \
            if (br_ == 0) { p0_ = i0 + 16 * w_; r_ = 0; } else if (br_ == 1) { r_ = w_ & 3; p0_ = (i0 >> 2) + 16 * (w_ >> 2); } else { r_ = w_; p0_ = i0 >> 4; } } while (0)
#define ATT_LOAD_KQ(d_, L_, p0_, r_) do { const int tq_ = d_ * (p0_ + ql) + r_; \
            { const unsigned qo_ = (unsigned)(tq_ * INC + qcol + 8 * g) * 2u; _Pragma("unroll") for (int ks = 0; ks < 2; ++ks) qf[ks] = *(const bf16x8*)(baseb + qo_ + 64 * ks); } \
            _Pragma("unroll") for (int i_ = 0; i_ < 18; ++i_) { int pk = p0_ - 64 + 8 * i_ + (lane >> 3); pk = pk < 0 ? 0 : (pk > L_ - 1 ? L_ - 1 : pk); \
                kr[i_] = *(const u32x4*)(baseb + (unsigned)((d_ * pk + r_) * INC + kcol + 8 * (lane & 7)) * 2u); } } while (0)
#define ATT_LOAD_V(d_, L_, p0_, r_, K0_, K1_) do { _Pragma("unroll") for (int k2 = K0_; k2 < K1_; ++k2) _Pragma("unroll") for (int j = 0; j < 4; ++j) { const int rr = (lane >> 3) + 8 * j; \
            int pk = p0_ - 64 + 32 * k2 + rr; pk = pk < 0 ? 0 : (pk > L_ - 1 ? L_ - 1 : pk); vv[k2][j] = *(const u32x4*)(baseb + (unsigned)((d_ * pk + r_) * INC + vcol + 8 * (lane & 7)) * 2u); } } while (0)
        bf16x8 qf[2]; u32x4 kr[18]; u32x4 vv[5][4];
        { int d, L, p0, r; ATT_GEOM(0, d, L, p0, r); ATT_LOAD_KQ(d, L, p0, r); ATT_LOAD_V(d, L, p0, r, 0, ATT_VPRE); }
#pragma unroll 1
        for (int n = 0; n < 6; ++n) {
            const int lane = o_tid(WV) & 63, g = lane >> 4, ql = lane & 15;
            const int vrd = (int)(uintptr_t)vbp + (4 * g + ((lane >> 2) & 3)) * ATT_VROW + (lane & 3) * 8;
            const int br = n >> 1;
            int d, L, p0, r; ATT_GEOM(n, d, L, p0, r);
            const int tq = d * (p0 + ql) + r;
            f32x4 s[9];
            {
                const int kwr = (lane >> 3) * ATT_KROW + (lane & 7) * 16, krd = ql * ATT_KROW + g * 16;
#pragma unroll
                for (int grp = 0; grp < 3; ++grp) {
#pragma unroll
                    for (int t = 0; t < 3; ++t) { const int kt = 3 * grp + t;
                        *(LAS u32x4*)(vbp + t * 16 * ATT_KROW + kwr) = kr[2 * kt]; *(LAS u32x4*)(vbp + t * 16 * ATT_KROW + 8 * ATT_KROW + kwr) = kr[2 * kt + 1]; }
                    bf16x8 f0[3], f1[3];
#pragma unroll
                    for (int t = 0; t < 3; ++t) { f0[t] = *(const LAS bf16x8*)(vbp + t * 16 * ATT_KROW + krd); f1[t] = *(const LAS bf16x8*)(vbp + t * 16 * ATT_KROW + krd + 64); }
#pragma unroll
                    for (int t = 0; t < 3; ++t) { const int kt = 3 * grp + t;
                        f32x4 z = {0.f, 0.f, 0.f, 0.f};
                        z = __builtin_amdgcn_mfma_f32_16x16x32_bf16(f0[t], qf[0], z, 0, 0, 0);
                        s[kt] = __builtin_amdgcn_mfma_f32_16x16x32_bf16(f1[t], qf[1], z, 0, 0, 0); }
                }
            }
            __builtin_amdgcn_sched_barrier(0);
            ATT_LOAD_V(d, L, p0, r, ATT_VPRE, 5);
            if (n < 5) { int d2, L2, p02, r2; ATT_GEOM(n + 1, d2, L2, p02, r2); ATT_LOAD_KQ(d2, L2, p02, r2); }
            __builtin_amdgcn_sched_barrier(0);
            const int klo = max(ql, 64 - p0), khi = min(ql + 128, L + 63 - p0);
            float m = -3.0e38f;
#pragma unroll
            for (int kt = 0; kt < 9; ++kt)
#pragma unroll
                for (int j = 0; j < 4; ++j) { const int kk = 16 * kt + 4 * g + j; const bool ok = (kk >= klo) && (kk <= khi); s[kt][j] = ok ? s[kt][j] : -INFINITY; m = fmaxf(m, s[kt][j]); }
            m = fmaxf(m, __shfl_xor(m, 16)); m = fmaxf(m, __shfl_xor(m, 32));
            float lsum = 0.f;
#pragma unroll
            for (int kt = 0; kt < 9; ++kt)
#pragma unroll
                for (int j = 0; j < 4; ++j) { const float pe = __builtin_amdgcn_exp2f(s[kt][j] - m); s[kt][j] = pe; lsum += pe; }
            lsum += __shfl_xor(lsum, 16); lsum += __shfl_xor(lsum, 32);
            f32x4 o[4];
#pragma unroll
            for (int c = 0; c < 4; ++c) o[c] = (f32x4){0.f, 0.f, 0.f, 0.f};
#pragma unroll
            for (int k2 = 0; k2 < 5; ++k2) {
#pragma unroll
                for (int j = 0; j < 4; ++j) { const int rr = (lane >> 3) + 8 * j; *(LAS u32x4*)(vbp + rr * ATT_VROW + (lane & 7) * 16) = vv[k2][j]; }
                bf16x8 pf;
                { const f32x4 pa = s[2 * k2]; const f32x4 pb = (k2 < 4) ? s[2 * k2 + 1 < 9 ? 2 * k2 + 1 : 8] : (f32x4){0.f, 0.f, 0.f, 0.f};
                  u32x4 pw; pw.x = pg8::cvt_pk_bf16(pa[0], pa[1]); pw.y = pg8::cvt_pk_bf16(pa[2], pa[3]); pw.z = pg8::cvt_pk_bf16(pb[0], pb[1]); pw.w = pg8::cvt_pk_bf16(pb[2], pb[3]);
                  pf = __builtin_bit_cast(bf16x8, pw); }
                s16x4 lo[4], hi[4];
#pragma unroll
                for (int c = 0; c < 4; ++c) {
                    asm volatile("ds_read_b64_tr_b16 %0, %1 offset:%2" : "=&v"(lo[c]) : "v"(vrd), "i"(32 * c) : "memory");
                    asm volatile("ds_read_b64_tr_b16 %0, %1 offset:%2" : "=&v"(hi[c]) : "v"(vrd), "i"(16 * ATT_VROW + 32 * c) : "memory");
                }
                asm volatile("s_waitcnt lgkmcnt(0)" ::: "memory"); __builtin_amdgcn_sched_barrier(0);
#pragma unroll
                for (int c = 0; c < 4; ++c) {
                    const bf16x8 af = (bf16x8){lo[c][0], lo[c][1], lo[c][2], lo[c][3], hi[c][0], hi[c][1], hi[c][2], hi[c][3]};
                    o[c] = __builtin_amdgcn_mfma_f32_16x16x32_bf16(af, pf, o[c], 0, 0, 0);
                }
            }
            __builtin_amdgcn_sched_barrier(0);
            if (n < 5) { int d2, L2, p02, r2; ATT_GEOM(n + 1, d2, L2, p02, r2); ATT_LOAD_V(d2, L2, p02, r2, 0, ATT_VPRE); }
            __builtin_amdgcn_sched_barrier(0);
            const int tl = tq - i0;
            LAS float* sp = st + tl * ATT_ST_STRIDE;
            if (br == 0) {
#pragma unroll
                for (int c = 0; c < 4; ++c) *(LAS f32x4*)(sp + 16 * c + 4 * g) = o[c];
                if (g == 0) { sp[64] = m; sp[65] = lsum; }
            } else {
                const float mo = sp[64], lo_ = sp[65];
                f32x4 oo[4];
#pragma unroll
                for (int c = 0; c < 4; ++c) oo[c] = *(const LAS f32x4*)(sp + 16 * c + 4 * g);
                const float mn = fmaxf(mo, m);
                const float fa = __builtin_amdgcn_exp2f(mo - mn), fb = __builtin_amdgcn_exp2f(m - mn);
                const float ln = fa * lo_ + fb * lsum;
                if (br == 1) {
#pragma unroll
                    for (int c = 0; c < 4; ++c) *(LAS f32x4*)(sp + 16 * c + 4 * g) = oo[c] * fa + o[c] * fb;
                    if (g == 0) { sp[64] = mn; sp[65] = ln; }
                } else {
                    const float inv = 1.0f / ln;
                    bf16_t* yp = y + ((size_t)b * SEQ + tq) * DM + 512 + head * 64 + 4 * g;
#pragma unroll
                    for (int c = 0; c < 4; ++c) { const f32x4 ov = (oo[c] * fa + o[c] * fb) * inv;
                        u32x2 wv2; wv2.x = pg8::cvt_pk_bf16(ov[0], ov[1]); wv2.y = pg8::cvt_pk_bf16(ov[2], ov[3]); *(u32x2*)(yp + 16 * c) = wv2; }
                }
            }
            if (n & 1) __syncthreads();
        }
#undef ATT_GEOM
#undef ATT_LOAD_KQ
    }
}

#define HG_QS 272
#define HG_SS 144
#define HG_QT 0
#define HG_KT 17408
#define HG_VT 34816
#define HG_ST 52224
#define HG_OST 34816
#define HG_MISC 68608
#define HG_GRP 70656
#define HG_OS 528
typedef float f32x16 __attribute__((ext_vector_type(16)));
#define TR_READ(dst, base, off) asm volatile("ds_read_b64_tr_b16 %0, %1 offset:%2" : "=&v"(dst) : "v"(base), "i"(off) : "memory")
#define HG_BAR() do { asm volatile("s_waitcnt lgkmcnt(0)" ::: "memory"); __builtin_amdgcn_s_barrier(); asm volatile("" ::: "memory"); } while (0)
__device__ void hgrn_phase(int WV, const Params& p, int layer, LAS unsigned char* lds) {
    const int BID = o_bid();
    const int grp = WV >> 2, w = WV & 3;
    LAS unsigned char* gl = lds + grp * HG_GRP;
    LAS float* tot = (LAS float*)(gl + HG_MISC); LAS float* sref = tot + 256; LAS float* send = tot + 384;
    const int half = (WV >> 1) & 1;
#pragma unroll 1
    for (int item = BID; item < NB * 4; item += gridDim.x) {
        const int h = item & 3, b = item >> 2;
        const int c = (WV & 1) * 64 + (o_tid(WV) & 63);
        const bf16_t* pb = p.proj + (size_t)b * SEQ * INC;
        f32x16 stt[4];
#pragma unroll
        for (int ct = 0; ct < 4; ++ct)
#pragma unroll
            for (int i = 0; i < 16; ++i) stt[ct][i] = 0.f;
        { const int lane0 = o_tid(WV) & 63, cw0 = WV & 1, cf0 = grp ? 31 * 64 : 0;
#pragma unroll
          for (int k = 0; k < 4; ++k) { const int id = lane0 + 64 * k, tau = 32 * half + (id >> 3), ch = id & 7; const int t = grp ? (cf0 + 63 - tau) : (cf0 + tau);
              const bf16_t* row = pb + (size_t)t * INC + h * 128 + 64 * cw0 + 8 * ch; const u32x4 q0 = *(const u32x4*)row, a0 = *(const u32x4*)(row + 512 + grp * 512);
              *(LAS u32x4*)(gl + HG_QT + tau * HG_QS + (64 * cw0 + 8 * ch) * 2) = q0; *(LAS u32x4*)(gl + HG_KT + tau * HG_QS + (64 * cw0 + 8 * ch) * 2) = a0; } }
        u32x4 vld[4];
        { const int gt0 = (WV & 3) * 64 + (o_tid(WV) & 63), cf0 = grp ? 31 * 64 : 0;
#pragma unroll
          for (int i = 0; i < 4; ++i) { const int id = gt0 + 256 * i, tau = id >> 4, ch = id & 15; const int t = grp ? (cf0 + 63 - tau) : (cf0 + tau);
              vld[i] = *(const u32x4*)(pb + (size_t)t * INC + 1536 + h * 128 + 8 * ch); } }
#pragma unroll 1
        for (int j = 0; j < 32; ++j) {
            const int ci = grp ? (31 - j) : j, c0 = ci * 64;
            const int lane = o_tid(WV) & 63, gt = w * 64 + lane, r = lane & 31, hh = lane >> 5;
            const int gi = lane >> 4, li = lane & 15, tq = li >> 2, tp = li & 3;
            const int trV = (int)(uintptr_t)(gl + HG_VT) + (8 * hh + tq) * HG_QS + (32 * w + 16 * (gi & 1) + 4 * tp) * 2;
            const int trK = (int)(uintptr_t)(gl + HG_KT) + (8 * hh + tq) * HG_QS + (16 * (gi & 1) + 4 * tp) * 2;
            if (j > 0) {
#pragma unroll
                for (int i = 0; i < 4; ++i) { const int id = gt + 256 * i, tau = id >> 4, ch = id & 15; const int t = grp ? (c0 + 63 - tau) : (c0 + tau);
                    vld[i] = *(const u32x4*)(pb + (size_t)t * INC + 1536 + h * 128 + 8 * ch); }
            }
            const int cw = WV & 1;
            unsigned kq[32];
            {
                float pl = 1.0f;
#pragma unroll
                for (int i = 0; i < 32; ++i) { const int tau = 32 * half + i;
                    const unsigned qraw = *(const LAS bf16_t*)(gl + HG_QT + tau * HG_QS + c * 2), fraw = *(const LAS bf16_t*)(gl + HG_KT + tau * HG_QS + c * 2);
                    pl = fmaxf(pl * __uint_as_float(fraw << 16), 1e-30f);
                    kq[i] = fraw | (qraw << 16);
                    if ((i & 7) == 7) __builtin_amdgcn_sched_barrier(0);
                }
                tot[half * 128 + c] = pl;
            }
            asm volatile("s_waitcnt vmcnt(0)" ::: "memory");
            HG_BAR();
            {
                const float t0 = tot[c], t1 = tot[128 + c];
                const float fa = half ? 1.0f : __builtin_amdgcn_rcpf(t0), fb = half ? 1.0f : t0;
                float pl = 1.0f;
#pragma unroll
                for (int i = 0; i < 32; ++i) { const int tau = 32 * half + i;
                    const float f = __uint_as_float(kq[i] << 16), qq = __uint_as_float(kq[i] & 0xffff0000u);
                    pl = fmaxf(pl * f, 1e-30f);
                    const float eq = pl * fa, ek = fb * __builtin_amdgcn_rcpf(pl);
                    const unsigned pk = pg8::cvt_pk_bf16(qq * eq, (1.0f - f) * ek);
                    *(LAS bf16_t*)(gl + HG_QT + tau * HG_QS + c * 2) = (bf16_t)(pk & 0xffffu);
                    *(LAS bf16_t*)(gl + HG_KT + tau * HG_QS + c * 2) = (bf16_t)(pk >> 16);
                    if ((i & 7) == 7) __builtin_amdgcn_sched_barrier(0); }
                if (half == 0) sref[c] = t0; else send[c] = t1;
#pragma unroll
                for (int i = 0; i < 4; ++i) { const int id = gt + 256 * i, tau = id >> 4, ch = id & 15; *(LAS u32x4*)(gl + HG_VT + tau * HG_QS + ch * 16) = vld[i]; }
            }
            HG_BAR();
            u32x4 rq[4], ra[4];
            if (j < 31) {
                const int cn = grp ? (30 - j) : (j + 1), cn0 = cn * 64;
#pragma unroll
                for (int k = 0; k < 4; ++k) { const int id = lane + 64 * k, tau = 32 * half + (id >> 3), ch = id & 7; const int t = grp ? (cn0 + 63 - tau) : (cn0 + tau);
                    const bf16_t* row = pb + (size_t)t * INC + h * 128 + 64 * cw + 8 * ch; rq[k] = *(const u32x4*)row; ra[k] = *(const u32x4*)(row + 512 + grp * 512); }
            }
#pragma unroll
            for (int ct = 0; ct < 4; ++ct)
#pragma unroll
                for (int s = 0; s < 2; ++s) { const f32x4 s0 = *(const LAS f32x4*)(sref + 32 * ct + 16 * s + 4 * hh), s1 = *(const LAS f32x4*)(sref + 32 * ct + 16 * s + 8 + 4 * hh);
#pragma unroll
                    for (int i = 0; i < 4; ++i) { stt[ct][8 * s + i] *= s0[i]; stt[ct][8 * s + 4 + i] *= s1[i]; } }
            if (w != 1) {
                const int st_ = (w == 3) ? 1 : 0, tt_ = (w == 0) ? 0 : 1;
                f32x16 sa;
#pragma unroll
                for (int i = 0; i < 16; ++i) sa[i] = 0.f;
#pragma unroll
                for (int ks = 0; ks < 8; ++ks) {
                    const bf16x8 ka = *(const LAS bf16x8*)(gl + HG_KT + (32 * st_ + r) * HG_QS + (16 * ks + 8 * hh) * 2);
                    const bf16x8 qb = *(const LAS bf16x8*)(gl + HG_QT + (32 * tt_ + r) * HG_QS + (16 * ks + 8 * hh) * 2);
                    sa = __builtin_amdgcn_mfma_f32_32x32x16_bf16(ka, qb, sa, 0, 0, 0);
                }
                const int tau_abs = 32 * tt_ + r;
#pragma unroll
                for (int rg = 0; rg < 4; ++rg) { float v4[4];
#pragma unroll
                    for (int i = 0; i < 4; ++i) { const int sig_abs = 32 * st_ + 8 * rg + 4 * hh + i; v4[i] = (sig_abs <= tau_abs) ? sa[4 * rg + i] : 0.f; }
                    u32x2 wv2; wv2.x = pg8::cvt_pk_bf16(v4[0], v4[1]); wv2.y = pg8::cvt_pk_bf16(v4[2], v4[3]);
                    *(LAS u32x2*)(gl + HG_ST + tau_abs * HG_SS + (32 * st_ + 8 * rg + 4 * hh) * 2) = wv2; }
            }
            __builtin_amdgcn_sched_barrier(0);
            f32x16 oacc[2];
#pragma unroll
            for (int tt = 0; tt < 2; ++tt)
#pragma unroll
                for (int i = 0; i < 16; ++i) oacc[tt][i] = 0.f;
#pragma unroll
            for (int ct = 0; ct < 4; ++ct)
#pragma unroll
                for (int s = 0; s < 2; ++s) {
                    u32x4 bw; bw.x = pg8::cvt_pk_bf16(stt[ct][8 * s + 0], stt[ct][8 * s + 1]); bw.y = pg8::cvt_pk_bf16(stt[ct][8 * s + 2], stt[ct][8 * s + 3]);
                    bw.z = pg8::cvt_pk_bf16(stt[ct][8 * s + 4], stt[ct][8 * s + 5]); bw.w = pg8::cvt_pk_bf16(stt[ct][8 * s + 6], stt[ct][8 * s + 7]);
                    const bf16x8 bfr = __builtin_bit_cast(bf16x8, bw);
#pragma unroll
                    for (int tt = 0; tt < 2; ++tt) {
                        const LAS unsigned char* qa = gl + HG_QT + (32 * tt + r) * HG_QS + (32 * ct + 16 * s + 4 * hh) * 2;
                        const u32x2 a0 = *(const LAS u32x2*)qa, a1 = *(const LAS u32x2*)(qa + 16);
                        u32x4 aw; aw.x = a0.x; aw.y = a0.y; aw.z = a1.x; aw.w = a1.y;
                        oacc[tt] = __builtin_amdgcn_mfma_f32_32x32x16_bf16(__builtin_bit_cast(bf16x8, aw), bfr, oacc[tt], 0, 0, 0);
                    }
                    __builtin_amdgcn_sched_barrier(0);
                }
            HG_BAR();
            bf16x8 vf[4];
            { s16x4 lo[4], hi[4];
#pragma unroll
              for (int ks = 0; ks < 4; ++ks) { TR_READ(lo[ks], trV, (16 * ks) * HG_QS); TR_READ(hi[ks], trV, (16 * ks + 4) * HG_QS); }
              asm volatile("s_waitcnt lgkmcnt(0)" : "+v"(lo[0]), "+v"(hi[0]), "+v"(lo[1]), "+v"(hi[1]), "+v"(lo[2]), "+v"(hi[2]), "+v"(lo[3]), "+v"(hi[3]) :: "memory");
#pragma unroll
              for (int ks = 0; ks < 4; ++ks) vf[ks] = (bf16x8){lo[ks][0], lo[ks][1], lo[ks][2], lo[ks][3], hi[ks][0], hi[ks][1], hi[ks][2], hi[ks][3]}; }
            __builtin_amdgcn_sched_barrier(0);
#pragma unroll
            for (int tt = 0; tt < 2; ++tt)
#pragma unroll
                for (int ks = 0; ks < 4; ++ks) { if (tt == 0 && ks >= 2) continue;
                    const bf16x8 sfr = *(const LAS bf16x8*)(gl + HG_ST + (32 * tt + r) * HG_SS + (16 * ks + 8 * hh) * 2);
                    oacc[tt] = __builtin_amdgcn_mfma_f32_32x32x16_bf16(sfr, vf[ks], oacc[tt], 0, 0, 0); }
#pragma unroll
            for (int ct = 0; ct < 4; ++ct) {
                bf16x8 kf[4];
                { s16x4 lo[4], hi[4];
#pragma unroll
                  for (int ks = 0; ks < 4; ++ks) { TR_READ(lo[ks], trK, (16 * ks) * HG_QS + 64 * ct); TR_READ(hi[ks], trK, (16 * ks + 4) * HG_QS + 64 * ct); }
                  asm volatile("s_waitcnt lgkmcnt(0)" : "+v"(lo[0]), "+v"(hi[0]), "+v"(lo[1]), "+v"(hi[1]), "+v"(lo[2]), "+v"(hi[2]), "+v"(lo[3]), "+v"(hi[3]) :: "memory");
#pragma unroll
                  for (int ks = 0; ks < 4; ++ks) kf[ks] = (bf16x8){lo[ks][0], lo[ks][1], lo[ks][2], lo[ks][3], hi[ks][0], hi[ks][1], hi[ks][2], hi[ks][3]}; }
                __builtin_amdgcn_sched_barrier(0);
#pragma unroll
                for (int ks = 0; ks < 4; ++ks) stt[ct] = __builtin_amdgcn_mfma_f32_32x32x16_bf16(kf[ks], vf[ks], stt[ct], 0, 0, 0);
#pragma unroll
                for (int s = 0; s < 2; ++s) { const f32x4 s0 = *(const LAS f32x4*)(send + 32 * ct + 16 * s + 4 * hh), s1 = *(const LAS f32x4*)(send + 32 * ct + 16 * s + 8 + 4 * hh);
#pragma unroll
                    for (int i = 0; i < 4; ++i) { stt[ct][8 * s + i] *= s0[i]; stt[ct][8 * s + 4 + i] *= s1[i]; } }
            }
            HG_BAR();
            if (j < 31) {
#pragma unroll
                for (int k = 0; k < 4; ++k) { const int id = lane + 64 * k, tau = 32 * half + (id >> 3), ch = id & 7;
                    *(LAS u32x4*)(gl + HG_QT + tau * HG_QS + (64 * cw + 8 * ch) * 2) = rq[k]; *(LAS u32x4*)(gl + HG_KT + tau * HG_QS + (64 * cw + 8 * ch) * 2) = ra[k]; }
            }
#pragma unroll
            for (int tt = 0; tt < 2; ++tt)
#pragma unroll
                for (int i = 0; i < 16; ++i) { const int tau = 32 * tt + (i & 3) + 8 * (i >> 2) + 4 * hh; *(LAS float*)(gl + HG_OST + tau * HG_OS + (32 * w + r) * 4) = oacc[tt][i]; }
            HG_BAR();
            {
                const int tau = gt >> 2, seg = gt & 3; const int t = grp ? (c0 + 63 - tau) : (c0 + tau);
                const LAS f32x4* orow = (const LAS f32x4*)(gl + HG_OST + tau * HG_OS + seg * 128);
                bf16_t* yp = p.y + ((size_t)b * SEQ + t) * DM + h * 128 + seg * 32;
                if (j < 16) {
#pragma unroll
                    for (int i = 0; i < 4; ++i) { const f32x4 oa = orow[2 * i], ob = orow[2 * i + 1];
                        u32x4 o4; o4.x = pg8::cvt_pk_bf16(oa[0], oa[1]); o4.y = pg8::cvt_pk_bf16(oa[2], oa[3]); o4.z = pg8::cvt_pk_bf16(ob[0], ob[1]); o4.w = pg8::cvt_pk_bf16(ob[2], ob[3]); *(u32x4*)(yp + 8 * i) = o4; }
                } else {
                    const bf16_t* hg = p.proj + ((size_t)b * SEQ + t) * INC + 2048 + h * 128 + seg * 32;
                    LAS f32x4* erow = (LAS f32x4*)(gl + HG_OST + tau * HG_OS + seg * 128);
                    float ss = 0.f;
                    { u32x4 fpv[4];
#pragma unroll
                      for (int i = 0; i < 4; ++i) fpv[i] = *(const u32x4*)(yp + 8 * i);
                      __builtin_amdgcn_sched_barrier(0);
#pragma unroll
                      for (int i = 0; i < 4; ++i) { f32x4 oa = erow[2 * i], ob = erow[2 * i + 1]; const u32x4 pv = fpv[i];
                          oa[0] += __uint_as_float(pv.x << 16); oa[1] += __uint_as_float(pv.x & 0xffff0000u); oa[2] += __uint_as_float(pv.y << 16); oa[3] += __uint_as_float(pv.y & 0xffff0000u);
                          ob[0] += __uint_as_float(pv.z << 16); ob[1] += __uint_as_float(pv.z & 0xffff0000u); ob[2] += __uint_as_float(pv.w << 16); ob[3] += __uint_as_float(pv.w & 0xffff0000u);
                          erow[2 * i] = oa; erow[2 * i + 1] = ob;
                          const f32x4 qa = oa * oa, qb = ob * ob; ss += (qa[0] + qa[1]) + (qa[2] + qa[3]) + (qb[0] + qb[1]) + (qb[2] + qb[3]); } }
                    __builtin_amdgcn_sched_barrier(0);
                    u32x4 fgv[4];
#pragma unroll
                    for (int i = 0; i < 4; ++i) fgv[i] = *(const u32x4*)(hg + 8 * i);
                    ss += __shfl_xor(ss, 1); ss += __shfl_xor(ss, 2);
                    const float rn = rsqrtf(ss * (1.0f / 128.0f) + 1e-6f);
                    __builtin_amdgcn_sched_barrier(0);
#pragma unroll
                    for (int i = 0; i < 4; ++i) { const f32x4 oa = erow[2 * i] * rn, ob = erow[2 * i + 1] * rn; const u32x4 gv = fgv[i];
                        u32x4 o4;
                        o4.x = pg8::cvt_pk_bf16(oa[0] * __uint_as_float(gv.x << 16), oa[1] * __uint_as_float(gv.x & 0xffff0000u));
                        o4.y = pg8::cvt_pk_bf16(oa[2] * __uint_as_float(gv.y << 16), oa[3] * __uint_as_float(gv.y & 0xffff0000u));
                        o4.z = pg8::cvt_pk_bf16(ob[0] * __uint_as_float(gv.z << 16), ob[1] * __uint_as_float(gv.z & 0xffff0000u));
                        o4.w = pg8::cvt_pk_bf16(ob[2] * __uint_as_float(gv.w << 16), ob[3] * __uint_as_float(gv.w & 0xffff0000u));
                        *(u32x4*)(yp + 8 * i) = o4; }
                }
            }
        }
        asm volatile("s_waitcnt vmcnt(0)" ::: "memory");
        __syncthreads();
    }
}

#define H2_QT 0
#define H2_KT 17408
#define H2_VT 34816
#define H2_ST 52224
#define H2_MISC 61440
#define H2_BUF 62464
#define H2_OST (2 * H2_BUF)
#define H2_FLAG (H2_OST + 17408)
__device__ void hgrn2_phase(int WV, const Params& p, int layer, LAS unsigned char* lds) {
    const int BID = o_bid();
    const int w = WV & 3;
#pragma unroll 1
    for (int item = BID; item < NB * 4 * 2; item += gridDim.x) {
        const int dir = item & 1, h = (item >> 1) & 3, b = item >> 3;
        const bf16_t* pb = p.proj + (size_t)b * SEQ * INC;
        bf16_t* odst = dir ? (p.ob + (size_t)b * SEQ * 512 + h * 128) : (p.y + (size_t)b * SEQ * DM + h * 128);
        const int ostride = dir ? 512 : DM;
        if (WV < 4) {
            f32x16 stt[4];
#pragma unroll
            for (int ct = 0; ct < 4; ++ct)
#pragma unroll
                for (int i = 0; i < 16; ++i) stt[ct][i] = 0.f;
#pragma unroll 1
            for (int k = -1; k <= 32; ++k) {
                const int lane = o_tid(WV) & 63, r = lane & 31, hh = lane >> 5;
                if (k >= 1) {
                    const int st_ = w * 64 + lane; const int cp0 = (dir ? (31 - (k - 1)) : (k - 1)) * 64; const int row = st_ >> 2, seg = st_ & 3; const int t = dir ? (cp0 + 63 - row) : (cp0 + row);
                    const LAS u32x4* sp = (const LAS u32x4*)(lds + H2_OST + row * HG_QS + seg * 64);
                    u32x4* dp = (u32x4*)(odst + (size_t)t * ostride + seg * 32);
#pragma unroll
                    for (int i = 0; i < 4; ++i) dp[i] = sp[i];
                }
                if (k < 0 || k > 31) { HG_BAR(); HG_BAR(); continue; }
                const int gi = lane >> 4, li = lane & 15, tq = li >> 2, tp = li & 3;
                LAS unsigned char* gl = lds + (k & 1) * H2_BUF;
                LAS float* sref = (LAS float*)(gl + H2_MISC); LAS float* send = sref + 128;
                const int trV = (int)(uintptr_t)(gl + H2_VT) + (8 * hh + tq) * HG_QS + (32 * w + 16 * (gi & 1) + 4 * tp) * 2;
                const int trK = (int)(uintptr_t)(gl + H2_KT) + (8 * hh + tq) * HG_QS + (16 * (gi & 1) + 4 * tp) * 2;
#pragma unroll
                for (int ct = 0; ct < 4; ++ct)
#pragma unroll
                    for (int s = 0; s < 2; ++s) { const f32x4 s0 = *(const LAS f32x4*)(sref + 32 * ct + 16 * s + 4 * hh), s1 = *(const LAS f32x4*)(sref + 32 * ct + 16 * s + 8 + 4 * hh);
#pragma unroll
                        for (int i = 0; i < 4; ++i) { stt[ct][8 * s + i] *= s0[i]; stt[ct][8 * s + 4 + i] *= s1[i]; } }
                f32x16 oacc[2];
#pragma unroll
                for (int tt = 0; tt < 2; ++tt)
#pragma unroll
                    for (int i = 0; i < 16; ++i) oacc[tt][i] = 0.f;
#pragma unroll
                for (int ct = 0; ct < 4; ++ct)
#pragma unroll
                    for (int s = 0; s < 2; ++s) {
                        u32x4 bw; bw.x = pg8::cvt_pk_bf16(stt[ct][8 * s + 0], stt[ct][8 * s + 1]); bw.y = pg8::cvt_pk_bf16(stt[ct][8 * s + 2], stt[ct][8 * s + 3]);
                        bw.z = pg8::cvt_pk_bf16(stt[ct][8 * s + 4], stt[ct][8 * s + 5]); bw.w = pg8::cvt_pk_bf16(stt[ct][8 * s + 6], stt[ct][8 * s + 7]);
                        const bf16x8 bfr = __builtin_bit_cast(bf16x8, bw);
#pragma unroll
                        for (int tt = 0; tt < 2; ++tt) {
                            const LAS unsigned char* qa = gl + H2_QT + (32 * tt + r) * HG_QS + (32 * ct + 16 * s + 4 * hh) * 2;
                            const u32x2 a0 = *(const LAS u32x2*)qa, a1 = *(const LAS u32x2*)(qa + 16);
                            u32x4 aw; aw.x = a0.x; aw.y = a0.y; aw.z = a1.x; aw.w = a1.y;
                            oacc[tt] = __builtin_amdgcn_mfma_f32_32x32x16_bf16(__builtin_bit_cast(bf16x8, aw), bfr, oacc[tt], 0, 0, 0);
                        }
                        __builtin_amdgcn_sched_barrier(0);
                    }
                HG_BAR();
                bf16x8 vf[4];
                { s16x4 lo[4], hi[4];
#pragma unroll
                  for (int ks = 0; ks < 4; ++ks) { TR_READ(lo[ks], trV, (16 * ks) * HG_QS); TR_READ(hi[ks], trV, (16 * ks + 4) * HG_QS); }
                  asm volatile("s_waitcnt lgkmcnt(0)" : "+v"(lo[0]), "+v"(hi[0]), "+v"(lo[1]), "+v"(hi[1]), "+v"(lo[2]), "+v"(hi[2]), "+v"(lo[3]), "+v"(hi[3]) :: "memory");
#pragma unroll
                  for (int ks = 0; ks < 4; ++ks) vf[ks] = (bf16x8){lo[ks][0], lo[ks][1], lo[ks][2], lo[ks][3], hi[ks][0], hi[ks][1], hi[ks][2], hi[ks][3]}; }
                __builtin_amdgcn_sched_barrier(0);
#pragma unroll
                for (int tt = 0; tt < 2; ++tt)
#pragma unroll
                    for (int ks = 0; ks < 4; ++ks) { if (tt == 0 && ks >= 2) continue;
                        const bf16x8 sfr = *(const LAS bf16x8*)(gl + H2_ST + (32 * tt + r) * HG_SS + (16 * ks + 8 * hh) * 2);
                        oacc[tt] = __builtin_amdgcn_mfma_f32_32x32x16_bf16(sfr, vf[ks], oacc[tt], 0, 0, 0); }
#pragma unroll
                for (int ct = 0; ct < 4; ++ct) {
                    bf16x8 kf[4];
                    { s16x4 lo[4], hi[4];
#pragma unroll
                      for (int ks = 0; ks < 4; ++ks) { TR_READ(lo[ks], trK, (16 * ks) * HG_QS + 64 * ct); TR_READ(hi[ks], trK, (16 * ks + 4) * HG_QS + 64 * ct); }
                      asm volatile("s_waitcnt lgkmcnt(0)" : "+v"(lo[0]), "+v"(hi[0]), "+v"(lo[1]), "+v"(hi[1]), "+v"(lo[2]), "+v"(hi[2]), "+v"(lo[3]), "+v"(hi[3]) :: "memory");
#pragma unroll
                      for (int ks = 0; ks < 4; ++ks) kf[ks] = (bf16x8){lo[ks][0], lo[ks][1], lo[ks][2], lo[ks][3], hi[ks][0], hi[ks][1], hi[ks][2], hi[ks][3]}; }
                    __builtin_amdgcn_sched_barrier(0);
#pragma unroll
                    for (int ks = 0; ks < 4; ++ks) stt[ct] = __builtin_amdgcn_mfma_f32_32x32x16_bf16(kf[ks], vf[ks], stt[ct], 0, 0, 0);
#pragma unroll
                    for (int s = 0; s < 2; ++s) { const f32x4 s0 = *(const LAS f32x4*)(send + 32 * ct + 16 * s + 4 * hh), s1 = *(const LAS f32x4*)(send + 32 * ct + 16 * s + 8 + 4 * hh);
#pragma unroll
                        for (int i = 0; i < 4; ++i) { stt[ct][8 * s + i] *= s0[i]; stt[ct][8 * s + 4 + i] *= s1[i]; } }
                }
#pragma unroll
                for (int tt = 0; tt < 2; ++tt)
#pragma unroll
                    for (int i = 0; i < 16; i += 2) { const int tau = 32 * tt + (i & 3) + 8 * (i >> 2) + 4 * hh;
                        const unsigned pk = pg8::cvt_pk_bf16(oacc[tt][i], oacc[tt][i + 1]);
                        *(LAS bf16_t*)(lds + H2_OST + tau * HG_QS + (32 * w + r) * 2) = (bf16_t)(pk & 0xffffu);
                        *(LAS bf16_t*)(lds + H2_OST + (tau + 1) * HG_QS + (32 * w + r) * 2) = (bf16_t)(pk >> 16); }
                HG_BAR();
            }
        } else {
            const int pw = WV - 4;
            u32x4 rq[4], rf[4], rv[4];
            {
                const int lane = o_tid(WV) & 63, pt = pw * 64 + lane; const int c0 = (dir ? 31 : 0) * 64;
#pragma unroll
                for (int i = 0; i < 4; ++i) { const int id = lane + 64 * i, row = id >> 2, ch = id & 3; const int t = dir ? (c0 + 63 - row) : (c0 + row);
                    const bf16_t* src = pb + (size_t)t * INC + h * 128 + 32 * pw + 8 * ch; rq[i] = *(const u32x4*)src; rf[i] = *(const u32x4*)(src + 512 + dir * 512); }
#pragma unroll
                for (int i = 0; i < 4; ++i) { const int id = pt + 256 * i, tau = id >> 4, ch = id & 15; const int t = dir ? (c0 + 63 - tau) : (c0 + tau);
                    rv[i] = *(const u32x4*)(pb + (size_t)t * INC + 1536 + h * 128 + 8 * ch); }
            }
#pragma unroll 1
            for (int k = -1; k <= 32; ++k) {
                const int lane = o_tid(WV) & 63, pt = pw * 64 + lane, cl = lane & 31, half = lane >> 5, c = 32 * pw + cl;
                LAS unsigned char* gn = lds + ((k + 1) & 1) * H2_BUF;
                if (k + 1 <= 31) {
#pragma unroll
                    for (int i = 0; i < 4; ++i) { const int id = lane + 64 * i, row = id >> 2, ch = id & 3;
                        *(LAS u32x4*)(gn + H2_QT + row * HG_QS + (32 * pw + 8 * ch) * 2) = rq[i]; *(LAS u32x4*)(gn + H2_KT + row * HG_QS + (32 * pw + 8 * ch) * 2) = rf[i]; }
#pragma unroll
                    for (int i = 0; i < 4; ++i) { const int id = pt + 256 * i, tau = id >> 4, ch = id & 15; *(LAS u32x4*)(gn + H2_VT + tau * HG_QS + ch * 16) = rv[i]; }
                    float pl = 1.0f;
#pragma unroll
                    for (int i = 0; i < 32; ++i) { const unsigned fraw = *(const LAS bf16_t*)(gn + H2_KT + (32 * half + i) * HG_QS + c * 2); pl = fmaxf(pl * __uint_as_float(fraw << 16), 1e-30f); }
                    const float po = __shfl_xor(pl, 32);
                    const float t0 = half ? po : pl, t1 = half ? pl : po;
                    const float fa = half ? 1.0f : __builtin_amdgcn_rcpf(t0), fb = half ? 1.0f : t0;
                    pl = 1.0f;
#pragma unroll
                    for (int i = 0; i < 32; ++i) { const int tau = 32 * half + i;
                        const unsigned qraw = *(const LAS bf16_t*)(gn + H2_QT + tau * HG_QS + c * 2), fraw = *(const LAS bf16_t*)(gn + H2_KT + tau * HG_QS + c * 2);
                        const float f = __uint_as_float(fraw << 16), qq = __uint_as_float(qraw << 16);
                        pl = fmaxf(pl * f, 1e-30f);
                        const float eq = pl * fa, ek = fb * __builtin_amdgcn_rcpf(pl);
                        const unsigned pk = pg8::cvt_pk_bf16(qq * eq, (1.0f - f) * ek);
                        *(LAS bf16_t*)(gn + H2_QT + tau * HG_QS + c * 2) = (bf16_t)(pk & 0xffffu);
                        *(LAS bf16_t*)(gn + H2_KT + tau * HG_QS + c * 2) = (bf16_t)(pk >> 16);
                        if ((i & 7) == 7) __builtin_amdgcn_sched_barrier(0); }
                    LAS float* srefn = (LAS float*)(gn + H2_MISC);
                    if (half == 0) srefn[c] = t0; else srefn[128 + c] = t1;
                }
                if (k + 2 <= 31) {
                    const int c0 = (dir ? (31 - (k + 2)) : (k + 2)) * 64;
#pragma unroll
                    for (int i = 0; i < 4; ++i) { const int id = lane + 64 * i, row = id >> 2, ch = id & 3; const int t = dir ? (c0 + 63 - row) : (c0 + row);
                        const bf16_t* src = pb + (size_t)t * INC + h * 128 + 32 * pw + 8 * ch; rq[i] = *(const u32x4*)src; rf[i] = *(const u32x4*)(src + 512 + dir * 512); }
#pragma unroll
                    for (int i = 0; i < 4; ++i) { const int id = pt + 256 * i, tau = id >> 4, ch = id & 15; const int t = dir ? (c0 + 63 - tau) : (c0 + tau);
                        rv[i] = *(const u32x4*)(pb + (size_t)t * INC + 1536 + h * 128 + 8 * ch); }
                }
                HG_BAR();
                if (k + 1 <= 31 && pw < 3) {
                    const int r = lane & 31, hh = lane >> 5;
                    const int st_ = (pw == 2) ? 1 : 0, tt_ = (pw == 0) ? 0 : 1;
                    f32x16 sa;
#pragma unroll
                    for (int i = 0; i < 16; ++i) sa[i] = 0.f;
#pragma unroll
                    for (int ks = 0; ks < 8; ++ks) {
                        const bf16x8 ka = *(const LAS bf16x8*)(gn + H2_KT + (32 * st_ + r) * HG_QS + (16 * ks + 8 * hh) * 2);
                        const bf16x8 qb = *(const LAS bf16x8*)(gn + H2_QT + (32 * tt_ + r) * HG_QS + (16 * ks + 8 * hh) * 2);
                        sa = __builtin_amdgcn_mfma_f32_32x32x16_bf16(ka, qb, sa, 0, 0, 0);
                    }
                    const int tau_abs = 32 * tt_ + r;
#pragma unroll
                    for (int rg = 0; rg < 4; ++rg) { float v4[4];
#pragma unroll
                        for (int i = 0; i < 4; ++i) { const int sig_abs = 32 * st_ + 8 * rg + 4 * hh + i; v4[i] = (sig_abs <= tau_abs) ? sa[4 * rg + i] : 0.f; }
                        u32x2 wv2; wv2.x = pg8::cvt_pk_bf16(v4[0], v4[1]); wv2.y = pg8::cvt_pk_bf16(v4[2], v4[3]);
                        *(LAS u32x2*)(gn + H2_ST + tau_abs * HG_SS + (32 * st_ + 8 * rg + 4 * hh) * 2) = wv2; }
                }
                HG_BAR();
            }
        }
        asm volatile("s_waitcnt vmcnt(0)" ::: "memory");
        __syncthreads();
        LAS int* flagp = (LAS int*)(lds + H2_FLAG);
        if (o_tid(WV) == 0) {
            __builtin_amdgcn_fence(__ATOMIC_RELEASE, "agent");
            asm volatile("s_waitcnt vmcnt(0)" ::: "memory");
            const int old = __hip_atomic_fetch_add(p.hdone + layer * 64 + b * 4 + h, 1, __ATOMIC_RELAXED, __HIP_MEMORY_SCOPE_AGENT);
            if (old == 1) { __builtin_amdgcn_fence(__ATOMIC_ACQUIRE, "agent"); asm volatile("s_waitcnt vmcnt(0)" ::: "memory"); }
            *flagp = old;
        }
        __syncthreads();
        if (*flagp == 1) {
            const int tid = o_tid(WV);
            bf16_t* yb = p.y + (size_t)b * SEQ * DM + h * 128; const bf16_t* obb = p.ob + (size_t)b * SEQ * 512 + h * 128; const bf16_t* gb = pb + 2048 + h * 128;
#pragma unroll 1
            for (int it = 0; it < (SEQ * 4) / NTHREADS; ++it) {
                const int piece = tid + NTHREADS * it, row = piece >> 2, seg = piece & 3;
                u32x4* yp = (u32x4*)(yb + (size_t)row * DM + seg * 32); const u32x4* op = (const u32x4*)(obb + (size_t)row * 512 + seg * 32); const u32x4* gp = (const u32x4*)(gb + (size_t)row * INC + seg * 32);
                u32x4 fv[4], bv[4], gv[4];
#pragma unroll
                for (int i = 0; i < 4; ++i) { fv[i] = yp[i]; bv[i] = op[i]; gv[i] = gp[i]; }
                __builtin_amdgcn_sched_barrier(0);
                f32x4 e[8]; float ss = 0.f;
#pragma unroll
                for (int i = 0; i < 4; ++i) {
                    e[2 * i][0] = __uint_as_float(fv[i].x << 16) + __uint_as_float(bv[i].x << 16); e[2 * i][1] = __uint_as_float(fv[i].x & 0xffff0000u) + __uint_as_float(bv[i].x & 0xffff0000u);
                    e[2 * i][2] = __uint_as_float(fv[i].y << 16) + __uint_as_float(bv[i].y << 16); e[2 * i][3] = __uint_as_float(fv[i].y & 0xffff0000u) + __uint_as_float(bv[i].y & 0xffff0000u);
                    e[2 * i + 1][0] = __uint_as_float(fv[i].z << 16) + __uint_as_float(bv[i].z << 16); e[2 * i + 1][1] = __uint_as_float(fv[i].z & 0xffff0000u) + __uint_as_float(bv[i].z & 0xffff0000u);
                    e[2 * i + 1][2] = __uint_as_float(fv[i].w << 16) + __uint_as_float(bv[i].w << 16); e[2 * i + 1][3] = __uint_as_float(fv[i].w & 0xffff0000u) + __uint_as_float(bv[i].w & 0xffff0000u);
                    const f32x4 q0 = e[2 * i] * e[2 * i], q1 = e[2 * i + 1] * e[2 * i + 1]; ss += (q0[0] + q0[1]) + (q0[2] + q0[3]) + (q1[0] + q1[1]) + (q1[2] + q1[3]); }
                ss += __shfl_xor(ss, 1); ss += __shfl_xor(ss, 2);
                const float rn = rsqrtf(ss * (1.0f / 128.0f) + 1e-6f);
#pragma unroll
                for (int i = 0; i < 4; ++i) { u32x4 o4;
                    o4.x = pg8::cvt_pk_bf16(e[2 * i][0] * rn * __uint_as_float(gv[i].x << 16), e[2 * i][1] * rn * __uint_as_float(gv[i].x & 0xffff0000u));
                    o4.y = pg8::cvt_pk_bf16(e[2 * i][2] * rn * __uint_as_float(gv[i].y << 16), e[2 * i][3] * rn * __uint_as_float(gv[i].y & 0xffff0000u));
                    o4.z = pg8::cvt_pk_bf16(e[2 * i + 1][0] * rn * __uint_as_float(gv[i].z << 16), e[2 * i + 1][1] * rn * __uint_as_float(gv[i].z & 0xffff0000u));
                    o4.w = pg8::cvt_pk_bf16(e[2 * i + 1][2] * rn * __uint_as_float(gv[i].w << 16), e[2 * i + 1][3] * rn * __uint_as_float(gv[i].w & 0xffff0000u));
                    yp[i] = o4; }
            }
        }
        __syncthreads();
    }
}

#define RT_STRIDE 1028
__device__ void ln_router_phase(int WV, const bf16_t* mix, bf16_t* xb, const float* g, const float* bta, const float* w1, const float* b1, const float* w2, const float* b2,
                                int* expert, float* gate, int* rank, int* hist  , int* slot_tok, LAS float* wl) {
    const int TID = o_tid(WV), BID = o_bid();
    LAS int* lhist = (LAS int*)((LAS unsigned char*)wl + 150 * 1024);
    if (TID < NEXP) lhist[TID] = 0;
    for (long i = (long)BID * NTHREADS + TID; i < PSLOTS; i += (long)gridDim.x * NTHREADS) slot_tok[i] = T_TOK;
    {
        f32x4 t1[2], t2[16];
#pragma unroll
        for (int m = 0; m < 2; ++m) t1[m] = ((const f32x4*)w1)[TID + NTHREADS * m];
#pragma unroll
        for (int m = 0; m < 16; ++m) t2[m] = ((const f32x4*)w2)[TID + NTHREADS * m];
        __builtin_amdgcn_sched_barrier(0);
#pragma unroll
        for (int m = 0; m < 2; ++m) { const int k = TID + NTHREADS * m;
#pragma unroll
            for (int i = 0; i < 4; ++i) wl[i * RT_STRIDE + k] = t1[m][i]; }
#pragma unroll
        for (int m = 0; m < 16; ++m) { const int q = TID + NTHREADS * m, k = q >> 3, o4 = (q & 7) * 4;
#pragma unroll
            for (int i = 0; i < 4; ++i) wl[(4 + o4 + i) * RT_STRIDE + k] = t2[m][i]; }
        if (TID < 32) wl[36 * RT_STRIDE + TID] = b2[TID];
    }
    __syncthreads();
    const int lane = TID & 63, gw = BID * NWAVES + (TID >> 6), ngw = gridDim.x * NWAVES;
    const LAS float* wlane = wl + 4 * lane;
    f32x4 gg[4], bb[4];
#pragma unroll
    for (int j = 0; j < 4; ++j) { gg[j] = ((const f32x4*)g)[lane + 64 * j]; bb[j] = ((const f32x4*)bta)[lane + 64 * j]; }
    float b1v[4];
#pragma unroll
    for (int o = 0; o < 4; ++o) b1v[o] = b1[o];
    long w = gw;
    u32x2 hb_[4], mx_[4];
    if (w < T_TOK) {
#pragma unroll
        for (int j = 0; j < 4; ++j) { hb_[j] = ((const u32x2*)(xb + w * DM))[lane + 64 * j]; mx_[j] = ((const u32x2*)(mix + w * DM))[lane + 64 * j]; } }
    for (; w < T_TOK; w += ngw) {
        u32x2 hn_[4], mn_[4]; const long wn = w + ngw;
        if (wn < T_TOK) {
#pragma unroll
            for (int j = 0; j < 4; ++j) { hn_[j] = ((const u32x2*)(xb + wn * DM))[lane + 64 * j]; mn_[j] = ((const u32x2*)(mix + wn * DM))[lane + 64 * j]; } }
        __builtin_amdgcn_sched_barrier(0);
        f32x4 v[4];
#pragma unroll
        for (int j = 0; j < 4; ++j) { v[j][0] = ALPHA * __uint_as_float(hb_[j].x << 16) + __uint_as_float(mx_[j].x << 16); v[j][1] = ALPHA * __uint_as_float(hb_[j].x & 0xffff0000u) + __uint_as_float(mx_[j].x & 0xffff0000u);
            v[j][2] = ALPHA * __uint_as_float(hb_[j].y << 16) + __uint_as_float(mx_[j].y << 16); v[j][3] = ALPHA * __uint_as_float(hb_[j].y & 0xffff0000u) + __uint_as_float(mx_[j].y & 0xffff0000u); }
        float s = 0.f;
#pragma unroll
        for (int j = 0; j < 4; ++j) s += (v[j][0] + v[j][1]) + (v[j][2] + v[j][3]);
        const float mu = wave_sum(s) * (1.0f / 1024.0f);
        float qq = 0.f;
#pragma unroll
        for (int j = 0; j < 4; ++j) { const f32x4 d = v[j] - mu; qq += (d[0] * d[0] + d[1] * d[1]) + (d[2] * d[2] + d[3] * d[3]); }
        const float r = rsqrtf(wave_sum(qq) * (1.0f / 1024.0f) + 1e-5f);
        u32x2* xp = (u32x2*)(xb + w * DM) + lane;
#pragma unroll
        for (int j = 0; j < 4; ++j) { v[j] = (v[j] - mu) * r * gg[j] + bb[j];
            u32x2 o; o.x = pg8::cvt_pk_bf16(v[j][0], v[j][1]); o.y = pg8::cvt_pk_bf16(v[j][2], v[j][3]); xp[64 * j] = o; }
        float l1[4];
#pragma unroll
        for (int o = 0; o < 4; ++o) { float sx = 0.f;
#pragma unroll
            for (int j = 0; j < 4; ++j) { const f32x4 ww = *(const LAS f32x4*)(wlane + o * RT_STRIDE + 256 * j); sx += (v[j][0] * ww[0] + v[j][1] * ww[1]) + (v[j][2] * ww[2] + v[j][3] * ww[3]); }
            l1[o] = sx; }
        wave_sum_n<4>(l1);
        int grp = 0; float mx = l1[0] + b1v[0];
#pragma unroll
        for (int o = 0; o < 4; ++o) l1[o] += b1v[o];
#pragma unroll
        for (int o = 1; o < 4; ++o) if (l1[o] > mx) { mx = l1[o]; grp = o; }
        grp = __builtin_amdgcn_readfirstlane(grp);
        float den = 0.f;
#pragma unroll
        for (int o = 0; o < 4; ++o) den += __expf(l1[o] - mx);
        const float pgrp = 1.0f / den;
        float l2[8];
        const LAS float* wg2 = wlane + (4 + grp * 8) * RT_STRIDE;
#pragma unroll
        for (int o = 0; o < 8; ++o) { float sx = 0.f;
#pragma unroll
            for (int j = 0; j < 4; ++j) { const f32x4 ww = *(const LAS f32x4*)(wg2 + o * RT_STRIDE + 256 * j); sx += (v[j][0] * ww[0] + v[j][1] * ww[1]) + (v[j][2] * ww[2] + v[j][3] * ww[3]); }
            l2[o] = sx; }
        wave_sum_n<8>(l2);
#pragma unroll
        for (int o = 0; o < 8; ++o) l2[o] += wl[36 * RT_STRIDE + grp * 8 + o];
        int e0 = 0; float m0 = l2[0];
#pragma unroll
        for (int o = 1; o < 8; ++o) if (l2[o] > m0) { m0 = l2[o]; e0 = o; }
        int e1 = -1; float m1 = -3.0e38f;
#pragma unroll
        for (int o = 0; o < 8; ++o) if (o != e0 && l2[o] > m1) { m1 = l2[o]; e1 = o; }
        const float rr = __expf(m1 - m0);
        const float wa = 1.0f / (1.0f + rr), wb = rr / (1.0f + rr);
        if (lane == 0) {
            const int ea = grp * 8 + e0, eb = grp * 8 + e1;
            expert[w * 2] = ea; expert[w * 2 + 1] = eb;
            gate[w * 2] = pgrp * wa; gate[w * 2 + 1] = pgrp * wb;
            rank[w * 2] = __hip_atomic_fetch_add(lhist + ea, 1, __ATOMIC_RELAXED, __HIP_MEMORY_SCOPE_WORKGROUP);
            rank[w * 2 + 1] = __hip_atomic_fetch_add(lhist + eb, 1, __ATOMIC_RELAXED, __HIP_MEMORY_SCOPE_WORKGROUP);
        }
#pragma unroll
        for (int j = 0; j < 4; ++j) { hb_[j] = hn_[j]; mx_[j] = mn_[j]; }
    }
    __syncthreads();
    if (TID < NEXP) hist[BID * NEXP + TID] = lhist[TID];
}
__device__ void moe_tables(int WV, const int* hist, int* lds_pstart, int* lds_tile_exp) {
    const int TID = o_tid(WV), BID = o_bid();
    int* tot = lds_pstart + 384; int* part = lds_pstart + 416; int* base = lds_pstart + 448;
    if (TID < 64) tot[TID] = 0;
    __syncthreads();
    const int nent = gridDim.x * NEXP;
    int tl = 0, pl = 0;
    for (int i0 = TID; i0 < nent; i0 += 16 * NTHREADS) {
        int vv_[16];
#pragma unroll
        for (int k = 0; k < 16; ++k) { const int i = i0 + k * NTHREADS; vv_[k] = (i < nent) ? __hip_atomic_load(hist + i, __ATOMIC_RELAXED, __HIP_MEMORY_SCOPE_AGENT) : 0; }
#pragma unroll
        for (int k = 0; k < 16; ++k) { const int i = i0 + k * NTHREADS; tl += vv_[k]; if ((i >> 5) < BID) pl += vv_[k]; }
    }
    __hip_atomic_fetch_add(tot + (TID & 31), tl, __ATOMIC_RELAXED, __HIP_MEMORY_SCOPE_WORKGROUP);
    __hip_atomic_fetch_add(part + (TID & 31), pl, __ATOMIC_RELAXED, __HIP_MEMORY_SCOPE_WORKGROUP);
    __syncthreads();
    if (TID == 0) {
        int acc = 0;
#pragma unroll 1
        for (int e = 0; e < NEXP; ++e) { lds_pstart[e] = acc; base[e] = acc + part[e]; const int nt = (tot[e] + 255) >> 8;
#pragma unroll 1
            for (int t = 0; t < nt; ++t) lds_tile_exp[(acc >> 8) + t] = e; acc += nt * 256; }
#pragma unroll 1
        for (int t = acc >> 8; t < NTILES; ++t) lds_tile_exp[t] = -1;
        lds_pstart[32] = acc >> 8;
    }
    __syncthreads();
}
__device__ void moe_scatter_phase(int WV, const int* expert, const int* rank, const int* lds_pstart, int* slot_tok, int* dest) {
    const int TID = o_tid(WV), BID = o_bid();
    const int* base = lds_pstart + 448;
    const int ngw = gridDim.x * NWAVES;
    for (int a = TID; a < 2 * NWAVES * ((T_TOK + ngw - 1) / ngw); a += NTHREADS) {
        const int r = a >> 1, k = a & 1;
        const long w = (long)(BID * NWAVES + (r & 7)) + (long)ngw * (r >> 3);
        if (w < T_TOK) { const long i = w * 2 + k; const int s = base[expert[i]] + rank[i]; dest[i] = s; slot_tok[s] = (int)w; }
    }
}
__device__ void moe_combine_ln_phase(int WV, float* h, bf16_t* xb, const bf16_t* ys, const int* dest, const float* gate, const float* g, const float* bta, bool write_xb) {
    const int TID = o_tid(WV), BID = o_bid();
    const int lane = TID & 63, gw = BID * NWAVES + (TID >> 6), ngw = gridDim.x * NWAVES;
    f32x4 gg[4], bb[4];
#pragma unroll
    for (int j = 0; j < 4; ++j) { gg[j] = ((const f32x4*)g)[lane + 64 * j]; bb[j] = ((const f32x4*)bta)[lane + 64 * j]; }
    if (ngw * 16 != T_TOK) {
        long w = gw;
        int d0n = 0, d1n = 0; float g0n = 0.f, g1n = 0.f;
        u32x2 hv[4]; u32x2 ya[4], yb[4]; float g0 = 0.f, g1 = 0.f;
        if (w < T_TOK) { const int d0 = dest[w * 2], d1 = dest[w * 2 + 1]; g0 = gate[w * 2]; g1 = gate[w * 2 + 1];
    #pragma unroll
            for (int j = 0; j < 4; ++j) { hv[j] = ((const u32x2*)(xb + w * DM))[lane + 64 * j]; ya[j] = ((const u32x2*)(ys + (long)d0 * DM))[lane + 64 * j]; yb[j] = ((const u32x2*)(ys + (long)d1 * DM))[lane + 64 * j]; } }
        if (w + ngw < T_TOK) { d0n = dest[(w + ngw) * 2]; d1n = dest[(w + ngw) * 2 + 1]; g0n = gate[(w + ngw) * 2]; g1n = gate[(w + ngw) * 2 + 1]; }
        for (; w < T_TOK; w += ngw) {
            u32x2 hn[4]; u32x2 yan[4], ybn[4]; const float g0c = g0n, g1c = g1n;
            const long wn = w + ngw, wnn = w + 2 * (long)ngw;
            if (wn < T_TOK) {
    #pragma unroll
                for (int j = 0; j < 4; ++j) { hn[j] = ((const u32x2*)(xb + wn * DM))[lane + 64 * j]; yan[j] = ((const u32x2*)(ys + (long)d0n * DM))[lane + 64 * j]; ybn[j] = ((const u32x2*)(ys + (long)d1n * DM))[lane + 64 * j]; } }
            if (wnn < T_TOK) { d0n = dest[wnn * 2]; d1n = dest[wnn * 2 + 1]; g0n = gate[wnn * 2]; g1n = gate[wnn * 2 + 1]; }
            __builtin_amdgcn_sched_barrier(0);
            f32x4 v[4]; float s = 0.f;
    #pragma unroll
            for (int j = 0; j < 4; ++j) {
                v[j][0] = ALPHA * __uint_as_float(hv[j].x << 16) + g0 * __uint_as_float(ya[j].x << 16) + g1 * __uint_as_float(yb[j].x << 16);
                v[j][1] = ALPHA * __uint_as_float(hv[j].x & 0xffff0000u) + g0 * __uint_as_float(ya[j].x & 0xffff0000u) + g1 * __uint_as_float(yb[j].x & 0xffff0000u);
                v[j][2] = ALPHA * __uint_as_float(hv[j].y << 16) + g0 * __uint_as_float(ya[j].y << 16) + g1 * __uint_as_float(yb[j].y << 16);
                v[j][3] = ALPHA * __uint_as_float(hv[j].y & 0xffff0000u) + g0 * __uint_as_float(ya[j].y & 0xffff0000u) + g1 * __uint_as_float(yb[j].y & 0xffff0000u);
                s += (v[j][0] + v[j][1]) + (v[j][2] + v[j][3]); }
            const float mu = wave_sum(s) * (1.0f / 1024.0f);
            float qq = 0.f;
    #pragma unroll
            for (int j = 0; j < 4; ++j) { const f32x4 d = v[j] - mu; qq += (d[0] * d[0] + d[1] * d[1]) + (d[2] * d[2] + d[3] * d[3]); }
            const float r = rsqrtf(wave_sum(qq) * (1.0f / 1024.0f) + 1e-5f);
    #pragma unroll
            for (int j = 0; j < 4; ++j) { const f32x4 o = (v[j] - mu) * r * gg[j] + bb[j]; if (!write_xb) ((f32x4*)(h + w * DM))[lane + 64 * j] = o;
                if (write_xb) { u32x2 ob; ob.x = pg8::cvt_pk_bf16(o[0], o[1]); ob.y = pg8::cvt_pk_bf16(o[2], o[3]); ((u32x2*)(xb + w * DM))[lane + 64 * j] = ob; } }
    #pragma unroll
            for (int j = 0; j < 4; ++j) { hv[j] = hn[j]; ya[j] = yan[j]; yb[j] = ybn[j]; }
            g0 = g0c; g1 = g1c;
        }
        return;
    }
    int dv0 = 0, dv1 = 0; float gv0 = 0.f, gv1 = 0.f;
    { const long wr = gw + (long)(lane & 15) * ngw; if (wr < T_TOK) { dv0 = dest[wr * 2]; dv1 = dest[wr * 2 + 1]; gv0 = gate[wr * 2]; gv1 = gate[wr * 2 + 1]; } }
    u32x2 hv[2][4]; u32x2 ya[2][4], yb[2][4];
#define CMB_LOAD(HV, YA, YB, i_) do { _Pragma("unroll") for (int q_ = 0; q_ < 2; ++q_) { const int ii_ = (i_) + 8 * q_; const long wq_ = gw + (long)ii_ * ngw; \
        const int d0_ = __builtin_amdgcn_readlane(dv0, ii_), d1_ = __builtin_amdgcn_readlane(dv1, ii_); \
        _Pragma("unroll") for (int j = 0; j < 4; ++j) { HV[q_][j] = ((const u32x2*)(xb + wq_ * DM))[lane + 64 * j]; YA[q_][j] = ((const u32x2*)(ys + (long)d0_ * DM))[lane + 64 * j]; YB[q_][j] = ((const u32x2*)(ys + (long)d1_ * DM))[lane + 64 * j]; } } } while (0)
    CMB_LOAD(hv, ya, yb, 0);
#pragma unroll 1
    for (int i = 0; i < 8; ++i) {
        u32x2 hn[2][4]; u32x2 yan[2][4], ybn[2][4];
        if (i < 7) CMB_LOAD(hn, yan, ybn, i + 1);
        __builtin_amdgcn_sched_barrier(0);
#pragma unroll
        for (int q = 0; q < 2; ++q) {
            const int ii = i + 8 * q; const long w = gw + (long)ii * ngw;
            const float g0 = __int_as_float(__builtin_amdgcn_readlane(__float_as_int(gv0), ii)), g1 = __int_as_float(__builtin_amdgcn_readlane(__float_as_int(gv1), ii));
            f32x4 v[4]; float s = 0.f;
#pragma unroll
            for (int j = 0; j < 4; ++j) {
                v[j][0] = ALPHA * __uint_as_float(hv[q][j].x << 16) + g0 * __uint_as_float(ya[q][j].x << 16) + g1 * __uint_as_float(yb[q][j].x << 16);
                v[j][1] = ALPHA * __uint_as_float(hv[q][j].x & 0xffff0000u) + g0 * __uint_as_float(ya[q][j].x & 0xffff0000u) + g1 * __uint_as_float(yb[q][j].x & 0xffff0000u);
                v[j][2] = ALPHA * __uint_as_float(hv[q][j].y << 16) + g0 * __uint_as_float(ya[q][j].y << 16) + g1 * __uint_as_float(yb[q][j].y << 16);
                v[j][3] = ALPHA * __uint_as_float(hv[q][j].y & 0xffff0000u) + g0 * __uint_as_float(ya[q][j].y & 0xffff0000u) + g1 * __uint_as_float(yb[q][j].y & 0xffff0000u);
                s += (v[j][0] + v[j][1]) + (v[j][2] + v[j][3]); }
            const float mu = wave_sum(s) * (1.0f / 1024.0f);
            float qq = 0.f;
#pragma unroll
            for (int j = 0; j < 4; ++j) { const f32x4 d = v[j] - mu; qq += (d[0] * d[0] + d[1] * d[1]) + (d[2] * d[2] + d[3] * d[3]); }
            const float r = rsqrtf(wave_sum(qq) * (1.0f / 1024.0f) + 1e-5f);
#pragma unroll
            for (int j = 0; j < 4; ++j) { const f32x4 o = (v[j] - mu) * r * gg[j] + bb[j]; if (!write_xb) ((f32x4*)(h + w * DM))[lane + 64 * j] = o;
                if (write_xb) { u32x2 ob; ob.x = pg8::cvt_pk_bf16(o[0], o[1]); ob.y = pg8::cvt_pk_bf16(o[2], o[3]); ((u32x2*)(xb + w * DM))[lane + 64 * j] = ob; } }
        }
#pragma unroll
        for (int q = 0; q < 2; ++q)
#pragma unroll
            for (int j = 0; j < 4; ++j) { hv[q][j] = hn[q][j]; ya[q][j] = yan[q][j]; yb[q][j] = ybn[q][j]; }
    }
#undef CMB_LOAD
}

#define XB_TMO      128
#define XB_XCNT(j)  (256  + 64 * (j))
#define XB_XSUB(j)  (1280 + 64 * (j))
#define XB_XGEN(j)  (2304 + 64 * (j))
#define XB_TOP      3328
#define XB_TOPGEN   3392
#define XCD_BAR_WORDS 3456
#define XB_SPIN_CAP (1u << 22)
__device__ __forceinline__ unsigned xb_ld(unsigned* p)              { return __hip_atomic_load(p, __ATOMIC_RELAXED, __HIP_MEMORY_SCOPE_AGENT); }
__device__ __forceinline__ unsigned xb_add(unsigned* p, unsigned v) { return __hip_atomic_fetch_add(p, v, __ATOMIC_RELAXED, __HIP_MEMORY_SCOPE_AGENT); }
__device__ __forceinline__ unsigned xb_xcc_id() { return (unsigned)__builtin_amdgcn_s_getreg((3 << 11) | 20) & 0xFu; }
#define XB_SPIN(cond, bar) do { unsigned _sp = 0; while (cond) { __builtin_amdgcn_s_sleep(1); \
    if ((++_sp & 255u) == 0u) { if (xb_ld(&(bar)[XB_TMO])) break; if (_sp > XB_SPIN_CAP) { atomicAdd(&(bar)[XB_TMO], 1u); break; } } } } while (0)
struct XcdBarrier { unsigned* bar; unsigned x; volatile LAS unsigned* st; };
__device__ __forceinline__ XcdBarrier xcd_barrier_post(unsigned* bar, volatile LAS unsigned* st, bool leader) {
    XcdBarrier b; b.bar = bar; b.x = xb_xcc_id(); b.st = st;
    if (leader) st[2] = xb_add(&bar[XB_XCNT(b.x)], 1u);
    return b;
}
__device__ __forceinline__ void xcd_barrier_complete(unsigned* bar, unsigned x, unsigned& nloc, unsigned& nx, unsigned& before) {
    const unsigned G = gridDim.x * gridDim.y * gridDim.z;
    unsigned sum, cnt, mine, bef, sp = 0u;
    for (;;) {
        sum = 0u; cnt = 0u; mine = 0u; bef = 0u;
#pragma unroll
        for (unsigned j = 0; j < 16; ++j) { const unsigned c = xb_ld(&bar[XB_XCNT(j)]); sum += c; cnt += (c > 0u) ? 1u : 0u; mine = (j == x) ? c : mine; bef += (j < x) ? c : 0u; }
        if (sum == G) break;
        __builtin_amdgcn_s_sleep(1);
        if ((++sp & 255u) == 0u) { if (xb_ld(&bar[XB_TMO])) break; if (sp > XB_SPIN_CAP) { atomicAdd(&bar[XB_TMO], 1u); break; } }
    }
    nloc = mine > 0u ? mine : 1u; nx = cnt > 0u ? cnt : 1u; before = bef;
}
__device__ __forceinline__ void xcd_barrier(const XcdBarrier& b, bool leader) {
    asm volatile("s_waitcnt vmcnt(0)" ::: "memory");
    __syncthreads();
    if (leader) {
        unsigned* bar = b.bar;
        __builtin_amdgcn_s_waitcnt(0);
        unsigned nloc = b.st[0], nx = b.st[1];
        if (nloc == 0u) { unsigned bef; xcd_barrier_complete(bar, b.x, nloc, nx, bef); b.st[0] = nloc; b.st[1] = nx; b.st[3] = bef; }
        const unsigned old = xb_add(&bar[XB_XSUB(b.x)], 1u);
        const unsigned gen = old / nloc;
        if (old + 1u == (gen + 1u) * nloc) {
            __builtin_amdgcn_fence(__ATOMIC_RELEASE, "agent");
            asm volatile("s_waitcnt vmcnt(0)" ::: "memory");
            const unsigned og = xb_add(&bar[XB_TOP], 1u);
            const unsigned tg = og / nx;
            if (og + 1u == (tg + 1u) * nx) xb_add(&bar[XB_TOPGEN], 1u);
            else XB_SPIN(xb_ld(&bar[XB_TOPGEN]) == tg, bar);
            __builtin_amdgcn_fence(__ATOMIC_ACQUIRE, "agent");
            xb_add(&bar[XB_XGEN(b.x)], 1u);
            asm volatile("s_waitcnt vmcnt(0)" ::: "memory");
        } else {
            XB_SPIN(xb_ld(&bar[XB_XGEN(b.x)]) == gen, bar);
            __builtin_amdgcn_fence(__ATOMIC_ACQUIRE, "agent");
            asm volatile("s_waitcnt vmcnt(0)" ::: "memory");
        }
    }
    __syncthreads();
}

__global__ void __launch_bounds__(NTHREADS, 2) fwd_megakernel(Params p) {
    extern __shared__ __attribute__((aligned(16))) unsigned char lds_raw[];
    cg::grid_group grid = cg::this_grid();
    const int WV = __builtin_amdgcn_readfirstlane(threadIdx.x >> 6);
    float* lds = (float*)lds_raw;
    LAS unsigned char* ldsl = (LAS unsigned char*)lds_raw;
    int* lds_pstart = (int*)(lds_raw + LDS_TAB_OFF);
    int* lds_tile_exp = lds_pstart + 64;
    int* lds_tok = lds_pstart + 512;
    volatile LAS unsigned* xst = (volatile LAS unsigned*)(lds_raw + LDS_BYTES - 16);
    const bool xlead = (o_tid(WV) == 0);
    if (xlead) { xst[0] = 0u; xst[1] = 0u; }
    __syncthreads();
    const XcdBarrier xb = xcd_barrier_post(p.bar, xst, xlead);
    rope_table_phase(WV, p.rope_tab, p.lbtab, p.lb_logits);
    convert_dense_phase(WV, p, ldsl);
    grid.sync();
#pragma unroll 1
    for (int l = 0; l < 2; ++l) {
        { pg8::Gemm g{p.xb, p.wt_in + (size_t)l * INC * DM, DM, 0, nullptr}; pg8::StaticOrder S; S.init(T_TOK, INC, gridDim.x, o_bid());
          pg8::EpiInProj E{p.proj, p.rope_tab, p.lbtab + l * 1024, p.norm_g + l * 512};
          pg8::gemm_phase<pg8::EpiInProj, pg8::StaticOrder, false>(WV, ldsl, g, S, E, nullptr, (int)((2u * xb.x) & 15u)); }
        xcd_barrier(xb, o_tid(WV) == 0);
        hgrn2_phase(WV, p, l, ldsl);
        attn_phase(WV, p, l, p.proj, p.y, ldsl, p.counts + 128 + l);
        xcd_barrier(xb, o_tid(WV) == 0);
        { pg8::Gemm g{p.y, p.wt_out + (size_t)l * DM * DM, DM, 0, nullptr}; pg8::StaticOrder S; S.init(T_TOK, DM, gridDim.x, o_bid());
          pg8::EpiBf16Plain E{p.mix, DM};
          pg8::gemm_phase<pg8::EpiBf16Plain, pg8::StaticOrder, false>(WV, ldsl, g, S, E, nullptr, (int)((2u * xb.x) & 15u)); }
        xcd_barrier(xb, o_tid(WV) == 0);
        ln_router_phase(WV, p.mix, p.xb, p.ln1_g + l * DM, p.ln1_b + l * DM, p.rw1 + l * DM * 4, p.rb1 + l * 4, p.rw2 + l * DM * 32, p.rb2 + l * 32, p.expert, p.gate, p.rank, p.hist, p.slot_tok, (LAS float*)ldsl);
        xcd_barrier(xb, o_tid(WV) == 0);
        moe_tables(WV, p.hist, lds_pstart, lds_tile_exp);
        moe_scatter_phase(WV, p.expert, p.rank, lds_pstart, p.slot_tok, p.dest);
        xcd_barrier(xb, o_tid(WV) == 0);
        { const int xn = (int)xst[0], xr = (int)xst[2], xbef = (int)xst[3];
          { pg8::Gemm g{p.xb, p.wt_gu, DM, (long)DM * DM, p.slot_tok}; pg8::MoeOrderPub S; S.init(lds_pstart[32], 4, xn, xr, xbef, gridDim.x, lds_tile_exp); S.cnt = p.mcnt + l * NTILES;
            pg8::EpiGateUp E{p.hid};
            { const int t0 = o_tid(WV); pg8::Unit u; for (int i = 0; S.next(i, u); ++i) { if (t0 < 256) lds_tok[i * 256 + t0] = p.slot_tok[u.pm * 256 + t0]; } }
            __syncthreads();
            pg8::gemm_phase<pg8::EpiGateUp, pg8::MoeOrderPub, true>(WV, ldsl, g, S, E, (const LAS int*)lds_tok); }
          { pg8::Gemm g{p.hid, p.wt_dn, DEXP, (long)DM * DEXP, nullptr}; pg8::MoeOrderWait S; S.init(lds_pstart[32], 4, xn, (xr + xn / 2) % xn, xbef, gridDim.x, lds_tile_exp); S.cnt = p.mcnt + l * NTILES;
            S.pollw = (LAS int*)(lds_raw + LDS_BYTES - 32);
            pg8::EpiBf16Plain E{p.ys, DM};
            pg8::gemm_phase<pg8::EpiBf16Plain, pg8::MoeOrderWait, false>(WV, ldsl, g, S, E, nullptr); } }
        xcd_barrier(xb, o_tid(WV) == 0);
        moe_combine_ln_phase(WV, p.hbuf, p.xb, p.ys, p.dest, p.gate, p.ln2_g + l * DM, p.ln2_b + l * DM, l == 0);
        if (l == 0) xcd_barrier(xb, o_tid(WV) == 0);
    }
}

extern "C" void kernel_launch(void* const* d_in, const int* in_sizes, int n_in, void* d_out, int out_size, void* d_ws, size_t ws_size, hipStream_t stream) {
    static int grid_blocks = 0;
    if (!grid_blocks) {
        int dev = 0, cus = 0, per_cu = 0;
        (void)hipGetDevice(&dev);
        (void)hipDeviceGetAttribute(&cus, hipDeviceAttributeMultiprocessorCount, dev);
        (void)hipFuncSetAttribute((const void*)fwd_megakernel, hipFuncAttributeMaxDynamicSharedMemorySize, LDS_BYTES);
        (void)hipOccupancyMaxActiveBlocksPerMultiprocessor(&per_cu, (const void*)fwd_megakernel, NTHREADS, LDS_BYTES);
        if (per_cu < 1) { fprintf(stderr, "occupancy query says %d blocks/CU\n", per_cu); per_cu = 1; }
        grid_blocks = cus;
        fprintf(stderr, "megakernel: cus=%d per_cu=%d grid=%d\n", cus, per_cu, grid_blocks);
    }
    Params p{};
    p.x = (const float*)d_in[0]; p.w_in = (const float*)d_in[1]; p.lb_logits = (const float*)d_in[2]; p.norm_g = (const float*)d_in[3]; p.w_out = (const float*)d_in[4];
    p.ln1_g = (const float*)d_in[5]; p.ln1_b = (const float*)d_in[6]; p.rw1 = (const float*)d_in[7]; p.rb1 = (const float*)d_in[8]; p.rw2 = (const float*)d_in[9]; p.rb2 = (const float*)d_in[10];
    p.wg = (const float*)d_in[11]; p.wu = (const float*)d_in[12]; p.wd = (const float*)d_in[13]; p.ln2_g = (const float*)d_in[14]; p.ln2_b = (const float*)d_in[15];
    p.hbuf = (float*)d_out;
    char* ws = (char*)d_ws;
    size_t off = 0;
    auto take = [&](size_t bytes) { char* q = ws + off; off += (bytes + 255) & ~(size_t)255; return q; };
    p.counts = (int*)take(4096);
    p.bar = (unsigned*)take((size_t)XCD_BAR_WORDS * 4);
    p.hist = (int*)take((size_t)1024 * NEXP * 4);
    p.rope_tab = (float2*)take((size_t)SEQ * 8 * 8);
    p.lbtab = (float*)take((size_t)2 * 2 * 512 * 4);
    p.expert = (int*)take((size_t)T_TOK * 2 * 4);
    p.rank = (int*)take((size_t)T_TOK * 2 * 4);
    p.gate = (float*)take((size_t)T_TOK * 2 * 4);
    p.dest = (int*)take((size_t)T_TOK * 2 * 4);
    p.slot_tok = (int*)take((size_t)PSLOTS * 4);
    p.wt_in = (bf16_t*)take((size_t)2 * INC * DM * 2);
    p.wt_out = (bf16_t*)take((size_t)2 * DM * DM * 2);
    p.xb = (bf16_t*)take((size_t)T_TOK * DM * 2);
    char* big = take(0);
    p.proj = (bf16_t*)big;
    p.y = (bf16_t*)(big + (size_t)T_TOK * INC * 2);
    p.o_f = (float*)(big + (size_t)T_TOK * INC * 2 + (size_t)T_TOK * DM * 2);
    p.o_b = p.o_f + (size_t)T_TOK * 512;
    char* moe = big + (size_t)T_TOK * INC * 2 + (size_t)T_TOK * DM * 2;
    p.wt_gu = (bf16_t*)moe;
    p.wt_dn = (bf16_t*)(moe + (size_t)NEXP * DM * DM * 2);
    p.ob = (bf16_t*)(moe + (size_t)NEXP * DM * DM * 2 + (size_t)NEXP * DM * DEXP * 2);
    p.hdone = p.counts;
    p.mcnt = p.counts + 256;
    p.hid = (bf16_t*)big;
    p.mix = (bf16_t*)big;
    p.ys = (bf16_t*)(big + (size_t)PSLOTS * DEXP * 2);
    if (off + (size_t)T_TOK * INC * 2 + (size_t)T_TOK * DM * 2 + (size_t)T_TOK * 512 * 8 > ws_size) fprintf(stderr, "workspace too small: %zu\n", ws_size);
    (void)hipMemsetAsync(p.counts, 0, 4096 + (((size_t)XCD_BAR_WORDS * 4 + 255) & ~(size_t)255), stream);
    void* args[] = {&p};
    hipError_t e = hipLaunchCooperativeKernel((const void*)fwd_megakernel, dim3(grid_blocks), dim3(NTHREADS), args, LDS_BYTES, stream);
    if (e != hipSuccess) fprintf(stderr, "cooperative launch failed: %s (grid %d)\n", hipGetErrorString(e), grid_blocks);
}
```

```cpp
#include <hip/hip_runtime.h>
#include <hip/hip_cooperative_groups.h>
#include <stdint.h>
#include <stdio.h>
namespace cg = cooperative_groups;

#define T_TOK 32768
#define DM 1024
#define SEQ 2048
#define NB 16
#define INC 4096
#define NEXP 32
#define DEXP 512
#define PSLOTS ((T_TOK * 2 / 256 + NEXP) * 256)
#define NTILES (PSLOTS / 256)
#define ALPHA 1.41421356237309515f
#define ATT_VPRE 5
#define NTHREADS 512
#define NWAVES 8
#define LDS_BYTES (152 * 1024)
#define LDS_TAB_OFF (144 * 1024)

typedef unsigned short bf16_t;
__device__ __forceinline__ float bf2f(bf16_t b) { return __uint_as_float(((unsigned)b) << 16); }
__device__ __forceinline__ bf16_t f2bf(float f) { unsigned u = __float_as_uint(f); u += 0x7FFFu + ((u >> 16) & 1u); return (bf16_t)(u >> 16); }
template <int CTRL> __device__ __forceinline__ float dppf(float v) { return __int_as_float(__builtin_amdgcn_update_dpp(0, __float_as_int(v), CTRL, 0xf, 0xf, true)); }
__device__ __forceinline__ float wave_sum(float v) {
    v += dppf<0xB1>(v);
    v += dppf<0x4E>(v);
    v += dppf<0x141>(v);
    v += dppf<0x140>(v);
    const int vi = __float_as_int(v);
    return (__int_as_float(__builtin_amdgcn_readlane(vi, 0)) + __int_as_float(__builtin_amdgcn_readlane(vi, 16))) + (__int_as_float(__builtin_amdgcn_readlane(vi, 32)) + __int_as_float(__builtin_amdgcn_readlane(vi, 48)));
}
__device__ __forceinline__ int o_tid(int wv) { int l; asm volatile("v_mbcnt_lo_u32_b32 %0, -1, 0\n\tv_mbcnt_hi_u32_b32 %0, -1, %0" : "=v"(l)); return wv * 64 + l; }
__device__ __forceinline__ int o_bid() { int b = blockIdx.x; asm volatile("" : "+s"(b)); return b; }
template <int N> __device__ __forceinline__ void wave_sum_n(float (&s)[N]) {
#pragma unroll
    for (int i = 0; i < N; ++i) s[i] = wave_sum(s[i]);
}
__device__ __forceinline__ float siluf(float x) { return x * __builtin_amdgcn_rcpf(1.0f + __expf(-x)); }

struct Params {
    const float* x; const float* w_in; const float* lb_logits; const float* norm_g; const float* w_out; const float* ln1_g; const float* ln1_b;
    const float* rw1; const float* rb1; const float* rw2; const float* rb2; const float* wg; const float* wu; const float* wd; const float* ln2_g; const float* ln2_b;
    float* hbuf;
    int* counts;
    int* hist;
    unsigned* bar;
    float2* rope_tab;
    float* lbtab;
    int* expert; int* rank; float* gate; int* dest; int* slot_tok;
    bf16_t* proj; bf16_t* y; float* o_f; float* o_b; bf16_t* hid; bf16_t* ys;
    bf16_t* xb;
    bf16_t* mix;
    bf16_t* ob;
    int* hdone;
    int* mcnt;
    bf16_t* wt_in;
    bf16_t* wt_out;
    bf16_t* wt_gu;
    bf16_t* wt_dn;
};

#define LAS __attribute__((address_space(3)))
typedef short bf16x8 __attribute__((ext_vector_type(8)));
typedef float f32x4 __attribute__((ext_vector_type(4)));
typedef unsigned u32x4 __attribute__((ext_vector_type(4)));
typedef unsigned u32x2 __attribute__((ext_vector_type(2)));
namespace pg8 {
constexpr int BM = 256, BK = 64, HALF = 128, HTB = HALF * BK * 2, STAGE_BYTES = 8 * HTB, NXCD = 8, WGM = 8;
__device__ __forceinline__ int lds_byte(int r, int c) { const int st = (r >> 4) * 2 + (c >> 5), rr = r & 15, cc = c & 31, ob = rr * 64 + cc * 2; return st * 1024 + (ob ^ (((ob >> 9) & 1) << 5)); }
__device__ __forceinline__ void stage_rc(int b, int& R, int& C) { const int st = b / 1024, sb = b % 1024, swz = sb ^ (((sb >> 9) & 1) << 5); R = (st >> 1) * 16 + swz / 64; C = (st & 1) * 32 + (swz % 64) / 2; }
__device__ __forceinline__ int perm32(int rho) { const int n = rho >> 4, i = rho & 15; return 8 * (i >> 2) + 4 * n + (i & 3); }
__device__ __forceinline__ unsigned cvt_pk_bf16(float lo, float hi) { unsigned r; asm volatile("v_cvt_pk_bf16_f32 %0, %1, %2" : "=v"(r) : "v"(lo), "v"(hi)); return r; }

__device__ __forceinline__ int regroup_src(int fr, int fq) { const int lane = fr + 16 * fq; return ((lane >> 2) + 16 * (lane & 3)) << 2; }
__device__ __forceinline__ u32x4 regroup(const u32x4 w, int src4) { u32x4 r; r.x = (unsigned)__builtin_amdgcn_ds_bpermute(src4, (int)w.x); r.y = (unsigned)__builtin_amdgcn_ds_bpermute(src4, (int)w.y);
    r.z = (unsigned)__builtin_amdgcn_ds_bpermute(src4, (int)w.z); r.w = (unsigned)__builtin_amdgcn_ds_bpermute(src4, (int)w.w); return r; }
__device__ __forceinline__ u32x2 regroup(const u32x2 w, int src4) { u32x2 r; r.x = (unsigned)__builtin_amdgcn_ds_bpermute(src4, (int)w.x); r.y = (unsigned)__builtin_amdgcn_ds_bpermute(src4, (int)w.y); return r; }
struct Unit { int pm, pn, e; };
struct Gemm { const bf16_t* A; const bf16_t* Bt; int K; long bstride; const int* rowidx; };

struct StaticOrder {
    int nM, nN, nwg, G, c;
    __device__ void init(int M, int N, int G_, int c_) { nM = M / BM; nN = N / BM; nwg = nM * nN; G = G_; c = c_; }
    __device__ bool next(int i, Unit& u) const {
        const long L = (long)i * G + c; if (L >= nwg) return false;
        int wgid = (int)L; { const int q = nwg / NXCD, r = nwg % NXCD, xcd = wgid % NXCD, off = wgid / NXCD; wgid = (xcd < r ? xcd * (q + 1) : r * (q + 1) + (xcd - r) * q) + off; }
        const int nig = WGM * nN, gid = wgid / nig, fm = gid * WGM, gsz = (nM - fm) < WGM ? (nM - fm) : WGM;
        u.pm = fm + ((wgid % nig) % gsz); u.pn = (wgid % nig) / gsz; u.e = 0; return true;
    }
    static constexpr bool WAITS = false;
    __device__ __forceinline__ void a_ready(const Unit&, int, int) const {}
    __device__ __forceinline__ void done(const Unit&, int) const {}
};
struct MoeOrder {
    static constexpr bool WAITS = false;
    int nN, nwg, G, c, u0; const int* tile_exp;
    __device__ void init(int nact, int nN_, int nloc, int rank, int before, int Gtot, const int* te) {
        const int t0 = (int)((long)nact * before / Gtot), t1 = (int)((long)nact * (before + nloc) / Gtot);
        nN = nN_; u0 = t0 * nN_; nwg = (t1 - t0) * nN_; G = nloc; c = rank; tile_exp = te; }
    __device__ bool next(int i, Unit& u) const {
        const long L = (long)i * G + c; if (L >= nwg) return false;
        const int wgid = u0 + (int)L;
        u.pm = wgid / nN; u.pn = wgid % nN; u.e = tile_exp[u.pm]; return true;
    }
    __device__ __forceinline__ void a_ready(const Unit&, int, int) const {}
    __device__ __forceinline__ void done(const Unit&, int) const {}
};
struct MoeOrderPub : MoeOrder {
    int* cnt;
    __device__ __forceinline__ void done(const Unit& u, int lane) const {
        asm volatile("s_waitcnt vmcnt(0)" ::: "memory");
        if (lane == 0) __hip_atomic_fetch_add(cnt + u.pm, 1, __ATOMIC_RELAXED, __HIP_MEMORY_SCOPE_AGENT);
    }
};
struct MoeOrderWait : MoeOrder {
    static constexpr bool WAITS = true;
    const int* cnt; LAS int* pollw;
    __device__ __forceinline__ void spin(const Unit& u) const {
        unsigned spins = 0;
        while (__builtin_amdgcn_readfirstlane(__hip_atomic_load(cnt + u.pm, __ATOMIC_RELAXED, __HIP_MEMORY_SCOPE_AGENT)) < 32) { __builtin_amdgcn_s_sleep(2); if (++spins > (1u << 22)) break; }
    }
    __device__ __forceinline__ void a_ready(const Unit& u, int wid, int lane) const {
        if (wid == 0) spin(u);
        asm volatile("" ::: "memory"); __builtin_amdgcn_s_barrier(); asm volatile("" ::: "memory");
    }
    __device__ __forceinline__ void poll_issue(const Unit& u, int wid, int lane) const {
        if (wid == 0 && lane == 0) __builtin_amdgcn_global_load_lds((const unsigned*)(cnt + u.pm), (LAS unsigned*)pollw, 4, 0, 16);
    }
    __device__ __forceinline__ void poll_check(const Unit& u, int wid, int lane) const {
        if (wid == 0) { const int v = __builtin_amdgcn_readfirstlane(*(volatile LAS int*)pollw); if (v < 32) spin(u); }
    }
};

struct EpiInProj {
    static constexpr bool PERM = true;
    bf16_t* O; const float2* rope; const float* lbl; const float* ngl;
    __device__ __forceinline__ void operator()(const f32x4 (&acc)[2][2][4][2], const Unit& u, int wr, int wc, int fr, int fq) const {
        const int region = u.pn >> 1;
        const int row0 = u.pm * BM + wr * 64 + fr, col0 = u.pn * BM + wc * 32 + 8 * fq;
        const bool do_rope = (region == 5 || region == 6) && ((wc & 1) == 0);
        const int srow = (fr >> 2) + 4 * fq, spc = fr & 3, src4 = regroup_src(fr, fq);
        const float scale = (region == 0) ? 0.08838834764831845f : ((region == 5) ? 0.125f * 1.4426950408889634f : 1.0f);
#pragma unroll
        for (int ai = 0; ai < 2; ++ai)
#pragma unroll
            for (int m = 0; m < 4; ++m) {
                const int row = row0 + ai * HALF + m * 16;
                bf16_t* rowp = O + (size_t)(row - fr + srow) * INC + (col0 - 8 * fq + 8 * spc);
                f32x4 cs0 = {1.f, 0.f, 1.f, 0.f}, cs1 = cs0, cs2 = cs0, cs3 = cs0;
                if (do_rope) { const f32x4* t = (const f32x4*)(rope + (size_t)(row & (SEQ - 1)) * 8); cs0 = t[0]; cs1 = t[1]; cs2 = t[2]; cs3 = t[3]; }
#pragma unroll
                for (int bj = 0; bj < 2; ++bj) {
                    f32x4 v0 = acc[ai][bj][m][0] * scale, v1 = acc[ai][bj][m][1] * scale;
                    if (region == 4) {
                        const float* np_ = ngl + ((col0 + bj * HALF) & 511);
                        const f32x4 n0 = *(const f32x4*)np_, n1 = *(const f32x4*)(np_ + 4);
#pragma unroll
                        for (int j = 0; j < 4; ++j) { v0[j] = siluf(v0[j]) * n0[j]; v1[j] = siluf(v1[j]) * n1[j]; }
                    }
                    if (region == 1 || region == 2) {
                        const float* lp = lbl + (region - 1) * 512 + ((col0 + bj * HALF) & 511);
                        const f32x4 l0 = *(const f32x4*)lp, l1 = *(const f32x4*)(lp + 4);
#pragma unroll
                        for (int j = 0; j < 4; ++j) {
                            const float a0 = fminf(fmaxf(v0[j], -30.f), 30.f), a1 = fminf(fmaxf(v1[j], -30.f), 30.f);
                            v0[j] = l0[j] + (1.0f - l0[j]) * __builtin_amdgcn_rcpf(1.0f + __expf(-a0));
                            v1[j] = l1[j] + (1.0f - l1[j]) * __builtin_amdgcn_rcpf(1.0f + __expf(-a1)); }
                    }
                    if (do_rope) {
                        const float sgn = (fq == 0) ? -1.f : 1.f;
                        f32x4 o0, o1;
#pragma unroll
                        for (int j = 0; j < 4; ++j) { o0[j] = __shfl_xor(v0[j], 16); o1[j] = __shfl_xor(v1[j], 16); }
                        const float c[8] = {cs0[0], cs0[2], cs1[0], cs1[2], cs2[0], cs2[2], cs3[0], cs3[2]};
                        const float s[8] = {cs0[1], cs0[3], cs1[1], cs1[3], cs2[1], cs2[3], cs3[1], cs3[3]};
                        if (fq < 2) {
#pragma unroll
                            for (int j = 0; j < 4; ++j) { v0[j] = v0[j] * c[j] + sgn * o0[j] * s[j]; v1[j] = v1[j] * c[4 + j] + sgn * o1[j] * s[4 + j]; }
                        }
                    }
                    u32x4 w; w.x = cvt_pk_bf16(v0[0], v0[1]); w.y = cvt_pk_bf16(v0[2], v0[3]); w.z = cvt_pk_bf16(v1[0], v1[1]); w.w = cvt_pk_bf16(v1[2], v1[3]);
                    *(u32x4*)(rowp + bj * HALF) = regroup(w, src4);
                }
            }
    }
};
struct EpiOutProj {
    static constexpr bool PERM = false;
    const float* H; float* Z;
    __device__ __forceinline__ void operator()(const f32x4 (&acc)[2][2][4][2], const Unit& u, int wr, int wc, int fr, int fq) const {
        const int row0 = u.pm * BM + wr * 64 + fr, col0 = u.pn * BM + wc * 32 + 4 * fq;
#pragma unroll
        for (int ai = 0; ai < 2; ++ai)
#pragma unroll
            for (int m = 0; m < 4; ++m) { const size_t off = (size_t)(row0 + ai * HALF + m * 16) * DM + col0;
#pragma unroll
                for (int bj = 0; bj < 2; ++bj)
#pragma unroll
                    for (int n = 0; n < 2; ++n) { const f32x4 hv = *(const f32x4*)(H + off + bj * HALF + n * 16); *(f32x4*)(Z + off + bj * HALF + n * 16) = hv * ALPHA + acc[ai][bj][m][n]; } }
    }
};
struct EpiGateUp {
    static constexpr bool PERM = true;
    bf16_t* O;
    __device__ __forceinline__ void operator()(const f32x4 (&acc)[2][2][4][2], const Unit& u, int wr, int wc, int fr, int fq) const {
        const int srow = (fr >> 2) + 4 * fq, spc = fr & 3, src4 = regroup_src(fr, fq);
        const int row0 = u.pm * BM + wr * 64 + srow, col0 = u.pn * 128 + wc * 16 + 4 * spc;
#pragma unroll
        for (int ai = 0; ai < 2; ++ai)
#pragma unroll
            for (int m = 0; m < 4; ++m) { bf16_t* rowp = O + (size_t)(row0 + ai * HALF + m * 16) * DEXP + col0;
#pragma unroll
                for (int bj = 0; bj < 2; ++bj) { const f32x4 v0 = acc[ai][bj][m][0], v1 = acc[ai][bj][m][1];
                    u32x2 w; w.x = cvt_pk_bf16(siluf(v0[0]) * v0[1], siluf(v0[2]) * v0[3]); w.y = cvt_pk_bf16(siluf(v1[0]) * v1[1], siluf(v1[2]) * v1[3]);
                    *(u32x2*)(rowp + bj * 64) = regroup(w, src4); } }
    }
};
struct EpiBf16Plain {
    static constexpr bool PERM = true;
    bf16_t* O; int ldc;
    __device__ __forceinline__ void operator()(const f32x4 (&acc)[2][2][4][2], const Unit& u, int wr, int wc, int fr, int fq) const {
        const int srow = (fr >> 2) + 4 * fq, spc = fr & 3, src4 = regroup_src(fr, fq);
        const int row0 = u.pm * BM + wr * 64 + srow, col0 = u.pn * BM + wc * 32 + 8 * spc;
#pragma unroll
        for (int ai = 0; ai < 2; ++ai)
#pragma unroll
            for (int m = 0; m < 4; ++m) { bf16_t* rowp = O + (size_t)(row0 + ai * HALF + m * 16) * ldc + col0;
#pragma unroll
                for (int bj = 0; bj < 2; ++bj) { const f32x4 v0 = acc[ai][bj][m][0], v1 = acc[ai][bj][m][1];
                    u32x4 w; w.x = cvt_pk_bf16(v0[0], v0[1]); w.y = cvt_pk_bf16(v0[2], v0[3]); w.z = cvt_pk_bf16(v1[0], v1[1]); w.w = cvt_pk_bf16(v1[2], v1[3]);
                    *(u32x4*)(rowp + bj * HALF) = regroup(w, src4); } }
    }
};

template <class Epi, class Sched, bool GATHER>
__device__ __forceinline__ void gemm_phase(int WV, LAS unsigned char* lds, const Gemm g, const Sched& S, const Epi& E, const LAS int* tokl, int krot = 0) {
    const int tid = o_tid(WV), wid = __builtin_amdgcn_readfirstlane(tid >> 6), lane = tid & 63, wr = wid >> 2, wc = wid & 3, fr = lane & 15, fq = lane >> 4;
    const int K = g.K, nt = K / BK;
    int RA[2]; unsigned voffA[2], voffB[2];
#pragma unroll
    for (int i = 0; i < 2; ++i) { int R, C; stage_rc(tid * 16 + i * 8192, R, C); const int Rb = Epi::PERM ? ((R & ~31) + perm32(R & 31)) : R;
        RA[i] = R; voffA[i] = GATHER ? (unsigned)C * 2u : (unsigned)(R * K + C) * 2u; voffB[i] = (unsigned)(Rb * K + C) * 2u; }
    const size_t kstep = (size_t)(BK * 2);
    const size_t hstep = (size_t)HALF * K * 2;
    const size_t tstep = 2 * hstep;
    const unsigned ldsw = (unsigned)wid * 1024u;
    const int aoff = lds_byte(wr * 64 + fr, fq * 8), boff = lds_byte(wc * 32 + fr, fq * 8);
#define PG8_SA(b, h) (((b) * 2 + (h)) * HTB)
#define PG8_SB(b, h) ((4 + (b) * 2 + (h)) * HTB)
#define PG8_STAGE(bufoff, gbase, voff) do { _Pragma("unroll") for (int _i = 0; _i < 2; ++_i) \
        __builtin_amdgcn_global_load_lds((const unsigned*)((const char*)(gbase) + (voff)[_i]), (LAS unsigned*)(lds + (bufoff) + ldsw + _i * 8192), 16, 0, 0); } while (0)
#define PG8_STAGE_A(bufoff, kp, h) do { if constexpr (GATHER) { PG8_STAGE(bufoff, kp, gA[h]); } else { PG8_STAGE(bufoff, (kp) + (h) * hstep, voffA); } } while (0)
#define PG8_GATHER_OFFS(ui_) do { if constexpr (GATHER) { _Pragma("unroll") for (int _h = 0; _h < 2; ++_h) _Pragma("unroll") for (int _i = 0; _i < 2; ++_i) { \
        int _row = tokl[(ui_) * BM + _h * HALF + RA[_i]]; _row = (_row >= T_TOK) ? 0 : _row; gA[_h][_i] = (unsigned)(_row * K) * 2u + voffA[_i]; } } } while (0)
#define PG8_LDA(dst, b, h) do { _Pragma("unroll") for (int m = 0; m < 4; ++m) _Pragma("unroll") for (int k = 0; k < 2; ++k) dst[m][k] = *(const LAS bf16x8*)(lds + PG8_SA(b, h) + aoff + m * 2048 + k * 1024); } while (0)
#define PG8_LDB(dst, b, h) do { _Pragma("unroll") for (int n = 0; n < 2; ++n) _Pragma("unroll") for (int k = 0; k < 2; ++k) dst[n][k] = *(const LAS bf16x8*)(lds + PG8_SB(b, h) + boff + n * 2048 + k * 1024); } while (0)
#define PG8_MMA(ai, bj, At, Bt) do { __builtin_amdgcn_s_setprio(1); _Pragma("unroll") for (int m = 0; m < 4; ++m) _Pragma("unroll") for (int n = 0; n < 2; ++n) _Pragma("unroll") for (int k = 0; k < 2; ++k) \
        acc[ai][bj][m][n] = __builtin_amdgcn_mfma_f32_16x16x32_bf16(Bt[n][k], At[m][k], acc[ai][bj][m][n], 0, 0, 0); __builtin_amdgcn_s_setprio(0); } while (0)
#define PG8_WAIT_V(n) asm volatile("s_waitcnt vmcnt(" #n ")" ::: "memory")
#define PG8_WAIT_L(n) asm volatile("s_waitcnt lgkmcnt(" #n ")" ::: "memory")
#define PG8_BAR __builtin_amdgcn_s_barrier()
#define PG8_SCHED __builtin_amdgcn_sched_barrier(0)
#define PG8_ZERO_ACC() do { float _z; asm volatile("v_mov_b32 %0, 0" : "=v"(_z)); _Pragma("unroll") for (int a = 0; a < 2; ++a) _Pragma("unroll") for (int b = 0; b < 2; ++b) _Pragma("unroll") for (int m = 0; m < 4; ++m) \
        _Pragma("unroll") for (int n = 0; n < 2; ++n) acc[a][b][m][n] = (f32x4){_z, _z, _z, _z}; } while (0)
    Unit cur, nxt; int ui = 0;
    if (!S.next(0, cur)) return;
    f32x4 acc[2][2][4][2];
    PG8_ZERO_ACC();
    bf16x8 At[4][2], B0[2][2], B1[2][2];
    unsigned gA[2][2];
    PG8_GATHER_OFFS(0);
    S.a_ready(cur, wid, lane);
    const char* cA = GATHER ? (const char*)g.A : (const char*)g.A + (size_t)cur.pm * tstep;
    const char* cB = (const char*)g.Bt + ((size_t)cur.e * g.bstride) * 2 + (size_t)cur.pn * tstep;
    const size_t rot0 = (size_t)krot * kstep;
    PG8_STAGE(PG8_SB(0, 0), cB + rot0, voffB); PG8_STAGE_A(PG8_SA(0, 0), cA + rot0, 0); PG8_STAGE(PG8_SB(0, 1), cB + rot0 + hstep, voffB); PG8_STAGE_A(PG8_SA(0, 1), cA + rot0, 1);
    if (wr == 1) PG8_BAR;
    PG8_WAIT_V(4); PG8_BAR;
    PG8_STAGE(PG8_SB(1, 0), cB + rot0 + kstep, voffB); PG8_STAGE_A(PG8_SA(1, 0), cA + rot0 + kstep, 0); PG8_STAGE(PG8_SB(1, 1), cB + rot0 + hstep + kstep, voffB);
    PG8_WAIT_V(6); PG8_BAR;
    for (;;) {
        const bool has_next = S.next(ui + 1, nxt);
        const char* nA = (GATHER || !has_next) ? cA : (const char*)g.A + (size_t)nxt.pm * tstep;
        const char* nB = has_next ? (const char*)g.Bt + ((size_t)nxt.e * g.bstride) * 2 + (size_t)nxt.pn * tstep : cB;
        for (int t = 0; t < nt; t += 2) {
            const bool last = (t == nt - 2);
            const char* a1 = cA + (size_t)((t + krot) & (nt - 1)) * kstep + kstep;
            const size_t o2 = (size_t)((t + 2 + krot) & (nt - 1)) * kstep;
            const char* a2 = (last ? nA : cA) + o2; const char* b2 = (last ? nB : cB) + o2;
            const char* a3 = a2 + kstep; const char* b3 = b2 + kstep;
            if constexpr (Sched::WAITS) { if (has_next) { if (t == nt - 4) S.poll_issue(nxt, wid, lane); if (last) S.poll_check(nxt, wid, lane); } }
            PG8_LDB(B0, 0, 0); PG8_SCHED; PG8_LDA(At, 0, 0); PG8_STAGE_A(PG8_SA(1, 1), a1, 1);
            PG8_WAIT_L(8); PG8_BAR; PG8_WAIT_L(0); PG8_MMA(0, 0, At, B0); PG8_BAR; PG8_SCHED;
            if (last && has_next) { PG8_GATHER_OFFS(ui + 1); }
            PG8_LDB(B1, 0, 1); PG8_STAGE(PG8_SB(0, 0), b2, voffB);
            PG8_BAR; PG8_WAIT_L(0); PG8_MMA(0, 1, At, B1); PG8_BAR;
            PG8_LDA(At, 0, 1); PG8_STAGE_A(PG8_SA(0, 0), a2, 0);
            PG8_BAR; PG8_WAIT_L(0); PG8_MMA(1, 0, At, B0); PG8_BAR; PG8_SCHED;
            PG8_STAGE(PG8_SB(0, 1), b2 + hstep, voffB);
            PG8_WAIT_V(6); PG8_BAR; PG8_MMA(1, 1, At, B1); PG8_BAR;
            PG8_LDB(B0, 1, 0); PG8_SCHED; PG8_LDA(At, 1, 0); PG8_STAGE_A(PG8_SA(0, 1), a2, 1);
            PG8_WAIT_L(8); PG8_BAR; PG8_WAIT_L(0); PG8_MMA(0, 0, At, B0); PG8_BAR; PG8_SCHED;
            PG8_LDB(B1, 1, 1); PG8_STAGE(PG8_SB(1, 0), b3, voffB);
            PG8_BAR; PG8_WAIT_L(0); PG8_MMA(0, 1, At, B1); PG8_BAR;
            PG8_LDA(At, 1, 1); PG8_STAGE_A(PG8_SA(1, 0), a3, 0);
            PG8_BAR; PG8_WAIT_L(0); PG8_MMA(1, 0, At, B0); PG8_BAR; PG8_SCHED;
            PG8_STAGE(PG8_SB(1, 1), b3 + hstep, voffB);
            PG8_WAIT_V(6); PG8_BAR; PG8_MMA(1, 1, At, B1); PG8_BAR;
        }
        E(acc, cur, wr, wc, fr, fq);
        S.done(cur, lane);
        if (!has_next) break;
        PG8_ZERO_ACC();
        cur = nxt; cA = nA; cB = nB; ++ui;
    }
    PG8_WAIT_V(0);
    if (wr == 0) PG8_BAR;
    PG8_BAR;
#undef PG8_SA
#undef PG8_SB
#undef PG8_STAGE
#undef PG8_STAGE_A
#undef PG8_GATHER_OFFS
#undef PG8_LDA
#undef PG8_LDB
#undef PG8_MMA
#undef PG8_WAIT_V
#undef PG8_WAIT_L
#undef PG8_BAR
#undef PG8_SCHED
#undef PG8_ZERO_ACC
}
}

__device__ __forceinline__ unsigned pk2(float lo, float hi) { return (unsigned)f2bf(lo) | ((unsigned)f2bf(hi) << 16); }
struct TrItem { const float* W; bf16_t* WT; int K, N, row_off, rmul, item; };
__device__ __forceinline__ void transpose_load(const TrItem& t, int lane, f32x4 (&v)[8]) {
    const int nblk = t.N / 32, kb = t.item / nblk, nb = t.item % nblk, k0 = 64 * kb, n0 = 32 * nb;
#pragma unroll
    for (int i = 0; i < 8; ++i) v[i] = *(const f32x4*)(t.W + (size_t)(k0 + (lane >> 3) + 8 * i) * t.N + n0 + 4 * (lane & 7));
}
__device__ __forceinline__ void transpose_emit(const TrItem& t, int lane, const f32x4 (&v)[8], LAS float* scr) {
    const int nblk = t.N / 32, kb = t.item / nblk, nb = t.item % nblk, k0 = 64 * kb, n0 = 32 * nb;
#pragma unroll
    for (int i = 0; i < 8; ++i) { const int kk = (lane >> 3) + 8 * i; LAS float* d = scr + kk * 33 + 4 * (lane & 7); d[0] = v[i][0]; d[1] = v[i][1]; d[2] = v[i][2]; d[3] = v[i][3]; }
    asm volatile("s_waitcnt lgkmcnt(0)" ::: "memory");
    const int c = lane & 7;
#pragma unroll
    for (int j = 0; j < 4; ++j) { const int n = (lane >> 3) + 8 * j; const LAS float* s = scr + (8 * c) * 33 + n;
        u32x4 o; o.x = pg8::cvt_pk_bf16(s[0 * 33], s[1 * 33]); o.y = pg8::cvt_pk_bf16(s[2 * 33], s[3 * 33]); o.z = pg8::cvt_pk_bf16(s[4 * 33], s[5 * 33]); o.w = pg8::cvt_pk_bf16(s[6 * 33], s[7 * 33]);
        *(u32x4*)(t.WT + (size_t)(t.row_off + t.rmul * (n0 + n)) * t.K + k0 + 8 * c) = o; }
    asm volatile("s_waitcnt lgkmcnt(0)" ::: "memory");
}
__device__ __forceinline__ void transpose_item(const float* W, int K, int N, bf16_t* WT, int row_off, int rmul, LAS float* scr, int item, int lane) {
    TrItem t{W, WT, K, N, row_off, rmul, item}; f32x4 v[8]; transpose_load(t, lane, v); transpose_emit(t, lane, v, scr);
}
__device__ void convert_dense_phase(int WV, const Params& p, LAS unsigned char* lds) {
    const int TID = o_tid(WV), BID = o_bid();
    const int lane = TID & 63, wave = TID >> 6, gw = BID * NWAVES + wave, ngw = gridDim.x * NWAVES;
    LAS float* scr = (LAS float*)(lds + wave * 16384);
    constexpr int I_IN = (DM / 64) * (INC / 32), I_OUT = (DM / 64) * (DM / 32);
    for (int it = gw; it < 2 * (I_IN + I_OUT); it += ngw) {
        int r = it; const int l = r / (I_IN + I_OUT); r -= l * (I_IN + I_OUT);
        if (r < I_IN) transpose_item(p.w_in + (size_t)l * DM * INC, DM, INC, p.wt_in + (size_t)l * INC * DM, 0, 1, scr, r, lane);
        else transpose_item(p.w_out + (size_t)l * DM * DM, DM, DM, p.wt_out + (size_t)l * DM * DM, 0, 1, scr, r - I_IN, lane);
    }
    const f32x4* xs = (const f32x4*)p.x; u32x2* xd = (u32x2*)p.xb;
    for (long i = (long)BID * NTHREADS + TID; i < (long)T_TOK * DM / 4; i += (long)gridDim.x * NTHREADS) { const f32x4 v = xs[i]; u32x2 o; o.x = pk2(v[0], v[1]); o.y = pk2(v[2], v[3]); xd[i] = o; }
}
#define CONV_CHUNKS (NEXP * 768 / 32)
__device__ __forceinline__ void convert_expert_chunk(int WV, const Params& p, int l, int chunk, LAS unsigned char* lds, int lane) {
    LAS float* scr = (LAS float*)(lds + WV * 12288);
    constexpr int I_G = (DM / 64) * (DEXP / 32), I_D = (DEXP / 64) * (DM / 32);
    constexpr int PER_E = 2 * I_G + I_D;
    const int it0 = chunk * 32 + WV * 4;
    const int e = it0 / PER_E; const int r0 = it0 - e * PER_E;
    const size_t eo = ((size_t)l * NEXP + e) * DM * DEXP;
    TrItem t;
    if (r0 < I_G) t = TrItem{p.wg + eo, p.wt_gu + (size_t)e * DM * DM, DM, DEXP, 0, 2, r0};
    else if (r0 < 2 * I_G) t = TrItem{p.wu + eo, p.wt_gu + (size_t)e * DM * DM, DM, DEXP, 1, 2, r0 - I_G};
    else t = TrItem{p.wd + eo, p.wt_dn + (size_t)e * DM * DEXP, DEXP, DM, 0, 1, r0 - 2 * I_G};
    f32x4 va[8], vb[8];
    TrItem ta = t, tb = t; tb.item = t.item + 1;
    transpose_load(ta, lane, va); transpose_load(tb, lane, vb);
    transpose_emit(ta, lane, va, scr);
    ta.item = t.item + 2; transpose_load(ta, lane, va);
    transpose_emit(tb, lane, vb, scr);
    tb.item = t.item + 3; transpose_load(tb, lane, vb);
    ta.item = t.item + 2; transpose_emit(ta, lane, va, scr);
    transpose_emit(tb, lane, vb, scr);
}
__device__ void convert_expert_phase(int WV, const Params& p, int l, LAS unsigned char* lds) {
    const int TID = o_tid(WV), BID = o_bid();
    const int lane = TID & 63, wave = TID >> 6, gw = BID * NWAVES + wave, ngw = gridDim.x * NWAVES;
    LAS float* scr = (LAS float*)(lds + wave * 16384);
    constexpr int I_G = (DM / 64) * (DEXP / 32), I_D = (DEXP / 64) * (DM / 32);
    constexpr int PER_E = 2 * I_G + I_D;
    for (int it = gw; it < NEXP * PER_E; it += ngw) {
        const int e = it / PER_E; int r = it - e * PER_E;
        const size_t eo = ((size_t)l * NEXP + e) * DM * DEXP;
        if (r < I_G) transpose_item(p.wg + eo, DM, DEXP, p.wt_gu + (size_t)e * DM * DM, 0, 2, scr, r, lane);
        else if (r < 2 * I_G) transpose_item(p.wu + eo, DM, DEXP, p.wt_gu + (size_t)e * DM * DM, 1, 2, scr, r - I_G, lane);
        else transpose_item(p.wd + eo, DEXP, DM, p.wt_dn + (size_t)e * DM * DEXP, 0, 1, scr, r - 2 * I_G, lane);
    }
}

__device__ __forceinline__ void sincos_poly(double ang, float& c, float& s) {
    const double TWO_PI = 6.283185307179586476925, INV_2PI = 0.15915494309189533577;
    const double k = __builtin_rint(ang * INV_2PI); const double r = ang - k * TWO_PI; const double r2 = r * r;
    double sn = 1.0 / 51090942171709440000.0;
    sn = sn * r2 * -1.0 + 1.0 / 121645100408832000.0;
    sn = sn * -r2 + 1.0 / 355687428096000.0;
    sn = sn * -r2 + 1.0 / 1307674368000.0;
    sn = sn * -r2 + 1.0 / 6227020800.0;
    sn = sn * -r2 + 1.0 / 39916800.0;
    sn = sn * -r2 + 1.0 / 362880.0;
    sn = sn * -r2 + 1.0 / 5040.0;
    sn = sn * -r2 + 1.0 / 120.0;
    sn = sn * -r2 + 1.0 / 6.0;
    sn = sn * -r2 + 1.0;
    sn = sn * r;
    double cs = 1.0 / 2432902008176640000.0;
    cs = cs * -r2 + 1.0 / 6402373705728000.0;
    cs = cs * -r2 + 1.0 / 20922789888000.0;
    cs = cs * -r2 + 1.0 / 87178291200.0;
    cs = cs * -r2 + 1.0 / 479001600.0;
    cs = cs * -r2 + 1.0 / 3628800.0;
    cs = cs * -r2 + 1.0 / 40320.0;
    cs = cs * -r2 + 1.0 / 720.0;
    cs = cs * -r2 + 1.0 / 24.0;
    cs = cs * -r2 + 0.5;
    cs = cs * -r2 + 1.0;
    c = (float)cs; s = (float)sn;
}
__device__ void rope_table_phase(int WV, float2* tab, float* lbtab, const float* lb_logits) {
    const int TID = o_tid(WV), BID = o_bid();
    if (BID == 0) { for (int i = TID; i < 1024; i += NTHREADS) { lbtab[i] = 0.f; lbtab[1024 + i] = 1.0f / (1.0f + __expf(lb_logits[i] - lb_logits[1024 + i])); } }
    const double invf[8] = {1.0, 0.19392274474868576, 0.03760603093086393, 0.007292664737217109, 0.001414213562373095, 0.0002742481756762073, 5.318295896944988e-05, 1.031338537721246e-05};
    for (int idx = BID * NTHREADS + TID; idx < SEQ * 8; idx += gridDim.x * NTHREADS) {
        const int j = idx & 7, pos = idx >> 3;
        double f = invf[0];
#pragma unroll
        for (int q = 1; q < 8; ++q) f = (j == q) ? invf[q] : f;
        float c, s; sincos_poly((double)pos * f, c, s);
        tab[idx] = make_float2(c, s);
    }
}
typedef short s16x4 __attribute__((ext_vector_type(4)));
#define ATT_ST_STRIDE 68
#define ATT_ST_BYTES (256 * ATT_ST_STRIDE * 4)
#define ATT_VROW 160
#define ATT_KROW 144
#define ATT_VB_BYTES (3 * 16 * ATT_KROW)
__device__ void attn_phase(int WV, const Params& p, int layer, const bf16_t* proj, bf16_t* y, LAS unsigned char* lds, int* ctr) {
    const int tid = o_tid(WV), lane = tid & 63, g = lane >> 4, ql = lane & 15, BID = o_bid();
    LAS float* st = (LAS float*)lds;
    LAS unsigned char* vbp = lds + ATT_ST_BYTES + WV * ATT_VB_BYTES;
    const int vrd = (int)(uintptr_t)vbp + (4 * g + ((lane >> 2) & 3)) * ATT_VROW + (lane & 3) * 8;
    const float L2E = 1.4426950408889634f;
    LAS int* qslot = (LAS int*)(lds + 150 * 1024);
#pragma unroll 1
    for (;;) {
        if (tid == 0) *qslot = atomicAdd(ctr, 1);
        __syncthreads();
        const int item = __builtin_amdgcn_readfirstlane(*qslot);
        if (item >= NB * 8 * 8 + CONV_CHUNKS) break;
        if (item >= NB * 8 * 8) {
            convert_expert_chunk(WV, p, layer, item - NB * 8 * 8, lds, lane);
            __syncthreads();
            continue;
        }
        const int blk = item & 7, head = (item >> 3) & 7, b = item >> 6;
        const int i0 = blk * 256;
        const bf16_t* base = proj + (size_t)b * SEQ * INC; const char* baseb = (const char*)base;
        const int qcol = 2560 + head * 64, kcol = 3072 + head * 64, vcol = 3584 + head * 64;
#define ATT_GEOM(n_, d_, L_, p0_, r_) do { const int br_ = (n_) >> 1, w_ = WV + 8 * ((n_) & 1); d_ = (br_ == 0) ? 1 : ((br_ == 1) ? 4 : 16); L_ = SEQ / d_; \
            if (br_ == 0) { p0_ = i0 + 16 * w_; r_ = 0; } else if (br_ == 1) { r_ = w_ & 3; p0_ = (i0 >> 2) + 16 * (w_ >> 2); } else { r_ = w_; p0_ = i0 >> 4; } } while (0)
#define ATT_LOAD_KQ(d_, L_, p0_, r_) do { const int tq_ = d_ * (p0_ + ql) + r_; \
            { const unsigned qo_ = (unsigned)(tq_ * INC + qcol + 8 * g) * 2u; _Pragma("unroll") for (int ks = 0; ks < 2; ++ks) qf[ks] = *(const bf16x8*)(baseb + qo_ + 64 * ks); } \
            _Pragma("unroll") for (int i_ = 0; i_ < 18; ++i_) { int pk = p0_ - 64 + 8 * i_ + (lane >> 3); pk = pk < 0 ? 0 : (pk > L_ - 1 ? L_ - 1 : pk); \
                kr[i_] = *(const u32x4*)(baseb + (unsigned)((d_ * pk + r_) * INC + kcol + 8 * (lane & 7)) * 2u); } } while (0)
#define ATT_LOAD_V(d_, L_, p0_, r_, K0_, K1_) do { _Pragma("unroll") for (int k2 = K0_; k2 < K1_; ++k2) _Pragma("unroll") for (int j = 0; j < 4; ++j) { const int rr = (lane >> 3) + 8 * j; \
            int pk = p0_ - 64 + 32 * k2 + rr; pk = pk < 0 ? 0 : (pk > L_ - 1 ? L_ - 1 : pk); vv[k2][j] = *(const u32x4*)(baseb + (unsigned)((d_ * pk + r_) * INC + vcol + 8 * (lane & 7)) * 2u); } } while (0)
        bf16x8 qf[2]; u32x4 kr[18]; u32x4 vv[5][4];
        { int d, L, p0, r; ATT_GEOM(0, d, L, p0, r); ATT_LOAD_KQ(d, L, p0, r); ATT_LOAD_V(d, L, p0, r, 0, ATT_VPRE); }
#pragma unroll 1
        for (int n = 0; n < 6; ++n) {
            const int lane = o_tid(WV) & 63, g = lane >> 4, ql = lane & 15;
            const int vrd = (int)(uintptr_t)vbp + (4 * g + ((lane >> 2) & 3)) * ATT_VROW + (lane & 3) * 8;
            const int br = n >> 1;
            int d, L, p0, r; ATT_GEOM(n, d, L, p0, r);
            const int tq = d * (p0 + ql) + r;
            f32x4 s[9];
            {
                const int kwr = (lane >> 3) * ATT_KROW + (lane & 7) * 16, krd = ql * ATT_KROW + g * 16;
#pragma unroll
                for (int grp = 0; grp < 3; ++grp) {
#pragma unroll
                    for (int t = 0; t < 3; ++t) { const int kt = 3 * grp + t;
                        *(LAS u32x4*)(vbp + t * 16 * ATT_KROW + kwr) = kr[2 * kt]; *(LAS u32x4*)(vbp + t * 16 * ATT_KROW + 8 * ATT_KROW + kwr) = kr[2 * kt + 1]; }
                    bf16x8 f0[3], f1[3];
#pragma unroll
                    for (int t = 0; t < 3; ++t) { f0[t] = *(const LAS bf16x8*)(vbp + t * 16 * ATT_KROW + krd); f1[t] = *(const LAS bf16x8*)(vbp + t * 16 * ATT_KROW + krd + 64); }
#pragma unroll
                    for (int t = 0; t < 3; ++t) { const int kt = 3 * grp + t;
                        f32x4 z = {0.f, 0.f, 0.f, 0.f};
                        z = __builtin_amdgcn_mfma_f32_16x16x32_bf16(f0[t], qf[0], z, 0, 0, 0);
                        s[kt] = __builtin_amdgcn_mfma_f32_16x16x32_bf16(f1[t], qf[1], z, 0, 0, 0); }
                }
            }
            __builtin_amdgcn_sched_barrier(0);
            ATT_LOAD_V(d, L, p0, r, ATT_VPRE, 5);
            if (n < 5) { int d2, L2, p02, r2; ATT_GEOM(n + 1, d2, L2, p02, r2); ATT_LOAD_KQ(d2, L2, p02, r2); }
            __builtin_amdgcn_sched_barrier(0);
            const int klo = max(ql, 64 - p0), khi = min(ql + 128, L + 63 - p0);
            float m = -3.0e38f;
#pragma unroll
            for (int kt = 0; kt < 9; ++kt)
#pragma unroll
                for (int j = 0; j < 4; ++j) { const int kk = 16 * kt + 4 * g + j; const bool ok = (kk >= klo) && (kk <= khi); s[kt][j] = ok ? s[kt][j] : -INFINITY; m = fmaxf(m, s[kt][j]); }
            m = fmaxf(m, __shfl_xor(m, 16)); m = fmaxf(m, __shfl_xor(m, 32));
            float lsum = 0.f;
#pragma unroll
            for (int kt = 0; kt < 9; ++kt)
#pragma unroll
                for (int j = 0; j < 4; ++j) { const float pe = __builtin_amdgcn_exp2f(s[kt][j] - m); s[kt][j] = pe; lsum += pe; }
            lsum += __shfl_xor(lsum, 16); lsum += __shfl_xor(lsum, 32);
            f32x4 o[4];
#pragma unroll
            for (int c = 0; c < 4; ++c) o[c] = (f32x4){0.f, 0.f, 0.f, 0.f};
#pragma unroll
            for (int k2 = 0; k2 < 5; ++k2) {
#pragma unroll
                for (int j = 0; j < 4; ++j) { const int rr = (lane >> 3) + 8 * j; *(LAS u32x4*)(vbp + rr * ATT_VROW + (lane & 7) * 16) = vv[k2][j]; }
                bf16x8 pf;
                { const f32x4 pa = s[2 * k2]; const f32x4 pb = (k2 < 4) ? s[2 * k2 + 1 < 9 ? 2 * k2 + 1 : 8] : (f32x4){0.f, 0.f, 0.f, 0.f};
                  u32x4 pw; pw.x = pg8::cvt_pk_bf16(pa[0], pa[1]); pw.y = pg8::cvt_pk_bf16(pa[2], pa[3]); pw.z = pg8::cvt_pk_bf16(pb[0], pb[1]); pw.w = pg8::cvt_pk_bf16(pb[2], pb[3]);
                  pf = __builtin_bit_cast(bf16x8, pw); }
                s16x4 lo[4], hi[4];
#pragma unroll
                for (int c = 0; c < 4; ++c) {
                    asm volatile("ds_read_b64_tr_b16 %0, %1 offset:%2" : "=&v"(lo[c]) : "v"(vrd), "i"(32 * c) : "memory");
                    asm volatile("ds_read_b64_tr_b16 %0, %1 offset:%2" : "=&v"(hi[c]) : "v"(vrd), "i"(16 * ATT_VROW + 32 * c) : "memory");
                }
                asm volatile("s_waitcnt lgkmcnt(0)" ::: "memory"); __builtin_amdgcn_sched_barrier(0);
#pragma unroll
                for (int c = 0; c < 4; ++c) {
                    const bf16x8 af = (bf16x8){lo[c][0], lo[c][1], lo[c][2], lo[c][3], hi[c][0], hi[c][1], hi[c][2], hi[c][3]};
                    o[c] = __builtin_amdgcn_mfma_f32_16x16x32_bf16(af, pf, o[c], 0, 0, 0);
                }
            }
            __builtin_amdgcn_sched_barrier(0);
            if (n < 5) { int d2, L2, p02, r2; ATT_GEOM(n + 1, d2, L2, p02, r2); ATT_LOAD_V(d2, L2, p02, r2, 0, ATT_VPRE); }
            __builtin_amdgcn_sched_barrier(0);
            const int tl = tq - i0;
            LAS float* sp = st + tl * ATT_ST_STRIDE;
            if (br == 0) {
#pragma unroll
                for (int c = 0; c < 4; ++c) *(LAS f32x4*)(sp + 16 * c + 4 * g) = o[c];
                if (g == 0) { sp[64] = m; sp[65] = lsum; }
            } else {
                const float mo = sp[64], lo_ = sp[65];
                f32x4 oo[4];
#pragma unroll
                for (int c = 0; c < 4; ++c) oo[c] = *(const LAS f32x4*)(sp + 16 * c + 4 * g);
                const float mn = fmaxf(mo, m);
                const float fa = __builtin_amdgcn_exp2f(mo - mn), fb = __builtin_amdgcn_exp2f(m - mn);
                const float ln = fa * lo_ + fb * lsum;
                if (br == 1) {
#pragma unroll
                    for (int c = 0; c < 4; ++c) *(LAS f32x4*)(sp + 16 * c + 4 * g) = oo[c] * fa + o[c] * fb;
                    if (g == 0) { sp[64] = mn; sp[65] = ln; }
                } else {
                    const float inv = 1.0f / ln;
                    bf16_t* yp = y + ((size_t)b * SEQ + tq) * DM + 512 + head * 64 + 4 * g;
#pragma unroll
                    for (int c = 0; c < 4; ++c) { const f32x4 ov = (oo[c] * fa + o[c] * fb) * inv;
                        u32x2 wv2; wv2.x = pg8::cvt_pk_bf16(ov[0], ov[1]); wv2.y = pg8::cvt_pk_bf16(ov[2], ov[3]); *(u32x2*)(yp + 16 * c) = wv2; }
                }
            }
            if (n & 1) __syncthreads();
        }
#undef ATT_GEOM
#undef ATT_LOAD_KQ
    }
}

#define HG_QS 272
#define HG_SS 144
#define HG_QT 0
#define HG_KT 17408
#define HG_VT 34816
#define HG_ST 52224
#define HG_OST 34816
#define HG_MISC 68608
#define HG_GRP 70656
#define HG_OS 528
typedef float f32x16 __attribute__((ext_vector_type(16)));
#define TR_READ(dst, base, off) asm volatile("ds_read_b64_tr_b16 %0, %1 offset:%2" : "=&v"(dst) : "v"(base), "i"(off) : "memory")
#define HG_BAR() do { asm volatile("s_waitcnt lgkmcnt(0)" ::: "memory"); __builtin_amdgcn_s_barrier(); asm volatile("" ::: "memory"); } while (0)
__device__ void hgrn_phase(int WV, const Params& p, int layer, LAS unsigned char* lds) {
    const int BID = o_bid();
    const int grp = WV >> 2, w = WV & 3;
    LAS unsigned char* gl = lds + grp * HG_GRP;
    LAS float* tot = (LAS float*)(gl + HG_MISC); LAS float* sref = tot + 256; LAS float* send = tot + 384;
    const int half = (WV >> 1) & 1;
#pragma unroll 1
    for (int item = BID; item < NB * 4; item += gridDim.x) {
        const int h = item & 3, b = item >> 2;
        const int c = (WV & 1) * 64 + (o_tid(WV) & 63);
        const bf16_t* pb = p.proj + (size_t)b * SEQ * INC;
        f32x16 stt[4];
#pragma unroll
        for (int ct = 0; ct < 4; ++ct)
#pragma unroll
            for (int i = 0; i < 16; ++i) stt[ct][i] = 0.f;
        { const int lane0 = o_tid(WV) & 63, cw0 = WV & 1, cf0 = grp ? 31 * 64 : 0;
#pragma unroll
          for (int k = 0; k < 4; ++k) { const int id = lane0 + 64 * k, tau = 32 * half + (id >> 3), ch = id & 7; const int t = grp ? (cf0 + 63 - tau) : (cf0 + tau);
              const bf16_t* row = pb + (size_t)t * INC + h * 128 + 64 * cw0 + 8 * ch; const u32x4 q0 = *(const u32x4*)row, a0 = *(const u32x4*)(row + 512 + grp * 512);
              *(LAS u32x4*)(gl + HG_QT + tau * HG_QS + (64 * cw0 + 8 * ch) * 2) = q0; *(LAS u32x4*)(gl + HG_KT + tau * HG_QS + (64 * cw0 + 8 * ch) * 2) = a0; } }
        u32x4 vld[4];
        { const int gt0 = (WV & 3) * 64 + (o_tid(WV) & 63), cf0 = grp ? 31 * 64 : 0;
#pragma unroll
          for (int i = 0; i < 4; ++i) { const int id = gt0 + 256 * i, tau = id >> 4, ch = id & 15; const int t = grp ? (cf0 + 63 - tau) : (cf0 + tau);
              vld[i] = *(const u32x4*)(pb + (size_t)t * INC + 1536 + h * 128 + 8 * ch); } }
#pragma unroll 1
        for (int j = 0; j < 32; ++j) {
            const int ci = grp ? (31 - j) : j, c0 = ci * 64;
            const int lane = o_tid(WV) & 63, gt = w * 64 + lane, r = lane & 31, hh = lane >> 5;
            const int gi = lane >> 4, li = lane & 15, tq = li >> 2, tp = li & 3;
            const int trV = (int)(uintptr_t)(gl + HG_VT) + (8 * hh + tq) * HG_QS + (32 * w + 16 * (gi & 1) + 4 * tp) * 2;
            const int trK = (int)(uintptr_t)(gl + HG_KT) + (8 * hh + tq) * HG_QS + (16 * (gi & 1) + 4 * tp) * 2;
            if (j > 0) {
#pragma unroll
                for (int i = 0; i < 4; ++i) { const int id = gt + 256 * i, tau = id >> 4, ch = id & 15; const int t = grp ? (c0 + 63 - tau) : (c0 + tau);
                    vld[i] = *(const u32x4*)(pb + (size_t)t * INC + 1536 + h * 128 + 8 * ch); }
            }
            const int cw = WV & 1;
            unsigned kq[32];
            {
                float pl = 1.0f;
#pragma unroll
                for (int i = 0; i < 32; ++i) { const int tau = 32 * half + i;
                    const unsigned qraw = *(const LAS bf16_t*)(gl + HG_QT + tau * HG_QS + c * 2), fraw = *(const LAS bf16_t*)(gl + HG_KT + tau * HG_QS + c * 2);
                    pl = fmaxf(pl * __uint_as_float(fraw << 16), 1e-30f);
                    kq[i] = fraw | (qraw << 16);
                    if ((i & 7) == 7) __builtin_amdgcn_sched_barrier(0);
                }
                tot[half * 128 + c] = pl;
            }
            asm volatile("s_waitcnt vmcnt(0)" ::: "memory");
            HG_BAR();
            {
                const float t0 = tot[c], t1 = tot[128 + c];
                const float fa = half ? 1.0f : __builtin_amdgcn_rcpf(t0), fb = half ? 1.0f : t0;
                float pl = 1.0f;
#pragma unroll
                for (int i = 0; i < 32; ++i) { const int tau = 32 * half + i;
                    const float f = __uint_as_float(kq[i] << 16), qq = __uint_as_float(kq[i] & 0xffff0000u);
                    pl = fmaxf(pl * f, 1e-30f);
                    const float eq = pl * fa, ek = fb * __builtin_amdgcn_rcpf(pl);
                    const unsigned pk = pg8::cvt_pk_bf16(qq * eq, (1.0f - f) * ek);
                    *(LAS bf16_t*)(gl + HG_QT + tau * HG_QS + c * 2) = (bf16_t)(pk & 0xffffu);
                    *(LAS bf16_t*)(gl + HG_KT + tau * HG_QS + c * 2) = (bf16_t)(pk >> 16);
                    if ((i & 7) == 7) __builtin_amdgcn_sched_barrier(0); }
                if (half == 0) sref[c] = t0; else send[c] = t1;
#pragma unroll
                for (int i = 0; i < 4; ++i) { const int id = gt + 256 * i, tau = id >> 4, ch = id & 15; *(LAS u32x4*)(gl + HG_VT + tau * HG_QS + ch * 16) = vld[i]; }
            }
            HG_BAR();
            u32x4 rq[4], ra[4];
            if (j < 31) {
                const int cn = grp ? (30 - j) : (j + 1), cn0 = cn * 64;
#pragma unroll
                for (int k = 0; k < 4; ++k) { const int id = lane + 64 * k, tau = 32 * half + (id >> 3), ch = id & 7; const int t = grp ? (cn0 + 63 - tau) : (cn0 + tau);
                    const bf16_t* row = pb + (size_t)t * INC + h * 128 + 64 * cw + 8 * ch; rq[k] = *(const u32x4*)row; ra[k] = *(const u32x4*)(row + 512 + grp * 512); }
            }
#pragma unroll
            for (int ct = 0; ct < 4; ++ct)
#pragma unroll
                for (int s = 0; s < 2; ++s) { const f32x4 s0 = *(const LAS f32x4*)(sref + 32 * ct + 16 * s + 4 * hh), s1 = *(const LAS f32x4*)(sref + 32 * ct + 16 * s + 8 + 4 * hh);
#pragma unroll
                    for (int i = 0; i < 4; ++i) { stt[ct][8 * s + i] *= s0[i]; stt[ct][8 * s + 4 + i] *= s1[i]; } }
            if (w != 1) {
                const int st_ = (w == 3) ? 1 : 0, tt_ = (w == 0) ? 0 : 1;
                f32x16 sa;
#pragma unroll
                for (int i = 0; i < 16; ++i) sa[i] = 0.f;
#pragma unroll
                for (int ks = 0; ks < 8; ++ks) {
                    const bf16x8 ka = *(const LAS bf16x8*)(gl + HG_KT + (32 * st_ + r) * HG_QS + (16 * ks + 8 * hh) * 2);
                    const bf16x8 qb = *(const LAS bf16x8*)(gl + HG_QT + (32 * tt_ + r) * HG_QS + (16 * ks + 8 * hh) * 2);
                    sa = __builtin_amdgcn_mfma_f32_32x32x16_bf16(ka, qb, sa, 0, 0, 0);
                }
                const int tau_abs = 32 * tt_ + r;
#pragma unroll
                for (int rg = 0; rg < 4; ++rg) { float v4[4];
#pragma unroll
                    for (int i = 0; i < 4; ++i) { const int sig_abs = 32 * st_ + 8 * rg + 4 * hh + i; v4[i] = (sig_abs <= tau_abs) ? sa[4 * rg + i] : 0.f; }
                    u32x2 wv2; wv2.x = pg8::cvt_pk_bf16(v4[0], v4[1]); wv2.y = pg8::cvt_pk_bf16(v4[2], v4[3]);
                    *(LAS u32x2*)(gl + HG_ST + tau_abs * HG_SS + (32 * st_ + 8 * rg + 4 * hh) * 2) = wv2; }
            }
            __builtin_amdgcn_sched_barrier(0);
            f32x16 oacc[2];
#pragma unroll
            for (int tt = 0; tt < 2; ++tt)
#pragma unroll
                for (int i = 0; i < 16; ++i) oacc[tt][i] = 0.f;
#pragma unroll
            for (int ct = 0; ct < 4; ++ct)
#pragma unroll
                for (int s = 0; s < 2; ++s) {
                    u32x4 bw; bw.x = pg8::cvt_pk_bf16(stt[ct][8 * s + 0], stt[ct][8 * s + 1]); bw.y = pg8::cvt_pk_bf16(stt[ct][8 * s + 2], stt[ct][8 * s + 3]);
                    bw.z = pg8::cvt_pk_bf16(stt[ct][8 * s + 4], stt[ct][8 * s + 5]); bw.w = pg8::cvt_pk_bf16(stt[ct][8 * s + 6], stt[ct][8 * s + 7]);
                    const bf16x8 bfr = __builtin_bit_cast(bf16x8, bw);
#pragma unroll
                    for (int tt = 0; tt < 2; ++tt) {
                        const LAS unsigned char* qa = gl + HG_QT + (32 * tt + r) * HG_QS + (32 * ct + 16 * s + 4 * hh) * 2;
                        const u32x2 a0 = *(const LAS u32x2*)qa, a1 = *(const LAS u32x2*)(qa + 16);
                        u32x4 aw; aw.x = a0.x; aw.y = a0.y; aw.z = a1.x; aw.w = a1.y;
                        oacc[tt] = __builtin_amdgcn_mfma_f32_32x32x16_bf16(__builtin_bit_cast(bf16x8, aw), bfr, oacc[tt], 0, 0, 0);
                    }
                    __builtin_amdgcn_sched_barrier(0);
                }
            HG_BAR();
            bf16x8 vf[4];
            { s16x4 lo[4], hi[4];
#pragma unroll
              for (int ks = 0; ks < 4; ++ks) { TR_READ(lo[ks], trV, (16 * ks) * HG_QS); TR_READ(hi[ks], trV, (16 * ks + 4) * HG_QS); }
              asm volatile("s_waitcnt lgkmcnt(0)" : "+v"(lo[0]), "+v"(hi[0]), "+v"(lo[1]), "+v"(hi[1]), "+v"(lo[2]), "+v"(hi[2]), "+v"(lo[3]), "+v"(hi[3]) :: "memory");
#pragma unroll
              for (int ks = 0; ks < 4; ++ks) vf[ks] = (bf16x8){lo[ks][0], lo[ks][1], lo[ks][2], lo[ks][3], hi[ks][0], hi[ks][1], hi[ks][2], hi[ks][3]}; }
            __builtin_amdgcn_sched_barrier(0);
#pragma unroll
            for (int tt = 0; tt < 2; ++tt)
#pragma unroll
                for (int ks = 0; ks < 4; ++ks) { if (tt == 0 && ks >= 2) continue;
                    const bf16x8 sfr = *(const LAS bf16x8*)(gl + HG_ST + (32 * tt + r) * HG_SS + (16 * ks + 8 * hh) * 2);
                    oacc[tt] = __builtin_amdgcn_mfma_f32_32x32x16_bf16(sfr, vf[ks], oacc[tt], 0, 0, 0); }
#pragma unroll
            for (int ct = 0; ct < 4; ++ct) {
                bf16x8 kf[4];
                { s16x4 lo[4], hi[4];
#pragma unroll
                  for (int ks = 0; ks < 4; ++ks) { TR_READ(lo[ks], trK, (16 * ks) * HG_QS + 64 * ct); TR_READ(hi[ks], trK, (16 * ks + 4) * HG_QS + 64 * ct); }
                  asm volatile("s_waitcnt lgkmcnt(0)" : "+v"(lo[0]), "+v"(hi[0]), "+v"(lo[1]), "+v"(hi[1]), "+v"(lo[2]), "+v"(hi[2]), "+v"(lo[3]), "+v"(hi[3]) :: "memory");
#pragma unroll
                  for (int ks = 0; ks < 4; ++ks) kf[ks] = (bf16x8){lo[ks][0], lo[ks][1], lo[ks][2], lo[ks][3], hi[ks][0], hi[ks][1], hi[ks][2], hi[ks][3]}; }
                __builtin_amdgcn_sched_barrier(0);
#pragma unroll
                for (int ks = 0; ks < 4; ++ks) stt[ct] = __builtin_amdgcn_mfma_f32_32x32x16_bf16(kf[ks], vf[ks], stt[ct], 0, 0, 0);
#pragma unroll
                for (int s = 0; s < 2; ++s) { const f32x4 s0 = *(const LAS f32x4*)(send + 32 * ct + 16 * s + 4 * hh), s1 = *(const LAS f32x4*)(send + 32 * ct + 16 * s + 8 + 4 * hh);
#pragma unroll
                    for (int i = 0; i < 4; ++i) { stt[ct][8 * s + i] *= s0[i]; stt[ct][8 * s + 4 + i] *= s1[i]; } }
            }
            HG_BAR();
            if (j < 31) {
#pragma unroll
                for (int k = 0; k < 4; ++k) { const int id = lane + 64 * k, tau = 32 * half + (id >> 3), ch = id & 7;
                    *(LAS u32x4*)(gl + HG_QT + tau * HG_QS + (64 * cw + 8 * ch) * 2) = rq[k]; *(LAS u32x4*)(gl + HG_KT + tau * HG_QS + (64 * cw + 8 * ch) * 2) = ra[k]; }
            }
#pragma unroll
            for (int tt = 0; tt < 2; ++tt)
#pragma unroll
                for (int i = 0; i < 16; ++i) { const int tau = 32 * tt + (i & 3) + 8 * (i >> 2) + 4 * hh; *(LAS float*)(gl + HG_OST + tau * HG_OS + (32 * w + r) * 4) = oacc[tt][i]; }
            HG_BAR();
            {
                const int tau = gt >> 2, seg = gt & 3; const int t = grp ? (c0 + 63 - tau) : (c0 + tau);
                const LAS f32x4* orow = (const LAS f32x4*)(gl + HG_OST + tau * HG_OS + seg * 128);
                bf16_t* yp = p.y + ((size_t)b * SEQ + t) * DM + h * 128 + seg * 32;
                if (j < 16) {
#pragma unroll
                    for (int i = 0; i < 4; ++i) { const f32x4 oa = orow[2 * i], ob = orow[2 * i + 1];
                        u32x4 o4; o4.x = pg8::cvt_pk_bf16(oa[0], oa[1]); o4.y = pg8::cvt_pk_bf16(oa[2], oa[3]); o4.z = pg8::cvt_pk_bf16(ob[0], ob[1]); o4.w = pg8::cvt_pk_bf16(ob[2], ob[3]); *(u32x4*)(yp + 8 * i) = o4; }
                } else {
                    const bf16_t* hg = p.proj + ((size_t)b * SEQ + t) * INC + 2048 + h * 128 + seg * 32;
                    LAS f32x4* erow = (LAS f32x4*)(gl + HG_OST + tau * HG_OS + seg * 128);
                    float ss = 0.f;
                    { u32x4 fpv[4];
#pragma unroll
                      for (int i = 0; i < 4; ++i) fpv[i] = *(const u32x4*)(yp + 8 * i);
                      __builtin_amdgcn_sched_barrier(0);
#pragma unroll
                      for (int i = 0; i < 4; ++i) { f32x4 oa = erow[2 * i], ob = erow[2 * i + 1]; const u32x4 pv = fpv[i];
                          oa[0] += __uint_as_float(pv.x << 16); oa[1] += __uint_as_float(pv.x & 0xffff0000u); oa[2] += __uint_as_float(pv.y << 16); oa[3] += __uint_as_float(pv.y & 0xffff0000u);
                          ob[0] += __uint_as_float(pv.z << 16); ob[1] += __uint_as_float(pv.z & 0xffff0000u); ob[2] += __uint_as_float(pv.w << 16); ob[3] += __uint_as_float(pv.w & 0xffff0000u);
                          erow[2 * i] = oa; erow[2 * i + 1] = ob;
                          const f32x4 qa = oa * oa, qb = ob * ob; ss += (qa[0] + qa[1]) + (qa[2] + qa[3]) + (qb[0] + qb[1]) + (qb[2] + qb[3]); } }
                    __builtin_amdgcn_sched_barrier(0);
                    u32x4 fgv[4];
#pragma unroll
                    for (int i = 0; i < 4; ++i) fgv[i] = *(const u32x4*)(hg + 8 * i);
                    ss += __shfl_xor(ss, 1); ss += __shfl_xor(ss, 2);
                    const float rn = rsqrtf(ss * (1.0f / 128.0f) + 1e-6f);
                    __builtin_amdgcn_sched_barrier(0);
#pragma unroll
                    for (int i = 0; i < 4; ++i) { const f32x4 oa = erow[2 * i] * rn, ob = erow[2 * i + 1] * rn; const u32x4 gv = fgv[i];
                        u32x4 o4;
                        o4.x = pg8::cvt_pk_bf16(oa[0] * __uint_as_float(gv.x << 16), oa[1] * __uint_as_float(gv.x & 0xffff0000u));
                        o4.y = pg8::cvt_pk_bf16(oa[2] * __uint_as_float(gv.y << 16), oa[3] * __uint_as_float(gv.y & 0xffff0000u));
                        o4.z = pg8::cvt_pk_bf16(ob[0] * __uint_as_float(gv.z << 16), ob[1] * __uint_as_float(gv.z & 0xffff0000u));
                        o4.w = pg8::cvt_pk_bf16(ob[2] * __uint_as_float(gv.w << 16), ob[3] * __uint_as_float(gv.w & 0xffff0000u));
                        *(u32x4*)(yp + 8 * i) = o4; }
                }
            }
        }
        asm volatile("s_waitcnt vmcnt(0)" ::: "memory");
        __syncthreads();
    }
}

#define H2_QT 0
#define H2_KT 17408
#define H2_VT 34816
#define H2_ST 52224
#define H2_MISC 61440
#define H2_BUF 62464
#define H2_OST (2 * H2_BUF)
#define H2_FLAG (H2_OST + 17408)
__device__ void hgrn2_phase(int WV, const Params& p, int layer, LAS unsigned char* lds) {
    const int BID = o_bid();
    const int w = WV & 3;
#pragma unroll 1
    for (int item = BID; item < NB * 4 * 2; item += gridDim.x) {
        const int dir = item & 1, h = (item >> 1) & 3, b = item >> 3;
        const bf16_t* pb = p.proj + (size_t)b * SEQ * INC;
        bf16_t* odst = dir ? (p.ob + (size_t)b * SEQ * 512 + h * 128) : (p.y + (size_t)b * SEQ * DM + h * 128);
        const int ostride = dir ? 512 : DM;
        if (WV < 4) {
            f32x16 stt[4];
#pragma unroll
            for (int ct = 0; ct < 4; ++ct)
#pragma unroll
                for (int i = 0; i < 16; ++i) stt[ct][i] = 0.f;
#pragma unroll 1
            for (int k = -1; k <= 32; ++k) {
                const int lane = o_tid(WV) & 63, r = lane & 31, hh = lane >> 5;
                if (k >= 1) {
                    const int st_ = w * 64 + lane; const int cp0 = (dir ? (31 - (k - 1)) : (k - 1)) * 64; const int row = st_ >> 2, seg = st_ & 3; const int t = dir ? (cp0 + 63 - row) : (cp0 + row);
                    const LAS u32x4* sp = (const LAS u32x4*)(lds + H2_OST + row * HG_QS + seg * 64);
                    u32x4* dp = (u32x4*)(odst + (size_t)t * ostride + seg * 32);
#pragma unroll
                    for (int i = 0; i < 4; ++i) dp[i] = sp[i];
                }
                if (k < 0 || k > 31) { HG_BAR(); HG_BAR(); continue; }
                const int gi = lane >> 4, li = lane & 15, tq = li >> 2, tp = li & 3;
                LAS unsigned char* gl = lds + (k & 1) * H2_BUF;
                LAS float* sref = (LAS float*)(gl + H2_MISC); LAS float* send = sref + 128;
                const int trV = (int)(uintptr_t)(gl + H2_VT) + (8 * hh + tq) * HG_QS + (32 * w + 16 * (gi & 1) + 4 * tp) * 2;
                const int trK = (int)(uintptr_t)(gl + H2_KT) + (8 * hh + tq) * HG_QS + (16 * (gi & 1) + 4 * tp) * 2;
#pragma unroll
                for (int ct = 0; ct < 4; ++ct)
#pragma unroll
                    for (int s = 0; s < 2; ++s) { const f32x4 s0 = *(const LAS f32x4*)(sref + 32 * ct + 16 * s + 4 * hh), s1 = *(const LAS f32x4*)(sref + 32 * ct + 16 * s + 8 + 4 * hh);
#pragma unroll
                        for (int i = 0; i < 4; ++i) { stt[ct][8 * s + i] *= s0[i]; stt[ct][8 * s + 4 + i] *= s1[i]; } }
                f32x16 oacc[2];
#pragma unroll
                for (int tt = 0; tt < 2; ++tt)
#pragma unroll
                    for (int i = 0; i < 16; ++i) oacc[tt][i] = 0.f;
#pragma unroll
                for (int ct = 0; ct < 4; ++ct)
#pragma unroll
                    for (int s = 0; s < 2; ++s) {
                        u32x4 bw; bw.x = pg8::cvt_pk_bf16(stt[ct][8 * s + 0], stt[ct][8 * s + 1]); bw.y = pg8::cvt_pk_bf16(stt[ct][8 * s + 2], stt[ct][8 * s + 3]);
                        bw.z = pg8::cvt_pk_bf16(stt[ct][8 * s + 4], stt[ct][8 * s + 5]); bw.w = pg8::cvt_pk_bf16(stt[ct][8 * s + 6], stt[ct][8 * s + 7]);
                        const bf16x8 bfr = __builtin_bit_cast(bf16x8, bw);
#pragma unroll
                        for (int tt = 0; tt < 2; ++tt) {
                            const LAS unsigned char* qa = gl + H2_QT + (32 * tt + r) * HG_QS + (32 * ct + 16 * s + 4 * hh) * 2;
                            const u32x2 a0 = *(const LAS u32x2*)qa, a1 = *(const LAS u32x2*)(qa + 16);
                            u32x4 aw; aw.x = a0.x; aw.y = a0.y; aw.z = a1.x; aw.w = a1.y;
                            oacc[tt] = __builtin_amdgcn_mfma_f32_32x32x16_bf16(__builtin_bit_cast(bf16x8, aw), bfr, oacc[tt], 0, 0, 0);
                        }
                        __builtin_amdgcn_sched_barrier(0);
                    }
                HG_BAR();
                bf16x8 vf[4];
                { s16x4 lo[4], hi[4];
#pragma unroll
                  for (int ks = 0; ks < 4; ++ks) { TR_READ(lo[ks], trV, (16 * ks) * HG_QS); TR_READ(hi[ks], trV, (16 * ks + 4) * HG_QS); }
                  asm volatile("s_waitcnt lgkmcnt(0)" : "+v"(lo[0]), "+v"(hi[0]), "+v"(lo[1]), "+v"(hi[1]), "+v"(lo[2]), "+v"(hi[2]), "+v"(lo[3]), "+v"(hi[3]) :: "memory");
#pragma unroll
                  for (int ks = 0; ks < 4; ++ks) vf[ks] = (bf16x8){lo[ks][0], lo[ks][1], lo[ks][2], lo[ks][3], hi[ks][0], hi[ks][1], hi[ks][2], hi[ks][3]}; }
                __builtin_amdgcn_sched_barrier(0);
#pragma unroll
                for (int tt = 0; tt < 2; ++tt)
#pragma unroll
                    for (int ks = 0; ks < 4; ++ks) { if (tt == 0 && ks >= 2) continue;
                        const bf16x8 sfr = *(const LAS bf16x8*)(gl + H2_ST + (32 * tt + r) * HG_SS + (16 * ks + 8 * hh) * 2);
                        oacc[tt] = __builtin_amdgcn_mfma_f32_32x32x16_bf16(sfr, vf[ks], oacc[tt], 0, 0, 0); }
#pragma unroll
                for (int ct = 0; ct < 4; ++ct) {
                    bf16x8 kf[4];
                    { s16x4 lo[4], hi[4];
#pragma unroll
                      for (int ks = 0; ks < 4; ++ks) { TR_READ(lo[ks], trK, (16 * ks) * HG_QS + 64 * ct); TR_READ(hi[ks], trK, (16 * ks + 4) * HG_QS + 64 * ct); }
                      asm volatile("s_waitcnt lgkmcnt(0)" : "+v"(lo[0]), "+v"(hi[0]), "+v"(lo[1]), "+v"(hi[1]), "+v"(lo[2]), "+v"(hi[2]), "+v"(lo[3]), "+v"(hi[3]) :: "memory");
#pragma unroll
                      for (int ks = 0; ks < 4; ++ks) kf[ks] = (bf16x8){lo[ks][0], lo[ks][1], lo[ks][2], lo[ks][3], hi[ks][0], hi[ks][1], hi[ks][2], hi[ks][3]}; }
                    __builtin_amdgcn_sched_barrier(0);
#pragma unroll
                    for (int ks = 0; ks < 4; ++ks) stt[ct] = __builtin_amdgcn_mfma_f32_32x32x16_bf16(kf[ks], vf[ks], stt[ct], 0, 0, 0);
#pragma unroll
                    for (int s = 0; s < 2; ++s) { const f32x4 s0 = *(const LAS f32x4*)(send + 32 * ct + 16 * s + 4 * hh), s1 = *(const LAS f32x4*)(send + 32 * ct + 16 * s + 8 + 4 * hh);
#pragma unroll
                        for (int i = 0; i < 4; ++i) { stt[ct][8 * s + i] *= s0[i]; stt[ct][8 * s + 4 + i] *= s1[i]; } }
                }
#pragma unroll
                for (int tt = 0; tt < 2; ++tt)
#pragma unroll
                    for (int i = 0; i < 16; i += 2) { const int tau = 32 * tt + (i & 3) + 8 * (i >> 2) + 4 * hh;
                        const unsigned pk = pg8::cvt_pk_bf16(oacc[tt][i], oacc[tt][i + 1]);
                        *(LAS bf16_t*)(lds + H2_OST + tau * HG_QS + (32 * w + r) * 2) = (bf16_t)(pk & 0xffffu);
                        *(LAS bf16_t*)(lds + H2_OST + (tau + 1) * HG_QS + (32 * w + r) * 2) = (bf16_t)(pk >> 16); }
                HG_BAR();
            }
        } else {
            const int pw = WV - 4;
            u32x4 rq[4], rf[4], rv[4];
            {
                const int lane = o_tid(WV) & 63, pt = pw * 64 + lane; const int c0 = (dir ? 31 : 0) * 64;
#pragma unroll
                for (int i = 0; i < 4; ++i) { const int id = lane + 64 * i, row = id >> 2, ch = id & 3; const int t = dir ? (c0 + 63 - row) : (c0 + row);
                    const bf16_t* src = pb + (size_t)t * INC + h * 128 + 32 * pw + 8 * ch; rq[i] = *(const u32x4*)src; rf[i] = *(const u32x4*)(src + 512 + dir * 512); }
#pragma unroll
                for (int i = 0; i < 4; ++i) { const int id = pt + 256 * i, tau = id >> 4, ch = id & 15; const int t = dir ? (c0 + 63 - tau) : (c0 + tau);
                    rv[i] = *(const u32x4*)(pb + (size_t)t * INC + 1536 + h * 128 + 8 * ch); }
            }
#pragma unroll 1
            for (int k = -1; k <= 32; ++k) {
                const int lane = o_tid(WV) & 63, pt = pw * 64 + lane, cl = lane & 31, half = lane >> 5, c = 32 * pw + cl;
                LAS unsigned char* gn = lds + ((k + 1) & 1) * H2_BUF;
                if (k + 1 <= 31) {
#pragma unroll
                    for (int i = 0; i < 4; ++i) { const int id = lane + 64 * i, row = id >> 2, ch = id & 3;
                        *(LAS u32x4*)(gn + H2_QT + row * HG_QS + (32 * pw + 8 * ch) * 2) = rq[i]; *(LAS u32x4*)(gn + H2_KT + row * HG_QS + (32 * pw + 8 * ch) * 2) = rf[i]; }
#pragma unroll
                    for (int i = 0; i < 4; ++i) { const int id = pt + 256 * i, tau = id >> 4, ch = id & 15; *(LAS u32x4*)(gn + H2_VT + tau * HG_QS + ch * 16) = rv[i]; }
                    float pl = 1.0f;
#pragma unroll
                    for (int i = 0; i < 32; ++i) { const unsigned fraw = *(const LAS bf16_t*)(gn + H2_KT + (32 * half + i) * HG_QS + c * 2); pl = fmaxf(pl * __uint_as_float(fraw << 16), 1e-30f); }
                    const float po = __shfl_xor(pl, 32);
                    const float t0 = half ? po : pl, t1 = half ? pl : po;
                    const float fa = half ? 1.0f : __builtin_amdgcn_rcpf(t0), fb = half ? 1.0f : t0;
                    pl = 1.0f;
#pragma unroll
                    for (int i = 0; i < 32; ++i) { const int tau = 32 * half + i;
                        const unsigned qraw = *(const LAS bf16_t*)(gn + H2_QT + tau * HG_QS + c * 2), fraw = *(const LAS bf16_t*)(gn + H2_KT + tau * HG_QS + c * 2);
                        const float f = __uint_as_float(fraw << 16), qq = __uint_as_float(qraw << 16);
                        pl = fmaxf(pl * f, 1e-30f);
                        const float eq = pl * fa, ek = fb * __builtin_amdgcn_rcpf(pl);
                        const unsigned pk = pg8::cvt_pk_bf16(qq * eq, (1.0f - f) * ek);
                        *(LAS bf16_t*)(gn + H2_QT + tau * HG_QS + c * 2) = (bf16_t)(pk & 0xffffu);
                        *(LAS bf16_t*)(gn + H2_KT + tau * HG_QS + c * 2) = (bf16_t)(pk >> 16);
                        if ((i & 7) == 7) __builtin_amdgcn_sched_barrier(0); }
                    LAS float* srefn = (LAS float*)(gn + H2_MISC);
                    if (half == 0) srefn[c] = t0; else srefn[128 + c] = t1;
                }
                if (k + 2 <= 31) {
                    const int c0 = (dir ? (31 - (k + 2)) : (k + 2)) * 64;
#pragma unroll
                    for (int i = 0; i < 4; ++i) { const int id = lane + 64 * i, row = id >> 2, ch = id & 3; const int t = dir ? (c0 + 63 - row) : (c0 + row);
                        const bf16_t* src = pb + (size_t)t * INC + h * 128 + 32 * pw + 8 * ch; rq[i] = *(const u32x4*)src; rf[i] = *(const u32x4*)(src + 512 + dir * 512); }
#pragma unroll
                    for (int i = 0; i < 4; ++i) { const int id = pt + 256 * i, tau = id >> 4, ch = id & 15; const int t = dir ? (c0 + 63 - tau) : (c0 + tau);
                        rv[i] = *(const u32x4*)(pb + (size_t)t * INC + 1536 + h * 128 + 8 * ch); }
                }
                HG_BAR();
                if (k + 1 <= 31 && pw < 3) {
                    const int r = lane & 31, hh = lane >> 5;
                    const int st_ = (pw == 2) ? 1 : 0, tt_ = (pw == 0) ? 0 : 1;
                    f32x16 sa;
#pragma unroll
                    for (int i = 0; i < 16; ++i) sa[i] = 0.f;
#pragma unroll
                    for (int ks = 0; ks < 8; ++ks) {
                        const bf16x8 ka = *(const LAS bf16x8*)(gn + H2_KT + (32 * st_ + r) * HG_QS + (16 * ks + 8 * hh) * 2);
                        const bf16x8 qb = *(const LAS bf16x8*)(gn + H2_QT + (32 * tt_ + r) * HG_QS + (16 * ks + 8 * hh) * 2);
                        sa = __builtin_amdgcn_mfma_f32_32x32x16_bf16(ka, qb, sa, 0, 0, 0);
                    }
                    const int tau_abs = 32 * tt_ + r;
#pragma unroll
                    for (int rg = 0; rg < 4; ++rg) { float v4[4];
#pragma unroll
                        for (int i = 0; i < 4; ++i) { const int sig_abs = 32 * st_ + 8 * rg + 4 * hh + i; v4[i] = (sig_abs <= tau_abs) ? sa[4 * rg + i] : 0.f; }
                        u32x2 wv2; wv2.x = pg8::cvt_pk_bf16(v4[0], v4[1]); wv2.y = pg8::cvt_pk_bf16(v4[2], v4[3]);
                        *(LAS u32x2*)(gn + H2_ST + tau_abs * HG_SS + (32 * st_ + 8 * rg + 4 * hh) * 2) = wv2; }
                }
                HG_BAR();
            }
        }
        asm volatile("s_waitcnt vmcnt(0)" ::: "memory");
        __syncthreads();
        LAS int* flagp = (LAS int*)(lds + H2_FLAG);
        if (o_tid(WV) == 0) {
            __builtin_amdgcn_fence(__ATOMIC_RELEASE, "agent");
            asm volatile("s_waitcnt vmcnt(0)" ::: "memory");
            const int old = __hip_atomic_fetch_add(p.hdone + layer * 64 + b * 4 + h, 1, __ATOMIC_RELAXED, __HIP_MEMORY_SCOPE_AGENT);
            if (old == 1) { __builtin_amdgcn_fence(__ATOMIC_ACQUIRE, "agent"); asm volatile("s_waitcnt vmcnt(0)" ::: "memory"); }
            *flagp = old;
        }
        __syncthreads();
        if (*flagp == 1) {
            const int tid = o_tid(WV);
            bf16_t* yb = p.y + (size_t)b * SEQ * DM + h * 128; const bf16_t* obb = p.ob + (size_t)b * SEQ * 512 + h * 128; const bf16_t* gb = pb + 2048 + h * 128;
#pragma unroll 1
            for (int it = 0; it < (SEQ * 4) / NTHREADS; ++it) {
                const int piece = tid + NTHREADS * it, row = piece >> 2, seg = piece & 3;
                u32x4* yp = (u32x4*)(yb + (size_t)row * DM + seg * 32); const u32x4* op = (const u32x4*)(obb + (size_t)row * 512 + seg * 32); const u32x4* gp = (const u32x4*)(gb + (size_t)row * INC + seg * 32);
                u32x4 fv[4], bv[4], gv[4];
#pragma unroll
                for (int i = 0; i < 4; ++i) { fv[i] = yp[i]; bv[i] = op[i]; gv[i] = gp[i]; }
                __builtin_amdgcn_sched_barrier(0);
                f32x4 e[8]; float ss = 0.f;
#pragma unroll
                for (int i = 0; i < 4; ++i) {
                    e[2 * i][0] = __uint_as_float(fv[i].x << 16) + __uint_as_float(bv[i].x << 16); e[2 * i][1] = __uint_as_float(fv[i].x & 0xffff0000u) + __uint_as_float(bv[i].x & 0xffff0000u);
                    e[2 * i][2] = __uint_as_float(fv[i].y << 16) + __uint_as_float(bv[i].y << 16); e[2 * i][3] = __uint_as_float(fv[i].y & 0xffff0000u) + __uint_as_float(bv[i].y & 0xffff0000u);
                    e[2 * i + 1][0] = __uint_as_float(fv[i].z << 16) + __uint_as_float(bv[i].z << 16); e[2 * i + 1][1] = __uint_as_float(fv[i].z & 0xffff0000u) + __uint_as_float(bv[i].z & 0xffff0000u);
                    e[2 * i + 1][2] = __uint_as_float(fv[i].w << 16) + __uint_as_float(bv[i].w << 16); e[2 * i + 1][3] = __uint_as_float(fv[i].w & 0xffff0000u) + __uint_as_float(bv[i].w & 0xffff0000u);
                    const f32x4 q0 = e[2 * i] * e[2 * i], q1 = e[2 * i + 1] * e[2 * i + 1]; ss += (q0[0] + q0[1]) + (q0[2] + q0[3]) + (q1[0] + q1[1]) + (q1[2] + q1[3]); }
                ss += __shfl_xor(ss, 1); ss += __shfl_xor(ss, 2);
                const float rn = rsqrtf(ss * (1.0f / 128.0f) + 1e-6f);
#pragma unroll
                for (int i = 0; i < 4; ++i) { u32x4 o4;
                    o4.x = pg8::cvt_pk_bf16(e[2 * i][0] * rn * __uint_as_float(gv[i].x << 16), e[2 * i][1] * rn * __uint_as_float(gv[i].x & 0xffff0000u));
                    o4.y = pg8::cvt_pk_bf16(e[2 * i][2] * rn * __uint_as_float(gv[i].y << 16), e[2 * i][3] * rn * __uint_as_float(gv[i].y & 0xffff0000u));
                    o4.z = pg8::cvt_pk_bf16(e[2 * i + 1][0] * rn * __uint_as_float(gv[i].z << 16), e[2 * i + 1][1] * rn * __uint_as_float(gv[i].z & 0xffff0000u));
                    o4.w = pg8::cvt_pk_bf16(e[2 * i + 1][2] * rn * __uint_as_float(gv[i].w << 16), e[2 * i + 1][3] * rn * __uint_as_float(gv[i].w & 0xffff0000u));
                    yp[i] = o4; }
            }
        }
        __syncthreads();
    }
}

#define RT_STRIDE 1028
__device__ void ln_router_phase(int WV, const bf16_t* mix, bf16_t* xb, const float* g, const float* bta, const float* w1, const float* b1, const float* w2, const float* b2,
                                int* expert, float* gate, int* rank, int* hist  , int* slot_tok, LAS float* wl) {
    const int TID = o_tid(WV), BID = o_bid();
    LAS int* lhist = (LAS int*)((LAS unsigned char*)wl + 150 * 1024);
    if (TID < NEXP) lhist[TID] = 0;
    for (long i = (long)BID * NTHREADS + TID; i < PSLOTS; i += (long)gridDim.x * NTHREADS) slot_tok[i] = T_TOK;
    {
        f32x4 t1[2], t2[16];
#pragma unroll
        for (int m = 0; m < 2; ++m) t1[m] = ((const f32x4*)w1)[TID + NTHREADS * m];
#pragma unroll
        for (int m = 0; m < 16; ++m) t2[m] = ((const f32x4*)w2)[TID + NTHREADS * m];
        __builtin_amdgcn_sched_barrier(0);
#pragma unroll
        for (int m = 0; m < 2; ++m) { const int k = TID + NTHREADS * m;
#pragma unroll
            for (int i = 0; i < 4; ++i) wl[i * RT_STRIDE + k] = t1[m][i]; }
#pragma unroll
        for (int m = 0; m < 16; ++m) { const int q = TID + NTHREADS * m, k = q >> 3, o4 = (q & 7) * 4;
#pragma unroll
            for (int i = 0; i < 4; ++i) wl[(4 + o4 + i) * RT_STRIDE + k] = t2[m][i]; }
        if (TID < 32) wl[36 * RT_STRIDE + TID] = b2[TID];
    }
    __syncthreads();
    const int lane = TID & 63, gw = BID * NWAVES + (TID >> 6), ngw = gridDim.x * NWAVES;
    const LAS float* wlane = wl + 4 * lane;
    f32x4 gg[4], bb[4];
#pragma unroll
    for (int j = 0; j < 4; ++j) { gg[j] = ((const f32x4*)g)[lane + 64 * j]; bb[j] = ((const f32x4*)bta)[lane + 64 * j]; }
    float b1v[4];
#pragma unroll
    for (int o = 0; o < 4; ++o) b1v[o] = b1[o];
    long w = gw;
    u32x2 hb_[4], mx_[4];
    if (w < T_TOK) {
#pragma unroll
        for (int j = 0; j < 4; ++j) { hb_[j] = ((const u32x2*)(xb + w * DM))[lane + 64 * j]; mx_[j] = ((const u32x2*)(mix + w * DM))[lane + 64 * j]; } }
    for (; w < T_TOK; w += ngw) {
        u32x2 hn_[4], mn_[4]; const long wn = w + ngw;
        if (wn < T_TOK) {
#pragma unroll
            for (int j = 0; j < 4; ++j) { hn_[j] = ((const u32x2*)(xb + wn * DM))[lane + 64 * j]; mn_[j] = ((const u32x2*)(mix + wn * DM))[lane + 64 * j]; } }
        __builtin_amdgcn_sched_barrier(0);
        f32x4 v[4];
#pragma unroll
        for (int j = 0; j < 4; ++j) { v[j][0] = ALPHA * __uint_as_float(hb_[j].x << 16) + __uint_as_float(mx_[j].x << 16); v[j][1] = ALPHA * __uint_as_float(hb_[j].x & 0xffff0000u) + __uint_as_float(mx_[j].x & 0xffff0000u);
            v[j][2] = ALPHA * __uint_as_float(hb_[j].y << 16) + __uint_as_float(mx_[j].y << 16); v[j][3] = ALPHA * __uint_as_float(hb_[j].y & 0xffff0000u) + __uint_as_float(mx_[j].y & 0xffff0000u); }
        float s = 0.f;
#pragma unroll
        for (int j = 0; j < 4; ++j) s += (v[j][0] + v[j][1]) + (v[j][2] + v[j][3]);
        const float mu = wave_sum(s) * (1.0f / 1024.0f);
        float qq = 0.f;
#pragma unroll
        for (int j = 0; j < 4; ++j) { const f32x4 d = v[j] - mu; qq += (d[0] * d[0] + d[1] * d[1]) + (d[2] * d[2] + d[3] * d[3]); }
        const float r = rsqrtf(wave_sum(qq) * (1.0f / 1024.0f) + 1e-5f);
        u32x2* xp = (u32x2*)(xb + w * DM) + lane;
#pragma unroll
        for (int j = 0; j < 4; ++j) { v[j] = (v[j] - mu) * r * gg[j] + bb[j];
            u32x2 o; o.x = pg8::cvt_pk_bf16(v[j][0], v[j][1]); o.y = pg8::cvt_pk_bf16(v[j][2], v[j][3]); xp[64 * j] = o; }
        float l1[4];
#pragma unroll
        for (int o = 0; o < 4; ++o) { float sx = 0.f;
#pragma unroll
            for (int j = 0; j < 4; ++j) { const f32x4 ww = *(const LAS f32x4*)(wlane + o * RT_STRIDE + 256 * j); sx += (v[j][0] * ww[0] + v[j][1] * ww[1]) + (v[j][2] * ww[2] + v[j][3] * ww[3]); }
            l1[o] = sx; }
        wave_sum_n<4>(l1);
        int grp = 0; float mx = l1[0] + b1v[0];
#pragma unroll
        for (int o = 0; o < 4; ++o) l1[o] += b1v[o];
#pragma unroll
        for (int o = 1; o < 4; ++o) if (l1[o] > mx) { mx = l1[o]; grp = o; }
        grp = __builtin_amdgcn_readfirstlane(grp);
        float den = 0.f;
#pragma unroll
        for (int o = 0; o < 4; ++o) den += __expf(l1[o] - mx);
        const float pgrp = 1.0f / den;
        float l2[8];
        const LAS float* wg2 = wlane + (4 + grp * 8) * RT_STRIDE;
#pragma unroll
        for (int o = 0; o < 8; ++o) { float sx = 0.f;
#pragma unroll
            for (int j = 0; j < 4; ++j) { const f32x4 ww = *(const LAS f32x4*)(wg2 + o * RT_STRIDE + 256 * j); sx += (v[j][0] * ww[0] + v[j][1] * ww[1]) + (v[j][2] * ww[2] + v[j][3] * ww[3]); }
            l2[o] = sx; }
        wave_sum_n<8>(l2);
#pragma unroll
        for (int o = 0; o < 8; ++o) l2[o] += wl[36 * RT_STRIDE + grp * 8 + o];
        int e0 = 0; float m0 = l2[0];
#pragma unroll
        for (int o = 1; o < 8; ++o) if (l2[o] > m0) { m0 = l2[o]; e0 = o; }
        int e1 = -1; float m1 = -3.0e38f;
#pragma unroll
        for (int o = 0; o < 8; ++o) if (o != e0 && l2[o] > m1) { m1 = l2[o]; e1 = o; }
        const float rr = __expf(m1 - m0);
        const float wa = 1.0f / (1.0f + rr), wb = rr / (1.0f + rr);
        if (lane == 0) {
            const int ea = grp * 8 + e0, eb = grp * 8 + e1;
            expert[w * 2] = ea; expert[w * 2 + 1] = eb;
            gate[w * 2] = pgrp * wa; gate[w * 2 + 1] = pgrp * wb;
            rank[w * 2] = __hip_atomic_fetch_add(lhist + ea, 1, __ATOMIC_RELAXED, __HIP_MEMORY_SCOPE_WORKGROUP);
            rank[w * 2 + 1] = __hip_atomic_fetch_add(lhist + eb, 1, __ATOMIC_RELAXED, __HIP_MEMORY_SCOPE_WORKGROUP);
        }
#pragma unroll
        for (int j = 0; j < 4; ++j) { hb_[j] = hn_[j]; mx_[j] = mn_[j]; }
    }
    __syncthreads();
    if (TID < NEXP) hist[BID * NEXP + TID] = lhist[TID];
}
__device__ void moe_tables(int WV, const int* hist, int* lds_pstart, int* lds_tile_exp) {
    const int TID = o_tid(WV), BID = o_bid();
    int* tot = lds_pstart + 384; int* part = lds_pstart + 416; int* base = lds_pstart + 448;
    if (TID < 64) tot[TID] = 0;
    __syncthreads();
    const int nent = gridDim.x * NEXP;
    int tl = 0, pl = 0;
    for (int i0 = TID; i0 < nent; i0 += 16 * NTHREADS) {
        int vv_[16];
#pragma unroll
        for (int k = 0; k < 16; ++k) { const int i = i0 + k * NTHREADS; vv_[k] = (i < nent) ? __hip_atomic_load(hist + i, __ATOMIC_RELAXED, __HIP_MEMORY_SCOPE_AGENT) : 0; }
#pragma unroll
        for (int k = 0; k < 16; ++k) { const int i = i0 + k * NTHREADS; tl += vv_[k]; if ((i >> 5) < BID) pl += vv_[k]; }
    }
    __hip_atomic_fetch_add(tot + (TID & 31), tl, __ATOMIC_RELAXED, __HIP_MEMORY_SCOPE_WORKGROUP);
    __hip_atomic_fetch_add(part + (TID & 31), pl, __ATOMIC_RELAXED, __HIP_MEMORY_SCOPE_WORKGROUP);
    __syncthreads();
    if (TID == 0) {
        int acc = 0;
#pragma unroll 1
        for (int e = 0; e < NEXP; ++e) { lds_pstart[e] = acc; base[e] = acc + part[e]; const int nt = (tot[e] + 255) >> 8;
#pragma unroll 1
            for (int t = 0; t < nt; ++t) lds_tile_exp[(acc >> 8) + t] = e; acc += nt * 256; }
#pragma unroll 1
        for (int t = acc >> 8; t < NTILES; ++t) lds_tile_exp[t] = -1;
        lds_pstart[32] = acc >> 8;
    }
    __syncthreads();
}
__device__ void moe_scatter_phase(int WV, const int* expert, const int* rank, const int* lds_pstart, int* slot_tok, int* dest) {
    const int TID = o_tid(WV), BID = o_bid();
    const int* base = lds_pstart + 448;
    const int ngw = gridDim.x * NWAVES;
    for (int a = TID; a < 2 * NWAVES * ((T_TOK + ngw - 1) / ngw); a += NTHREADS) {
        const int r = a >> 1, k = a & 1;
        const long w = (long)(BID * NWAVES + (r & 7)) + (long)ngw * (r >> 3);
        if (w < T_TOK) { const long i = w * 2 + k; const int s = base[expert[i]] + rank[i]; dest[i] = s; slot_tok[s] = (int)w; }
    }
}
__device__ void moe_combine_ln_phase(int WV, float* h, bf16_t* xb, const bf16_t* ys, const int* dest, const float* gate, const float* g, const float* bta, bool write_xb) {
    const int TID = o_tid(WV), BID = o_bid();
    const int lane = TID & 63, gw = BID * NWAVES + (TID >> 6), ngw = gridDim.x * NWAVES;
    f32x4 gg[4], bb[4];
#pragma unroll
    for (int j = 0; j < 4; ++j) { gg[j] = ((const f32x4*)g)[lane + 64 * j]; bb[j] = ((const f32x4*)bta)[lane + 64 * j]; }
    if (ngw * 16 != T_TOK) {
        long w = gw;
        int d0n = 0, d1n = 0; float g0n = 0.f, g1n = 0.f;
        u32x2 hv[4]; u32x2 ya[4], yb[4]; float g0 = 0.f, g1 = 0.f;
        if (w < T_TOK) { const int d0 = dest[w * 2], d1 = dest[w * 2 + 1]; g0 = gate[w * 2]; g1 = gate[w * 2 + 1];
    #pragma unroll
            for (int j = 0; j < 4; ++j) { hv[j] = ((const u32x2*)(xb + w * DM))[lane + 64 * j]; ya[j] = ((const u32x2*)(ys + (long)d0 * DM))[lane + 64 * j]; yb[j] = ((const u32x2*)(ys + (long)d1 * DM))[lane + 64 * j]; } }
        if (w + ngw < T_TOK) { d0n = dest[(w + ngw) * 2]; d1n = dest[(w + ngw) * 2 + 1]; g0n = gate[(w + ngw) * 2]; g1n = gate[(w + ngw) * 2 + 1]; }
        for (; w < T_TOK; w += ngw) {
            u32x2 hn[4]; u32x2 yan[4], ybn[4]; const float g0c = g0n, g1c = g1n;
            const long wn = w + ngw, wnn = w + 2 * (long)ngw;
            if (wn < T_TOK) {
    #pragma unroll
                for (int j = 0; j < 4; ++j) { hn[j] = ((const u32x2*)(xb + wn * DM))[lane + 64 * j]; yan[j] = ((const u32x2*)(ys + (long)d0n * DM))[lane + 64 * j]; ybn[j] = ((const u32x2*)(ys + (long)d1n * DM))[lane + 64 * j]; } }
            if (wnn < T_TOK) { d0n = dest[wnn * 2]; d1n = dest[wnn * 2 + 1]; g0n = gate[wnn * 2]; g1n = gate[wnn * 2 + 1]; }
            __builtin_amdgcn_sched_barrier(0);
            f32x4 v[4]; float s = 0.f;
    #pragma unroll
            for (int j = 0; j < 4; ++j) {
                v[j][0] = ALPHA * __uint_as_float(hv[j].x << 16) + g0 * __uint_as_float(ya[j].x << 16) + g1 * __uint_as_float(yb[j].x << 16);
                v[j][1] = ALPHA * __uint_as_float(hv[j].x & 0xffff0000u) + g0 * __uint_as_float(ya[j].x & 0xffff0000u) + g1 * __uint_as_float(yb[j].x & 0xffff0000u);
                v[j][2] = ALPHA * __uint_as_float(hv[j].y << 16) + g0 * __uint_as_float(ya[j].y << 16) + g1 * __uint_as_float(yb[j].y << 16);
                v[j][3] = ALPHA * __uint_as_float(hv[j].y & 0xffff0000u) + g0 * __uint_as_float(ya[j].y & 0xffff0000u) + g1 * __uint_as_float(yb[j].y & 0xffff0000u);
                s += (v[j][0] + v[j][1]) + (v[j][2] + v[j][3]); }
            const float mu = wave_sum(s) * (1.0f / 1024.0f);
            float qq = 0.f;
    #pragma unroll
            for (int j = 0; j < 4; ++j) { const f32x4 d = v[j] - mu; qq += (d[0] * d[0] + d[1] * d[1]) + (d[2] * d[2] + d[3] * d[3]); }
            const float r = rsqrtf(wave_sum(qq) * (1.0f / 1024.0f) + 1e-5f);
    #pragma unroll
            for (int j = 0; j < 4; ++j) { const f32x4 o = (v[j] - mu) * r * gg[j] + bb[j]; if (!write_xb) ((f32x4*)(h + w * DM))[lane + 64 * j] = o;
                if (write_xb) { u32x2 ob; ob.x = pg8::cvt_pk_bf16(o[0], o[1]); ob.y = pg8::cvt_pk_bf16(o[2], o[3]); ((u32x2*)(xb + w * DM))[lane + 64 * j] = ob; } }
    #pragma unroll
            for (int j = 0; j < 4; ++j) { hv[j] = hn[j]; ya[j] = yan[j]; yb[j] = ybn[j]; }
            g0 = g0c; g1 = g1c;
        }
        return;
    }
    int dv0 = 0, dv1 = 0; float gv0 = 0.f, gv1 = 0.f;
    { const long wr = gw + (long)(lane & 15) * ngw; if (wr < T_TOK) { dv0 = dest[wr * 2]; dv1 = dest[wr * 2 + 1]; gv0 = gate[wr * 2]; gv1 = gate[wr * 2 + 1]; } }
    u32x2 hv[2][4]; u32x2 ya[2][4], yb[2][4];
#define CMB_LOAD(HV, YA, YB, i_) do { _Pragma("unroll") for (int q_ = 0; q_ < 2; ++q_) { const int ii_ = (i_) + 8 * q_; const long wq_ = gw + (long)ii_ * ngw; \
        const int d0_ = __builtin_amdgcn_readlane(dv0, ii_), d1_ = __builtin_amdgcn_readlane(dv1, ii_); \
        _Pragma("unroll") for (int j = 0; j < 4; ++j) { HV[q_][j] = ((const u32x2*)(xb + wq_ * DM))[lane + 64 * j]; YA[q_][j] = ((const u32x2*)(ys + (long)d0_ * DM))[lane + 64 * j]; YB[q_][j] = ((const u32x2*)(ys + (long)d1_ * DM))[lane + 64 * j]; } } } while (0)
    CMB_LOAD(hv, ya, yb, 0);
#pragma unroll 1
    for (int i = 0; i < 8; ++i) {
        u32x2 hn[2][4]; u32x2 yan[2][4], ybn[2][4];
        if (i < 7) CMB_LOAD(hn, yan, ybn, i + 1);
        __builtin_amdgcn_sched_barrier(0);
#pragma unroll
        for (int q = 0; q < 2; ++q) {
            const int ii = i + 8 * q; const long w = gw + (long)ii * ngw;
            const float g0 = __int_as_float(__builtin_amdgcn_readlane(__float_as_int(gv0), ii)), g1 = __int_as_float(__builtin_amdgcn_readlane(__float_as_int(gv1), ii));
            f32x4 v[4]; float s = 0.f;
#pragma unroll
            for (int j = 0; j < 4; ++j) {
                v[j][0] = ALPHA * __uint_as_float(hv[q][j].x << 16) + g0 * __uint_as_float(ya[q][j].x << 16) + g1 * __uint_as_float(yb[q][j].x << 16);
                v[j][1] = ALPHA * __uint_as_float(hv[q][j].x & 0xffff0000u) + g0 * __uint_as_float(ya[q][j].x & 0xffff0000u) + g1 * __uint_as_float(yb[q][j].x & 0xffff0000u);
                v[j][2] = ALPHA * __uint_as_float(hv[q][j].y << 16) + g0 * __uint_as_float(ya[q][j].y << 16) + g1 * __uint_as_float(yb[q][j].y << 16);
                v[j][3] = ALPHA * __uint_as_float(hv[q][j].y & 0xffff0000u) + g0 * __uint_as_float(ya[q][j].y & 0xffff0000u) + g1 * __uint_as_float(yb[q][j].y & 0xffff0000u);
                s += (v[j][0] + v[j][1]) + (v[j][2] + v[j][3]); }
            const float mu = wave_sum(s) * (1.0f / 1024.0f);
            float qq = 0.f;
#pragma unroll
            for (int j = 0; j < 4; ++j) { const f32x4 d = v[j] - mu; qq += (d[0] * d[0] + d[1] * d[1]) + (d[2] * d[2] + d[3] * d[3]); }
            const float r = rsqrtf(wave_sum(qq) * (1.0f / 1024.0f) + 1e-5f);
#pragma unroll
            for (int j = 0; j < 4; ++j) { const f32x4 o = (v[j] - mu) * r * gg[j] + bb[j]; if (!write_xb) ((f32x4*)(h + w * DM))[lane + 64 * j] = o;
                if (write_xb) { u32x2 ob; ob.x = pg8::cvt_pk_bf16(o[0], o[1]); ob.y = pg8::cvt_pk_bf16(o[2], o[3]); ((u32x2*)(xb + w * DM))[lane + 64 * j] = ob; } }
        }
#pragma unroll
        for (int q = 0; q < 2; ++q)
#pragma unroll
            for (int j = 0; j < 4; ++j) { hv[q][j] = hn[q][j]; ya[q][j] = yan[q][j]; yb[q][j] = ybn[q][j]; }
    }
#undef CMB_LOAD
}

#define XB_TMO      128
#define XB_XCNT(j)  (256  + 64 * (j))
#define XB_XSUB(j)  (1280 + 64 * (j))
#define XB_XGEN(j)  (2304 + 64 * (j))
#define XB_TOP      3328
#define XB_TOPGEN   3392
#define XCD_BAR_WORDS 3456
#define XB_SPIN_CAP (1u << 22)
__device__ __forceinline__ unsigned xb_ld(unsigned* p)              { return __hip_atomic_load(p, __ATOMIC_RELAXED, __HIP_MEMORY_SCOPE_AGENT); }
__device__ __forceinline__ unsigned xb_add(unsigned* p, unsigned v) { return __hip_atomic_fetch_add(p, v, __ATOMIC_RELAXED, __HIP_MEMORY_SCOPE_AGENT); }
__device__ __forceinline__ unsigned xb_xcc_id() { return (unsigned)__builtin_amdgcn_s_getreg((3 << 11) | 20) & 0xFu; }
#define XB_SPIN(cond, bar) do { unsigned _sp = 0; while (cond) { __builtin_amdgcn_s_sleep(1); \
    if ((++_sp & 255u) == 0u) { if (xb_ld(&(bar)[XB_TMO])) break; if (_sp > XB_SPIN_CAP) { atomicAdd(&(bar)[XB_TMO], 1u); break; } } } } while (0)
struct XcdBarrier { unsigned* bar; unsigned x; volatile LAS unsigned* st; };
__device__ __forceinline__ XcdBarrier xcd_barrier_post(unsigned* bar, volatile LAS unsigned* st, bool leader) {
    XcdBarrier b; b.bar = bar; b.x = xb_xcc_id(); b.st = st;
    if (leader) st[2] = xb_add(&bar[XB_XCNT(b.x)], 1u);
    return b;
}
__device__ __forceinline__ void xcd_barrier_complete(unsigned* bar, unsigned x, unsigned& nloc, unsigned& nx, unsigned& before) {
    const unsigned G = gridDim.x * gridDim.y * gridDim.z;
    unsigned sum, cnt, mine, bef, sp = 0u;
    for (;;) {
        sum = 0u; cnt = 0u; mine = 0u; bef = 0u;
#pragma unroll
        for (unsigned j = 0; j < 16; ++j) { const unsigned c = xb_ld(&bar[XB_XCNT(j)]); sum += c; cnt += (c > 0u) ? 1u : 0u; mine = (j == x) ? c : mine; bef += (j < x) ? c : 0u; }
        if (sum == G) break;
        __builtin_amdgcn_s_sleep(1);
        if ((++sp & 255u) == 0u) { if (xb_ld(&bar[XB_TMO])) break; if (sp > XB_SPIN_CAP) { atomicAdd(&bar[XB_TMO], 1u); break; } }
    }
    nloc = mine > 0u ? mine : 1u; nx = cnt > 0u ? cnt : 1u; before = bef;
}
__device__ __forceinline__ void xcd_barrier(const XcdBarrier& b, bool leader) {
    asm volatile("s_waitcnt vmcnt(0)" ::: "memory");
    __syncthreads();
    if (leader) {
        unsigned* bar = b.bar;
        __builtin_amdgcn_s_waitcnt(0);
        unsigned nloc = b.st[0], nx = b.st[1];
        if (nloc == 0u) { unsigned bef; xcd_barrier_complete(bar, b.x, nloc, nx, bef); b.st[0] = nloc; b.st[1] = nx; b.st[3] = bef; }
        const unsigned old = xb_add(&bar[XB_XSUB(b.x)], 1u);
        const unsigned gen = old / nloc;
        if (old + 1u == (gen + 1u) * nloc) {
            __builtin_amdgcn_fence(__ATOMIC_RELEASE, "agent");
            asm volatile("s_waitcnt vmcnt(0)" ::: "memory");
            const unsigned og = xb_add(&bar[XB_TOP], 1u);
            const unsigned tg = og / nx;
            if (og + 1u == (tg + 1u) * nx) xb_add(&bar[XB_TOPGEN], 1u);
            else XB_SPIN(xb_ld(&bar[XB_TOPGEN]) == tg, bar);
            __builtin_amdgcn_fence(__ATOMIC_ACQUIRE, "agent");
            xb_add(&bar[XB_XGEN(b.x)], 1u);
            asm volatile("s_waitcnt vmcnt(0)" ::: "memory");
        } else {
            XB_SPIN(xb_ld(&bar[XB_XGEN(b.x)]) == gen, bar);
            __builtin_amdgcn_fence(__ATOMIC_ACQUIRE, "agent");
            asm volatile("s_waitcnt vmcnt(0)" ::: "memory");
        }
    }
    __syncthreads();
}

__global__ void __launch_bounds__(NTHREADS, 2) fwd_megakernel(Params p) {
    extern __shared__ __attribute__((aligned(16))) unsigned char lds_raw[];
    cg::grid_group grid = cg::this_grid();
    const int WV = __builtin_amdgcn_readfirstlane(threadIdx.x >> 6);
    float* lds = (float*)lds_raw;
    LAS unsigned char* ldsl = (LAS unsigned char*)lds_raw;
    int* lds_pstart = (int*)(lds_raw + LDS_TAB_OFF);
    int* lds_tile_exp = lds_pstart + 64;
    int* lds_tok = lds_pstart + 512;
    volatile LAS unsigned* xst = (volatile LAS unsigned*)(lds_raw + LDS_BYTES - 16);
    const bool xlead = (o_tid(WV) == 0);
    if (xlead) { xst[0] = 0u; xst[1] = 0u; }
    __syncthreads();
    const XcdBarrier xb = xcd_barrier_post(p.bar, xst, xlead);
    rope_table_phase(WV, p.rope_tab, p.lbtab, p.lb_logits);
    convert_dense_phase(WV, p, ldsl);
    grid.sync();
#pragma unroll 1
    for (int l = 0; l < 2; ++l) {
        { pg8::Gemm g{p.xb, p.wt_in + (size_t)l * INC * DM, DM, 0, nullptr}; pg8::StaticOrder S; S.init(T_TOK, INC, gridDim.x, o_bid());
          pg8::EpiInProj E{p.proj, p.rope_tab, p.lbtab + l * 1024, p.norm_g + l * 512};
          pg8::gemm_phase<pg8::EpiInProj, pg8::StaticOrder, false>(WV, ldsl, g, S, E, nullptr, (int)((2u * xb.x) & 15u)); }
        xcd_barrier(xb, o_tid(WV) == 0);
        hgrn2_phase(WV, p, l, ldsl);
        attn_phase(WV, p, l, p.proj, p.y, ldsl, p.counts + 128 + l);
        xcd_barrier(xb, o_tid(WV) == 0);
        { pg8::Gemm g{p.y, p.wt_out + (size_t)l * DM * DM, DM, 0, nullptr}; pg8::StaticOrder S; S.init(T_TOK, DM, gridDim.x, o_bid());
          pg8::EpiBf16Plain E{p.mix, DM};
          pg8::gemm_phase<pg8::EpiBf16Plain, pg8::StaticOrder, false>(WV, ldsl, g, S, E, nullptr, (int)((2u * xb.x) & 15u)); }
        xcd_barrier(xb, o_tid(WV) == 0);
        ln_router_phase(WV, p.mix, p.xb, p.ln1_g + l * DM, p.ln1_b + l * DM, p.rw1 + l * DM * 4, p.rb1 + l * 4, p.rw2 + l * DM * 32, p.rb2 + l * 32, p.expert, p.gate, p.rank, p.hist, p.slot_tok, (LAS float*)ldsl);
        xcd_barrier(xb, o_tid(WV) == 0);
        moe_tables(WV, p.hist, lds_pstart, lds_tile_exp);
        moe_scatter_phase(WV, p.expert, p.rank, lds_pstart, p.slot_tok, p.dest);
        xcd_barrier(xb, o_tid(WV) == 0);
        { const int xn = (int)xst[0], xr = (int)xst[2], xbef = (int)xst[3];
          { pg8::Gemm g{p.xb, p.wt_gu, DM, (long)DM * DM, p.slot_tok}; pg8::MoeOrderPub S; S.init(lds_pstart[32], 4, xn, xr, xbef, gridDim.x, lds_tile_exp); S.cnt = p.mcnt + l * NTILES;
            pg8::EpiGateUp E{p.hid};
            { const int t0 = o_tid(WV); pg8::Unit u; for (int i = 0; S.next(i, u); ++i) { if (t0 < 256) lds_tok[i * 256 + t0] = p.slot_tok[u.pm * 256 + t0]; } }
            __syncthreads();
            pg8::gemm_phase<pg8::EpiGateUp, pg8::MoeOrderPub, true>(WV, ldsl, g, S, E, (const LAS int*)lds_tok); }
          { pg8::Gemm g{p.hid, p.wt_dn, DEXP, (long)DM * DEXP, nullptr}; pg8::MoeOrderWait S; S.init(lds_pstart[32], 4, xn, (xr + xn / 2) % xn, xbef, gridDim.x, lds_tile_exp); S.cnt = p.mcnt + l * NTILES;
            S.pollw = (LAS int*)(lds_raw + LDS_BYTES - 32);
            pg8::EpiBf16Plain E{p.ys, DM};
            pg8::gemm_phase<pg8::EpiBf16Plain, pg8::MoeOrderWait, false>(WV, ldsl, g, S, E, nullptr); } }
        xcd_barrier(xb, o_tid(WV) == 0);
        moe_combine_ln_phase(WV, p.hbuf, p.xb, p.ys, p.dest, p.gate, p.ln2_g + l * DM, p.ln2_b + l * DM, l == 0);
        if (l == 0) xcd_barrier(xb, o_tid(WV) == 0);
    }
}

extern "C" void kernel_launch(void* const* d_in, const int* in_sizes, int n_in, void* d_out, int out_size, void* d_ws, size_t ws_size, hipStream_t stream) {
    static int grid_blocks = 0;
    if (!grid_blocks) {
        int dev = 0, cus = 0, per_cu = 0;
        (void)hipGetDevice(&dev);
        (void)hipDeviceGetAttribute(&cus, hipDeviceAttributeMultiprocessorCount, dev);
        (void)hipFuncSetAttribute((const void*)fwd_megakernel, hipFuncAttributeMaxDynamicSharedMemorySize, LDS_BYTES);
        (void)hipOccupancyMaxActiveBlocksPerMultiprocessor(&per_cu, (const void*)fwd_megakernel, NTHREADS, LDS_BYTES);
        if (per_cu < 1) { fprintf(stderr, "occupancy query says %d blocks/CU\n", per_cu); per_cu = 1; }
        grid_blocks = cus;
        fprintf(stderr, "megakernel: cus=%d per_cu=%d grid=%d\n", cus, per_cu, grid_blocks);
    }
    Params p{};
    p.x = (const float*)d_in[0]; p.w_in = (const float*)d_in[1]; p.lb_logits = (const float*)d_in[2]; p.norm_g = (const float*)d_in[3]; p.w_out = (const float*)d_in[4];
    p.ln1_g = (const float*)d_in[5]; p.ln1_b = (const float*)d_in[6]; p.rw1 = (const float*)d_in[7]; p.rb1 = (const float*)d_in[8]; p.rw2 = (const float*)d_in[9]; p.rb2 = (const float*)d_in[10];
    p.wg = (const float*)d_in[11]; p.wu = (const float*)d_in[12]; p.wd = (const float*)d_in[13]; p.ln2_g = (const float*)d_in[14]; p.ln2_b = (const float*)d_in[15];
    p.hbuf = (float*)d_out;
    char* ws = (char*)d_ws;
    size_t off = 0;
    auto take = [&](size_t bytes) { char* q = ws + off; off += (bytes + 255) & ~(size_t)255; return q; };
    p.counts = (int*)take(4096);
    p.bar = (unsigned*)take((size_t)XCD_BAR_WORDS * 4);
    p.hist = (int*)take((size_t)1024 * NEXP * 4);
    p.rope_tab = (float2*)take((size_t)SEQ * 8 * 8);
    p.lbtab = (float*)take((size_t)2 * 2 * 512 * 4);
    p.expert = (int*)take((size_t)T_TOK * 2 * 4);
    p.rank = (int*)take((size_t)T_TOK * 2 * 4);
    p.gate = (float*)take((size_t)T_TOK * 2 * 4);
    p.dest = (int*)take((size_t)T_TOK * 2 * 4);
    p.slot_tok = (int*)take((size_t)PSLOTS * 4);
    p.wt_in = (bf16_t*)take((size_t)2 * INC * DM * 2);
    p.wt_out = (bf16_t*)take((size_t)2 * DM * DM * 2);
    p.xb = (bf16_t*)take((size_t)T_TOK * DM * 2);
    char* big = take(0);
    p.proj = (bf16_t*)big;
    p.y = (bf16_t*)(big + (size_t)T_TOK * INC * 2);
    p.o_f = (float*)(big + (size_t)T_TOK * INC * 2 + (size_t)T_TOK * DM * 2);
    p.o_b = p.o_f + (size_t)T_TOK * 512;
    char* moe = big + (size_t)T_TOK * INC * 2 + (size_t)T_TOK * DM * 2;
    p.wt_gu = (bf16_t*)moe;
    p.wt_dn = (bf16_t*)(moe + (size_t)NEXP * DM * DM * 2);
    p.ob = (bf16_t*)(moe + (size_t)NEXP * DM * DM * 2 + (size_t)NEXP * DM * DEXP * 2);
    p.hdone = p.counts;
    p.mcnt = p.counts + 256;
    p.hid = (bf16_t*)big;
    p.mix = (bf16_t*)big;
    p.ys = (bf16_t*)(big + (size_t)PSLOTS * DEXP * 2);
    if (off + (size_t)T_TOK * INC * 2 + (size_t)T_TOK * DM * 2 + (size_t)T_TOK * 512 * 8 > ws_size) fprintf(stderr, "workspace too small: %zu\n", ws_size);
    (void)hipMemsetAsync(p.counts, 0, 4096 + (((size_t)XCD_BAR_WORDS * 4 + 255) & ~(size_t)255), stream);
    void* args[] = {&p};
    hipError_t e = hipLaunchCooperativeKernel((const void*)fwd_megakernel, dim3(grid_blocks), dim3(NTHREADS), args, LDS_BYTES, stream);
    if (e != hipSuccess) fprintf(stderr, "cooperative launch failed: %s (grid %d)\n", hipGetErrorString(e), grid_blocks);
}
```

```cpp
#include <hip/hip_runtime.h>
#include <hip/hip_cooperative_groups.h>
#include <stdint.h>
#include <stdio.h>
namespace cg = cooperative_groups;
typedef float f32x2 __attribute__((ext_vector_type(2)));

#define T_TOK 32768
#define DM 1024
#define SEQ 2048
#define NB 16
#define INC 4096
#define NEXP 32
#define DEXP 512
#define PSLOTS ((T_TOK * 2 / 256 + NEXP) * 256)
#define NTILES (PSLOTS / 256)
#define ALPHA 1.41421356237309515f
#define ATT_VPRE 5
#define NTHREADS 512
#define NWAVES 8
#define LDS_BYTES (152 * 1024)
#define LDS_TAB_OFF (144 * 1024)

typedef unsigned short bf16_t;
__device__ __forceinline__ float bf2f(bf16_t b) { return __uint_as_float(((unsigned)b) << 16); }
__device__ __forceinline__ bf16_t f2bf(float f) { unsigned u = __float_as_uint(f); u += 0x7FFFu + ((u >> 16) & 1u); return (bf16_t)(u >> 16); }
template <int CTRL> __device__ __forceinline__ float dppf(float v) { return __int_as_float(__builtin_amdgcn_update_dpp(0, __float_as_int(v), CTRL, 0xf, 0xf, true)); }
__device__ __forceinline__ float wave_sum(float v) {
    v += dppf<0xB1>(v);
    v += dppf<0x4E>(v);
    v += dppf<0x141>(v);
    v += dppf<0x140>(v);
    v += __int_as_float(__builtin_amdgcn_update_dpp(0, __float_as_int(v), 0x142, 0xA, 0xF, false));
    v += __int_as_float(__builtin_amdgcn_update_dpp(0, __float_as_int(v), 0x143, 0xC, 0xF, false));
    return __int_as_float(__builtin_amdgcn_readlane(__float_as_int(v), 63));
}
__device__ __forceinline__ int o_tid(int wv) { int l; asm volatile("v_mbcnt_lo_u32_b32 %0, -1, 0\n\tv_mbcnt_hi_u32_b32 %0, -1, %0" : "=v"(l)); return wv * 64 + l; }
__device__ __forceinline__ int o_bid() { int b = blockIdx.x; asm volatile("" : "+s"(b)); return b; }
template <int N> __device__ __forceinline__ void wave_sum_n(float (&s)[N]) {
#pragma unroll
    for (int i = 0; i < N; ++i) s[i] = wave_sum(s[i]);
}
__device__ __forceinline__ float siluf(float x) { return x * __builtin_amdgcn_rcpf(1.0f + __expf(-x)); }

struct Params {
    const float* x; const float* w_in; const float* lb_logits; const float* norm_g; const float* w_out; const float* ln1_g; const float* ln1_b;
    const float* rw1; const float* rb1; const float* rw2; const float* rb2; const float* wg; const float* wu; const float* wd; const float* ln2_g; const float* ln2_b;
    float* hbuf;
    int* counts;
    int* hist;
    unsigned* bar;
    float2* rope_tab;
    float* lbtab;
    int* expert; int* rank; float* gate; int* dest; int* slot_tok;
    bf16_t* proj; bf16_t* y; float* o_f; float* o_b; bf16_t* hid; bf16_t* ys;
    bf16_t* xb;
    bf16_t* mix;
    bf16_t* ob;
    int* hdone;
    int* mcnt;
    bf16_t* wt_in;
    bf16_t* wt_out;
    bf16_t* wt_gu;
    bf16_t* wt_dn;
};

#define LAS __attribute__((address_space(3)))
typedef short bf16x8 __attribute__((ext_vector_type(8)));
typedef float f32x4 __attribute__((ext_vector_type(4)));
typedef unsigned u32x4 __attribute__((ext_vector_type(4)));
typedef unsigned u32x2 __attribute__((ext_vector_type(2)));
namespace pg8 {
constexpr int BM = 256, BK = 64, HALF = 128, HTB = HALF * BK * 2, STAGE_BYTES = 8 * HTB, NXCD = 8, WGM = 8;
__device__ __forceinline__ int lds_byte(int r, int c) { const int st = (r >> 4) * 2 + (c >> 5), rr = r & 15, cc = c & 31, ob = rr * 64 + cc * 2; return st * 1024 + (ob ^ (((ob >> 9) & 1) << 5)); }
__device__ __forceinline__ void stage_rc(int b, int& R, int& C) { const int st = b / 1024, sb = b % 1024, swz = sb ^ (((sb >> 9) & 1) << 5); R = (st >> 1) * 16 + swz / 64; C = (st & 1) * 32 + (swz % 64) / 2; }
__device__ __forceinline__ int perm32(int rho) { const int n = rho >> 4, i = rho & 15; return 8 * (i >> 2) + 4 * n + (i & 3); }
__device__ __forceinline__ unsigned cvt_pk_bf16(float lo, float hi) { unsigned r; asm volatile("v_cvt_pk_bf16_f32 %0, %1, %2" : "=v"(r) : "v"(lo), "v"(hi)); return r; }

__device__ __forceinline__ int regroup_src(int fr, int fq) { const int lane = fr + 16 * fq; return ((lane >> 2) + 16 * (lane & 3)) << 2; }
__device__ __forceinline__ u32x4 regroup(const u32x4 w, int src4) { u32x4 r; r.x = (unsigned)__builtin_amdgcn_ds_bpermute(src4, (int)w.x); r.y = (unsigned)__builtin_amdgcn_ds_bpermute(src4, (int)w.y);
    r.z = (unsigned)__builtin_amdgcn_ds_bpermute(src4, (int)w.z); r.w = (unsigned)__builtin_amdgcn_ds_bpermute(src4, (int)w.w); return r; }
__device__ __forceinline__ u32x2 regroup(const u32x2 w, int src4) { u32x2 r; r.x = (unsigned)__builtin_amdgcn_ds_bpermute(src4, (int)w.x); r.y = (unsigned)__builtin_amdgcn_ds_bpermute(src4, (int)w.y); return r; }
struct Unit { int pm, pn, e; };
struct Gemm { const bf16_t* A; const bf16_t* Bt; int K; long bstride; const int* rowidx; };

struct StaticOrder {
    int nM, nN, nwg, G, c;
    __device__ void init(int M, int N, int G_, int c_) { nM = M / BM; nN = N / BM; nwg = nM * nN; G = G_; c = c_; }
    __device__ bool next(int i, Unit& u) const {
        const long L = (long)i * G + c; if (L >= nwg) return false;
        int wgid = (int)L; { const int q = nwg / NXCD, r = nwg % NXCD, xcd = wgid % NXCD, off = wgid / NXCD; wgid = (xcd < r ? xcd * (q + 1) : r * (q + 1) + (xcd - r) * q) + off; }
        const int nig = WGM * nN, gid = wgid / nig, fm = gid * WGM, gsz = (nM - fm) < WGM ? (nM - fm) : WGM;
        u.pm = fm + ((wgid % nig) % gsz); u.pn = (wgid % nig) / gsz; u.e = 0; return true;
    }
    static constexpr bool WAITS = false;
    __device__ __forceinline__ void a_ready(const Unit&, int, int) const {}
    __device__ __forceinline__ void done(const Unit&, int) const {}
};
struct MoeOrder {
    static constexpr bool WAITS = false;
    int nN, nwg, G, c, u0; const int* tile_exp;
    __device__ void init(int nact, int nN_, int nloc, int rank, int before, int Gtot, const int* te) {
        const int t0 = (int)((long)nact * before / Gtot), t1 = (int)((long)nact * (before + nloc) / Gtot);
        nN = nN_; u0 = t0 * nN_; nwg = (t1 - t0) * nN_; G = nloc; c = rank; tile_exp = te; }
    __device__ bool next(int i, Unit& u) const {
        const long L = (long)i * G + c; if (L >= nwg) return false;
        const int wgid = u0 + (int)L;
        u.pm = wgid / nN; u.pn = wgid % nN; u.e = tile_exp[u.pm]; return true;
    }
    __device__ __forceinline__ void a_ready(const Unit&, int, int) const {}
    __device__ __forceinline__ void done(const Unit&, int) const {}
};
struct MoeOrderPub : MoeOrder {
    int* cnt;
    __device__ __forceinline__ void done(const Unit& u, int lane) const {
        asm volatile("s_waitcnt vmcnt(0)" ::: "memory");
        if (lane == 0) __hip_atomic_fetch_add(cnt + u.pm, 1, __ATOMIC_RELAXED, __HIP_MEMORY_SCOPE_AGENT);
    }
};
struct MoeOrderWait : MoeOrder {
    static constexpr bool WAITS = true;
    const int* cnt; LAS int* pollw;
    __device__ __forceinline__ void spin(const Unit& u) const {
        unsigned spins = 0;
        while (__builtin_amdgcn_readfirstlane(__hip_atomic_load(cnt + u.pm, __ATOMIC_RELAXED, __HIP_MEMORY_SCOPE_AGENT)) < 32) { __builtin_amdgcn_s_sleep(2); if (++spins > (1u << 22)) break; }
    }
    __device__ __forceinline__ void a_ready(const Unit& u, int wid, int lane) const {
        if (wid == 0) spin(u);
        asm volatile("" ::: "memory"); __builtin_amdgcn_s_barrier(); asm volatile("" ::: "memory");
    }
    __device__ __forceinline__ void poll_issue(const Unit& u, int wid, int lane) const {
        if (wid == 0 && lane == 0) __builtin_amdgcn_global_load_lds((const unsigned*)(cnt + u.pm), (LAS unsigned*)pollw, 4, 0, 16);
    }
    __device__ __forceinline__ void poll_check(const Unit& u, int wid, int lane) const {
        if (wid == 0) { const int v = __builtin_amdgcn_readfirstlane(*(volatile LAS int*)pollw); if (v < 32) spin(u); }
    }
};

struct EpiInProj {
    static constexpr bool PERM = true;
    bf16_t* O; const float2* rope; const float* lbl; const float* ngl;
    __device__ __forceinline__ void operator()(const f32x4 (&acc)[2][2][4][2], const Unit& u, int wr, int wc, int fr, int fq) const {
        const int region = u.pn >> 1;
        const int srow = (fr >> 2) + 4 * fq, spc = fr & 3, src4 = regroup_src(fr, fq);
        const int row0 = u.pm * BM + wr * 64 + fr, col0 = u.pn * BM + wc * 32 + 8 * fq;
        bf16_t* sbase = O + (size_t)(u.pm * BM + wr * 64 + srow) * INC + (u.pn * BM + wc * 32 + 8 * spc);
#define EIP_PUT(ai_, m_, bj_, v0_, v1_) do { u32x4 w_; w_.x = cvt_pk_bf16((v0_)[0], (v0_)[1]); w_.y = cvt_pk_bf16((v0_)[2], (v0_)[3]); w_.z = cvt_pk_bf16((v1_)[0], (v1_)[1]); w_.w = cvt_pk_bf16((v1_)[2], (v1_)[3]); \
            *(u32x4*)(sbase + (size_t)((ai_) * HALF + (m_) * 16) * INC + (bj_) * HALF) = regroup(w_, src4); } while (0)
#define EIP_LOOP _Pragma("unroll") for (int ai = 0; ai < 2; ++ai) _Pragma("unroll") for (int m = 0; m < 4; ++m) _Pragma("unroll") for (int bj = 0; bj < 2; ++bj)
        if (region == 3 || region == 7) {
            EIP_LOOP { EIP_PUT(ai, m, bj, acc[ai][bj][m][0], acc[ai][bj][m][1]); }
        } else if (region == 0) {
            EIP_LOOP { const f32x4 v0 = acc[ai][bj][m][0] * 0.08838834764831845f, v1 = acc[ai][bj][m][1] * 0.08838834764831845f; EIP_PUT(ai, m, bj, v0, v1); }
        } else if (region == 1 || region == 2) {
            f32x4 l0[2], l1[2], o0[2], o1[2];
#pragma unroll
            for (int bj = 0; bj < 2; ++bj) { const float* lp = lbl + (region - 1) * 512 + ((col0 + bj * HALF) & 511); l0[bj] = *(const f32x4*)lp; l1[bj] = *(const f32x4*)(lp + 4); o0[bj] = 1.0f - l0[bj]; o1[bj] = 1.0f - l1[bj]; }
            EIP_LOOP { f32x4 v0 = acc[ai][bj][m][0], v1 = acc[ai][bj][m][1];
#pragma unroll
                for (int j = 0; j < 4; ++j) {
                    const float a0 = fminf(fmaxf(v0[j], -30.f), 30.f), a1 = fminf(fmaxf(v1[j], -30.f), 30.f);
                    v0[j] = l0[bj][j] + o0[bj][j] * __builtin_amdgcn_rcpf(1.0f + __expf(-a0));
                    v1[j] = l1[bj][j] + o1[bj][j] * __builtin_amdgcn_rcpf(1.0f + __expf(-a1)); }
                EIP_PUT(ai, m, bj, v0, v1); }
        } else if (region == 4) {
            f32x4 n0[2], n1[2];
#pragma unroll
            for (int bj = 0; bj < 2; ++bj) { const float* np_ = ngl + ((col0 + bj * HALF) & 511); n0[bj] = *(const f32x4*)np_; n1[bj] = *(const f32x4*)(np_ + 4); }
            EIP_LOOP { f32x4 v0 = acc[ai][bj][m][0], v1 = acc[ai][bj][m][1];
#pragma unroll
                for (int j = 0; j < 4; ++j) { v0[j] = siluf(v0[j]) * n0[bj][j]; v1[j] = siluf(v1[j]) * n1[bj][j]; }
                EIP_PUT(ai, m, bj, v0, v1); }
        } else {
            const float scale = (region == 5) ? 0.125f * 1.4426950408889634f : 1.0f;
            const bool do_rope = ((wc & 1) == 0);
#pragma unroll
            for (int ai = 0; ai < 2; ++ai)
#pragma unroll
                for (int m = 0; m < 4; ++m) {
                    const int row = row0 + ai * HALF + m * 16;
                    f32x4 cs0 = {1.f, 0.f, 1.f, 0.f}, cs1 = cs0, cs2 = cs0, cs3 = cs0;
                    if (do_rope) { const f32x4* t = (const f32x4*)(rope + (size_t)(row & (SEQ - 1)) * 8); cs0 = t[0]; cs1 = t[1]; cs2 = t[2]; cs3 = t[3]; }
#pragma unroll
                    for (int bj = 0; bj < 2; ++bj) {
                        f32x4 v0 = acc[ai][bj][m][0] * scale, v1 = acc[ai][bj][m][1] * scale;
                        if (do_rope) {
                            const float sgn = (fq == 0) ? -1.f : 1.f;
                            f32x4 o0, o1;
#pragma unroll
                            for (int j = 0; j < 4; ++j) { o0[j] = __shfl_xor(v0[j], 16); o1[j] = __shfl_xor(v1[j], 16); }
                            const float c[8] = {cs0[0], cs0[2], cs1[0], cs1[2], cs2[0], cs2[2], cs3[0], cs3[2]};
                            const float s[8] = {cs0[1], cs0[3], cs1[1], cs1[3], cs2[1], cs2[3], cs3[1], cs3[3]};
                            if (fq < 2) {
#pragma unroll
                                for (int j = 0; j < 4; ++j) { v0[j] = v0[j] * c[j] + sgn * o0[j] * s[j]; v1[j] = v1[j] * c[4 + j] + sgn * o1[j] * s[4 + j]; }
                            }
                        }
                        EIP_PUT(ai, m, bj, v0, v1);
                    }
                }
        }
#undef EIP_LOOP
#undef EIP_PUT
    }
};
struct EpiOutProj {
    static constexpr bool PERM = false;
    const float* H; float* Z;
    __device__ __forceinline__ void operator()(const f32x4 (&acc)[2][2][4][2], const Unit& u, int wr, int wc, int fr, int fq) const {
        const int row0 = u.pm * BM + wr * 64 + fr, col0 = u.pn * BM + wc * 32 + 4 * fq;
#pragma unroll
        for (int ai = 0; ai < 2; ++ai)
#pragma unroll
            for (int m = 0; m < 4; ++m) { const size_t off = (size_t)(row0 + ai * HALF + m * 16) * DM + col0;
#pragma unroll
                for (int bj = 0; bj < 2; ++bj)
#pragma unroll
                    for (int n = 0; n < 2; ++n) { const f32x4 hv = *(const f32x4*)(H + off + bj * HALF + n * 16); *(f32x4*)(Z + off + bj * HALF + n * 16) = hv * ALPHA + acc[ai][bj][m][n]; } }
    }
};
struct EpiGateUp {
    static constexpr bool PERM = true;
    bf16_t* O;
    __device__ __forceinline__ void operator()(const f32x4 (&acc)[2][2][4][2], const Unit& u, int wr, int wc, int fr, int fq) const {
        const int srow = (fr >> 2) + 4 * fq, spc = fr & 3, src4 = regroup_src(fr, fq);
        const int row0 = u.pm * BM + wr * 64 + srow, col0 = u.pn * 128 + wc * 16 + 4 * spc;
#pragma unroll
        for (int ai = 0; ai < 2; ++ai)
#pragma unroll
            for (int m = 0; m < 4; ++m) { bf16_t* rowp = O + (size_t)(row0 + ai * HALF + m * 16) * DEXP + col0;
#pragma unroll
                for (int bj = 0; bj < 2; ++bj) { const f32x4 v0 = acc[ai][bj][m][0], v1 = acc[ai][bj][m][1];
                    u32x2 w; w.x = cvt_pk_bf16(siluf(v0[0]) * v0[1], siluf(v0[2]) * v0[3]); w.y = cvt_pk_bf16(siluf(v1[0]) * v1[1], siluf(v1[2]) * v1[3]);
                    *(u32x2*)(rowp + bj * 64) = regroup(w, src4); } }
    }
};
struct EpiBf16Plain {
    static constexpr bool PERM = true;
    bf16_t* O; int ldc;
    __device__ __forceinline__ void operator()(const f32x4 (&acc)[2][2][4][2], const Unit& u, int wr, int wc, int fr, int fq) const {
        const int srow = (fr >> 2) + 4 * fq, spc = fr & 3, src4 = regroup_src(fr, fq);
        const int row0 = u.pm * BM + wr * 64 + srow, col0 = u.pn * BM + wc * 32 + 8 * spc;
#pragma unroll
        for (int ai = 0; ai < 2; ++ai)
#pragma unroll
            for (int m = 0; m < 4; ++m) { bf16_t* rowp = O + (size_t)(row0 + ai * HALF + m * 16) * ldc + col0;
#pragma unroll
                for (int bj = 0; bj < 2; ++bj) { const f32x4 v0 = acc[ai][bj][m][0], v1 = acc[ai][bj][m][1];
                    u32x4 w; w.x = cvt_pk_bf16(v0[0], v0[1]); w.y = cvt_pk_bf16(v0[2], v0[3]); w.z = cvt_pk_bf16(v1[0], v1[1]); w.w = cvt_pk_bf16(v1[2], v1[3]);
                    *(u32x4*)(rowp + bj * HALF) = regroup(w, src4); } }
    }
};

template <class Epi, class Sched, bool GATHER>
__device__ __forceinline__ void gemm_phase(int WV, LAS unsigned char* lds, const Gemm g, const Sched& S, const Epi& E, const LAS int* tokl, int krot = 0) {
    const int tid = o_tid(WV), wid = __builtin_amdgcn_readfirstlane(tid >> 6), lane = tid & 63, wr = wid >> 2, wc = wid & 3, fr = lane & 15, fq = lane >> 4;
    const int K = g.K, nt = K / BK;
    int RA[2]; unsigned voffA[2], voffB[2];
#pragma unroll
    for (int i = 0; i < 2; ++i) { int R, C; stage_rc(tid * 16 + i * 8192, R, C); const int Rb = Epi::PERM ? ((R & ~31) + perm32(R & 31)) : R;
        RA[i] = R; voffA[i] = GATHER ? (unsigned)C * 2u : (unsigned)(R * K + C) * 2u; voffB[i] = (unsigned)(Rb * K + C) * 2u; }
    const size_t kstep = (size_t)(BK * 2);
    const size_t hstep = (size_t)HALF * K * 2;
    const size_t tstep = 2 * hstep;
    const unsigned ldsw = (unsigned)wid * 1024u;
    const int aoff = lds_byte(wr * 64 + fr, fq * 8), boff = lds_byte(wc * 32 + fr, fq * 8);
#define PG8_SA(b, h) (((b) * 2 + (h)) * HTB)
#define PG8_SB(b, h) ((4 + (b) * 2 + (h)) * HTB)
#define PG8_STAGE(bufoff, gbase, voff) do { _Pragma("unroll") for (int _i = 0; _i < 2; ++_i) \
        __builtin_amdgcn_global_load_lds((const unsigned*)((const char*)(gbase) + (voff)[_i]), (LAS unsigned*)(lds + (bufoff) + ldsw + _i * 8192), 16, 0, 0); } while (0)
#define PG8_STAGE_A(bufoff, kp, h) do { if constexpr (GATHER) { PG8_STAGE(bufoff, kp, gA[h]); } else { PG8_STAGE(bufoff, (kp) + (h) * hstep, voffA); } } while (0)
#define PG8_GATHER_OFFS(ui_) do { if constexpr (GATHER) { _Pragma("unroll") for (int _h = 0; _h < 2; ++_h) _Pragma("unroll") for (int _i = 0; _i < 2; ++_i) { \
        int _row = tokl[(ui_) * BM + _h * HALF + RA[_i]]; _row = (_row >= T_TOK) ? 0 : _row; gA[_h][_i] = (unsigned)(_row * K) * 2u + voffA[_i]; } } } while (0)
#define PG8_LDA(dst, b, h) do { _Pragma("unroll") for (int m = 0; m < 4; ++m) _Pragma("unroll") for (int k = 0; k < 2; ++k) dst[m][k] = *(const LAS bf16x8*)(lds + PG8_SA(b, h) + aoff + m * 2048 + k * 1024); } while (0)
#define PG8_LDB(dst, b, h) do { _Pragma("unroll") for (int n = 0; n < 2; ++n) _Pragma("unroll") for (int k = 0; k < 2; ++k) dst[n][k] = *(const LAS bf16x8*)(lds + PG8_SB(b, h) + boff + n * 2048 + k * 1024); } while (0)
#define PG8_MMA(ai, bj, At, Bt) do { __builtin_amdgcn_s_setprio(1); _Pragma("unroll") for (int m = 0; m < 4; ++m) _Pragma("unroll") for (int n = 0; n < 2; ++n) _Pragma("unroll") for (int k = 0; k < 2; ++k) \
        acc[ai][bj][m][n] = __builtin_amdgcn_mfma_f32_16x16x32_bf16(Bt[n][k], At[m][k], acc[ai][bj][m][n], 0, 0, 0); __builtin_amdgcn_s_setprio(0); } while (0)
#define PG8_WAIT_V(n) asm volatile("s_waitcnt vmcnt(" #n ")" ::: "memory")
#define PG8_WAIT_L(n) asm volatile("s_waitcnt lgkmcnt(" #n ")" ::: "memory")
#define PG8_BAR __builtin_amdgcn_s_barrier()
#define PG8_SCHED __builtin_amdgcn_sched_barrier(0)
#define PG8_ZERO_ACC() do { float _z; asm volatile("v_mov_b32 %0, 0" : "=v"(_z)); _Pragma("unroll") for (int a = 0; a < 2; ++a) _Pragma("unroll") for (int b = 0; b < 2; ++b) _Pragma("unroll") for (int m = 0; m < 4; ++m) \
        _Pragma("unroll") for (int n = 0; n < 2; ++n) acc[a][b][m][n] = (f32x4){_z, _z, _z, _z}; } while (0)
    Unit cur, nxt; int ui = 0;
    if (!S.next(0, cur)) return;
    f32x4 acc[2][2][4][2];
    PG8_ZERO_ACC();
    bf16x8 At[4][2], B0[2][2], B1[2][2];
    unsigned gA[2][2];
    PG8_GATHER_OFFS(0);
    S.a_ready(cur, wid, lane);
    const char* cA = GATHER ? (const char*)g.A : (const char*)g.A + (size_t)cur.pm * tstep;
    const char* cB = (const char*)g.Bt + ((size_t)cur.e * g.bstride) * 2 + (size_t)cur.pn * tstep;
    const size_t rot0 = (size_t)krot * kstep;
    PG8_STAGE(PG8_SB(0, 0), cB + rot0, voffB); PG8_STAGE_A(PG8_SA(0, 0), cA + rot0, 0); PG8_STAGE(PG8_SB(0, 1), cB + rot0 + hstep, voffB); PG8_STAGE_A(PG8_SA(0, 1), cA + rot0, 1);
    if (wr == 1) PG8_BAR;
    PG8_WAIT_V(4); PG8_BAR;
    PG8_STAGE(PG8_SB(1, 0), cB + rot0 + kstep, voffB); PG8_STAGE_A(PG8_SA(1, 0), cA + rot0 + kstep, 0); PG8_STAGE(PG8_SB(1, 1), cB + rot0 + hstep + kstep, voffB);
    PG8_WAIT_V(6); PG8_BAR;
    for (;;) {
        const bool has_next = S.next(ui + 1, nxt);
        const char* nA = (GATHER || !has_next) ? cA : (const char*)g.A + (size_t)nxt.pm * tstep;
        const char* nB = has_next ? (const char*)g.Bt + ((size_t)nxt.e * g.bstride) * 2 + (size_t)nxt.pn * tstep : cB;
        for (int t = 0; t < nt; t += 2) {
            const bool last = (t == nt - 2);
            const char* a1 = cA + (size_t)((t + krot) & (nt - 1)) * kstep + kstep;
            const size_t o2 = (size_t)((t + 2 + krot) & (nt - 1)) * kstep;
            const char* a2 = (last ? nA : cA) + o2; const char* b2 = (last ? nB : cB) + o2;
            const char* a3 = a2 + kstep; const char* b3 = b2 + kstep;
            if constexpr (Sched::WAITS) { if (has_next) { if (t == nt - 4) S.poll_issue(nxt, wid, lane); if (last) S.poll_check(nxt, wid, lane); } }
            PG8_LDB(B0, 0, 0); PG8_SCHED; PG8_LDA(At, 0, 0); PG8_STAGE_A(PG8_SA(1, 1), a1, 1);
            PG8_WAIT_L(8); PG8_BAR; PG8_WAIT_L(0); PG8_MMA(0, 0, At, B0); PG8_BAR; PG8_SCHED;
            if (last && has_next) { PG8_GATHER_OFFS(ui + 1); }
            PG8_LDB(B1, 0, 1); PG8_STAGE(PG8_SB(0, 0), b2, voffB);
            PG8_BAR; PG8_WAIT_L(0); PG8_MMA(0, 1, At, B1); PG8_BAR;
            PG8_LDA(At, 0, 1); PG8_STAGE_A(PG8_SA(0, 0), a2, 0);
            PG8_BAR; PG8_WAIT_L(0); PG8_MMA(1, 0, At, B0); PG8_BAR; PG8_SCHED;
            PG8_STAGE(PG8_SB(0, 1), b2 + hstep, voffB);
            PG8_WAIT_V(6); PG8_BAR; PG8_MMA(1, 1, At, B1); PG8_BAR;
            PG8_LDB(B0, 1, 0); PG8_SCHED; PG8_LDA(At, 1, 0); PG8_STAGE_A(PG8_SA(0, 1), a2, 1);
            PG8_WAIT_L(8); PG8_BAR; PG8_WAIT_L(0); PG8_MMA(0, 0, At, B0); PG8_BAR; PG8_SCHED;
            PG8_LDB(B1, 1, 1); PG8_STAGE(PG8_SB(1, 0), b3, voffB);
            PG8_BAR; PG8_WAIT_L(0); PG8_MMA(0, 1, At, B1); PG8_BAR;
            PG8_LDA(At, 1, 1); PG8_STAGE_A(PG8_SA(1, 0), a3, 0);
            PG8_BAR; PG8_WAIT_L(0); PG8_MMA(1, 0, At, B0); PG8_BAR; PG8_SCHED;
            PG8_STAGE(PG8_SB(1, 1), b3 + hstep, voffB);
            PG8_WAIT_V(6); PG8_BAR; PG8_MMA(1, 1, At, B1); PG8_BAR;
        }
        E(acc, cur, wr, wc, fr, fq);
        S.done(cur, lane);
        if (!has_next) break;
        PG8_ZERO_ACC();
        cur = nxt; cA = nA; cB = nB; ++ui;
    }
    PG8_WAIT_V(0);
    if (wr == 0) PG8_BAR;
    PG8_BAR;
#undef PG8_SA
#undef PG8_SB
#undef PG8_STAGE
#undef PG8_STAGE_A
#undef PG8_GATHER_OFFS
#undef PG8_LDA
#undef PG8_LDB
#undef PG8_MMA
#undef PG8_WAIT_V
#undef PG8_WAIT_L
#undef PG8_BAR
#undef PG8_SCHED
#undef PG8_ZERO_ACC
}
}

__device__ __forceinline__ unsigned pk2(float lo, float hi) { return (unsigned)f2bf(lo) | ((unsigned)f2bf(hi) << 16); }
struct TrItem { const float* W; bf16_t* WT; int K, N, row_off, rmul, item; };
__device__ __forceinline__ void transpose_load(const TrItem& t, int lane, f32x4 (&v)[8]) {
    const int nblk = t.N / 32, kb = t.item / nblk, nb = t.item % nblk, k0 = 64 * kb, n0 = 32 * nb;
#pragma unroll
    for (int i = 0; i < 8; ++i) v[i] = *(const f32x4*)(t.W + (size_t)(k0 + 8 * (lane >> 3) + i) * t.N + n0 + 4 * (lane & 7));
}
__device__ __forceinline__ void transpose_emit(const TrItem& t, int lane, const f32x4 (&v)[8], LAS float* scr) {
    (void)scr;
    const int nblk = t.N / 32, kb = t.item / nblk, nb = t.item % nblk, k0 = 64 * kb, n0 = 32 * nb;
    bf16_t* obase = t.WT + (size_t)(t.row_off + t.rmul * (n0 + 4 * (lane & 7))) * t.K + k0 + 8 * (lane >> 3);
#pragma unroll
    for (int e = 0; e < 4; ++e) {
        u32x4 o; o.x = pg8::cvt_pk_bf16(v[0][e], v[1][e]); o.y = pg8::cvt_pk_bf16(v[2][e], v[3][e]); o.z = pg8::cvt_pk_bf16(v[4][e], v[5][e]); o.w = pg8::cvt_pk_bf16(v[6][e], v[7][e]);
        *(u32x4*)(obase + (size_t)(t.rmul * e) * t.K) = o; }
}
__device__ __forceinline__ void transpose_item(const float* W, int K, int N, bf16_t* WT, int row_off, int rmul, LAS float* scr, int item, int lane) {
    TrItem t{W, WT, K, N, row_off, rmul, item}; f32x4 v[8]; transpose_load(t, lane, v); transpose_emit(t, lane, v, scr);
}
__device__ void convert_dense_phase(int WV, const Params& p, LAS unsigned char* lds) {
    const int TID = o_tid(WV), BID = o_bid();
    const int lane = TID & 63, wave = TID >> 6, gw = BID * NWAVES + wave, ngw = gridDim.x * NWAVES;
    LAS float* scr = (LAS float*)(lds + wave * 16384);
    constexpr int I_IN = (DM / 64) * (INC / 32), I_OUT = (DM / 64) * (DM / 32);
    for (int it = gw; it < 2 * (I_IN + I_OUT); it += ngw) {
        int r = it; const int l = r / (I_IN + I_OUT); r -= l * (I_IN + I_OUT);
        if (r < I_IN) transpose_item(p.w_in + (size_t)l * DM * INC, DM, INC, p.wt_in + (size_t)l * INC * DM, 0, 1, scr, r, lane);
        else transpose_item(p.w_out + (size_t)l * DM * DM, DM, DM, p.wt_out + (size_t)l * DM * DM, 0, 1, scr, r - I_IN, lane);
    }
    const f32x4* xs = (const f32x4*)p.x; u32x2* xd = (u32x2*)p.xb;
    for (long i = (long)BID * NTHREADS + TID; i < (long)T_TOK * DM / 4; i += (long)gridDim.x * NTHREADS) { const f32x4 v = xs[i]; u32x2 o; o.x = pk2(v[0], v[1]); o.y = pk2(v[2], v[3]); xd[i] = o; }
}
#define CONV_CHUNKS (NEXP * 768 / 32)
__device__ __forceinline__ void convert_expert_chunk(int WV, const Params& p, int l, int chunk, LAS unsigned char* lds, int lane) {
    LAS float* scr = (LAS float*)(lds + WV * 12288);
    constexpr int I_G = (DM / 64) * (DEXP / 32), I_D = (DEXP / 64) * (DM / 32);
    constexpr int PER_E = 2 * I_G + I_D;
    const int it0 = chunk * 32 + WV * 4;
    const int e = it0 / PER_E; const int r0 = it0 - e * PER_E;
    const size_t eo = ((size_t)l * NEXP + e) * DM * DEXP;
    TrItem t;
    if (r0 < I_G) t = TrItem{p.wg + eo, p.wt_gu + (size_t)e * DM * DM, DM, DEXP, 0, 2, r0};
    else if (r0 < 2 * I_G) t = TrItem{p.wu + eo, p.wt_gu + (size_t)e * DM * DM, DM, DEXP, 1, 2, r0 - I_G};
    else t = TrItem{p.wd + eo, p.wt_dn + (size_t)e * DM * DEXP, DEXP, DM, 0, 1, r0 - 2 * I_G};
    f32x4 va[8], vb[8];
    TrItem ta = t, tb = t; tb.item = t.item + 1;
    transpose_load(ta, lane, va); transpose_load(tb, lane, vb);
    transpose_emit(ta, lane, va, scr);
    ta.item = t.item + 2; transpose_load(ta, lane, va);
    transpose_emit(tb, lane, vb, scr);
    tb.item = t.item + 3; transpose_load(tb, lane, vb);
    ta.item = t.item + 2; transpose_emit(ta, lane, va, scr);
    transpose_emit(tb, lane, vb, scr);
}
__device__ void convert_expert_phase(int WV, const Params& p, int l, LAS unsigned char* lds) {
    const int TID = o_tid(WV), BID = o_bid();
    const int lane = TID & 63, wave = TID >> 6, gw = BID * NWAVES + wave, ngw = gridDim.x * NWAVES;
    LAS float* scr = (LAS float*)(lds + wave * 16384);
    constexpr int I_G = (DM / 64) * (DEXP / 32), I_D = (DEXP / 64) * (DM / 32);
    constexpr int PER_E = 2 * I_G + I_D;
    for (int it = gw; it < NEXP * PER_E; it += ngw) {
        const int e = it / PER_E; int r = it - e * PER_E;
        const size_t eo = ((size_t)l * NEXP + e) * DM * DEXP;
        if (r < I_G) transpose_item(p.wg + eo, DM, DEXP, p.wt_gu + (size_t)e * DM * DM, 0, 2, scr, r, lane);
        else if (r < 2 * I_G) transpose_item(p.wu + eo, DM, DEXP, p.wt_gu + (size_t)e * DM * DM, 1, 2, scr, r - I_G, lane);
        else transpose_item(p.wd + eo, DEXP, DM, p.wt_dn + (size_t)e * DM * DEXP, 0, 1, scr, r - 2 * I_G, lane);
    }
}

__device__ __forceinline__ void sincos_poly(double ang, float& c, float& s) {
    const double TWO_PI = 6.283185307179586476925, INV_2PI = 0.15915494309189533577;
    const double k = __builtin_rint(ang * INV_2PI); const double r = ang - k * TWO_PI; const double r2 = r * r;
    double sn = 1.0 / 51090942171709440000.0;
    sn = sn * r2 * -1.0 + 1.0 / 121645100408832000.0;
    sn = sn * -r2 + 1.0 / 355687428096000.0;
    sn = sn * -r2 + 1.0 / 1307674368000.0;
    sn = sn * -r2 + 1.0 / 6227020800.0;
    sn = sn * -r2 + 1.0 / 39916800.0;
    sn = sn * -r2 + 1.0 / 362880.0;
    sn = sn * -r2 + 1.0 / 5040.0;
    sn = sn * -r2 + 1.0 / 120.0;
    sn = sn * -r2 + 1.0 / 6.0;
    sn = sn * -r2 + 1.0;
    sn = sn * r;
    double cs = 1.0 / 2432902008176640000.0;
    cs = cs * -r2 + 1.0 / 6402373705728000.0;
    cs = cs * -r2 + 1.0 / 20922789888000.0;
    cs = cs * -r2 + 1.0 / 87178291200.0;
    cs = cs * -r2 + 1.0 / 479001600.0;
    cs = cs * -r2 + 1.0 / 3628800.0;
    cs = cs * -r2 + 1.0 / 40320.0;
    cs = cs * -r2 + 1.0 / 720.0;
    cs = cs * -r2 + 1.0 / 24.0;
    cs = cs * -r2 + 0.5;
    cs = cs * -r2 + 1.0;
    c = (float)cs; s = (float)sn;
}
__device__ void rope_table_phase(int WV, float2* tab, float* lbtab, const float* lb_logits) {
    const int TID = o_tid(WV), BID = o_bid();
    if (BID == 0) { for (int i = TID; i < 1024; i += NTHREADS) { lbtab[i] = 0.f; lbtab[1024 + i] = 1.0f / (1.0f + __expf(lb_logits[i] - lb_logits[1024 + i])); } }
    const double invf[8] = {1.0, 0.19392274474868576, 0.03760603093086393, 0.007292664737217109, 0.001414213562373095, 0.0002742481756762073, 5.318295896944988e-05, 1.031338537721246e-05};
    for (int idx = BID * NTHREADS + TID; idx < SEQ * 8; idx += gridDim.x * NTHREADS) {
        const int j = idx & 7, pos = idx >> 3;
        double f = invf[0];
#pragma unroll
        for (int q = 1; q < 8; ++q) f = (j == q) ? invf[q] : f;
        float c, s; sincos_poly((double)pos * f, c, s);
        tab[idx] = make_float2(c, s);
    }
}
typedef short s16x4 __attribute__((ext_vector_type(4)));
#define ATT_ST_STRIDE 68
#define ATT_ST_BYTES (256 * ATT_ST_STRIDE * 4)
#define ATT_VROW 160
#define ATT_KROW 144
#define ATT_SHV (256 * ATT_KROW)
#define ATT_VB_BYTES (2 * 32 * ATT_VROW)
__device__ void attn_phase(int WV, const Params& p, int layer, const bf16_t* proj, bf16_t* y, LAS unsigned char* lds, int* ctr) {
    const int tid = o_tid(WV), lane = tid & 63, g = lane >> 4, ql = lane & 15, BID = o_bid();
    LAS float* st = (LAS float*)lds;
    LAS unsigned char* vbp = lds + ATT_ST_BYTES + WV * ATT_VB_BYTES;
    const int vrd = (int)(uintptr_t)vbp + (4 * g + ((lane >> 2) & 3)) * ATT_VROW + (lane & 3) * 8;
    const float L2E = 1.4426950408889634f;
    LAS int* qslot = (LAS int*)(lds + 150 * 1024);
    LAS unsigned char* shb = lds + ATT_ST_BYTES;
#pragma unroll 1
    for (;;) {
        if (tid == 0) *qslot = atomicAdd(ctr, 1);
        __syncthreads();
        const int item = __builtin_amdgcn_readfirstlane(*qslot);
        if (item >= NB * 8 * 8 + CONV_CHUNKS) break;
        if (item >= NB * 8 * 8) {
            convert_expert_chunk(WV, p, layer, item - NB * 8 * 8, lds, lane);
            __syncthreads();
            continue;
        }
        const int blk = item & 7, head = (item >> 3) & 7, b = item >> 6;
        const int i0 = blk * 256;
        const bf16_t* base = proj + (size_t)b * SEQ * INC; const char* baseb = (const char*)base;
        const int qcol = 2560 + head * 64, kcol = 3072 + head * 64, vcol = 3584 + head * 64;
#define ATT_GEOM(n_, d_, L_, p0_, r_) do { const int br_ = (n_) >> 1, w_ = WV + 8 * ((n_) & 1); d_ = (br_ == 0) ? 1 : ((br_ == 1) ? 4 : 16); L_ = SEQ / d_; \
            if (br_ == 0) { p0_ = i0 + 16 * w_; r_ = 0; } else if (br_ == 1) { r_ = w_ & 3; p0_ = (i0 >> 2) + 16 * (w_ >> 2); } else { r_ = w_; p0_ = i0 >> 4; } } while (0)
#define ATT_LOAD_Q(d_, L_, p0_, r_) do { const int tq_ = d_ * (p0_ + ql) + r_; \
            { const unsigned qo_ = (unsigned)(tq_ * INC + qcol + 8 * g) * 2u; _Pragma("unroll") for (int ks = 0; ks < 2; ++ks) qf[ks] = *(const bf16x8*)(baseb + qo_ + 64 * ks); } } while (0)
#define ATT_LOAD_KQ(d_, L_, p0_, r_) do { ATT_LOAD_Q(d_, L_, p0_, r_); \
            if ((p0_) >= 64 && (p0_) <= (L_) - 96) {        \
                const unsigned kb_ = (unsigned)((d_ * ((p0_) - 64 + (lane >> 3)) + r_) * INC + kcol + 8 * (lane & 7)) * 2u, st_ = (unsigned)(8 * d_ * INC) * 2u; \
                _Pragma("unroll") for (int i_ = 0; i_ < 18; ++i_) kr[i_] = *(const u32x4*)(baseb + (kb_ + (unsigned)i_ * st_)); \
            } else { \
            _Pragma("unroll") for (int i_ = 0; i_ < 18; ++i_) { int pk = p0_ - 64 + 8 * i_ + (lane >> 3); pk = pk < 0 ? 0 : (pk > L_ - 1 ? L_ - 1 : pk); \
                kr[i_] = *(const u32x4*)(baseb + (unsigned)((d_ * pk + r_) * INC + kcol + 8 * (lane & 7)) * 2u); } } } while (0)
#define ATT_LOAD_V(d_, L_, p0_, r_, K0_, K1_) do { \
            if ((p0_) >= 64 && (p0_) <= (L_) - 96) { \
                const unsigned vb_ = (unsigned)((d_ * ((p0_) - 64 + (lane >> 3)) + r_) * INC + vcol + 8 * (lane & 7)) * 2u, st_ = (unsigned)(8 * d_ * INC) * 2u; \
                _Pragma("unroll") for (int k2 = K0_; k2 < K1_; ++k2) _Pragma("unroll") for (int j = 0; j < 4; ++j) vv[k2][j] = *(const u32x4*)(baseb + (vb_ + (unsigned)(4 * k2 + j) * st_)); \
            } else { \
            _Pragma("unroll") for (int k2 = K0_; k2 < K1_; ++k2) _Pragma("unroll") for (int j = 0; j < 4; ++j) { const int rr = (lane >> 3) + 8 * j; \
            int pk = p0_ - 64 + 32 * k2 + rr; pk = pk < 0 ? 0 : (pk > L_ - 1 ? L_ - 1 : pk); vv[k2][j] = *(const u32x4*)(baseb + (unsigned)((d_ * pk + r_) * INC + vcol + 8 * (lane & 7)) * 2u); } } } while (0)
        bf16x8 qf[2];
        {
            u32x4 tk[4], tv[5];
#define ATT_TILE_LOAD(h_) do { const int pb_ = i0 + 128 * (h_) - 64; \
            _Pragma("unroll") for (int j_ = 0; j_ < 4; ++j_) { const int id_ = tidl + 512 * j_; int pk = pb_ + (id_ >> 3); pk = pk < 0 ? 0 : (pk > SEQ - 1 ? SEQ - 1 : pk); \
                tk[j_] = *(const u32x4*)(baseb + (unsigned)(pk * INC + kcol + 8 * (id_ & 7)) * 2u); tv[j_] = *(const u32x4*)(baseb + (unsigned)(pk * INC + vcol + 8 * (id_ & 7)) * 2u); } \
            { const int id_ = 2048 + (tidl & 127); int pk = pb_ + (id_ >> 3); pk = pk < 0 ? 0 : (pk > SEQ - 1 ? SEQ - 1 : pk); tv[4] = *(const u32x4*)(baseb + (unsigned)(pk * INC + vcol + 8 * (id_ & 7)) * 2u); } } while (0)
#define ATT_TILE_WRITE() do { _Pragma("unroll") for (int j_ = 0; j_ < 4; ++j_) { const int id_ = tidl + 512 * j_; \
                *(LAS u32x4*)(shb + (id_ >> 3) * ATT_KROW + (id_ & 7) * 16) = tk[j_]; *(LAS u32x4*)(shb + ATT_SHV + (id_ >> 3) * ATT_VROW + (id_ & 7) * 16) = tv[j_]; } \
            if (tidl < 128) { const int id_ = 2048 + tidl; *(LAS u32x4*)(shb + ATT_SHV + (id_ >> 3) * ATT_VROW + (id_ & 7) * 16) = tv[4]; } } while (0)
            { const int lane = o_tid(WV) & 63, g = lane >> 4, ql = lane & 15, tidl = WV * 64 + lane; ATT_TILE_LOAD(0); ATT_LOAD_Q(1, SEQ, i0 + 16 * WV, 0); ATT_TILE_WRITE(); }
            __syncthreads();
#pragma unroll 1
            for (int h = 0; h < 2; ++h) {
                const int lane = o_tid(WV) & 63, g = lane >> 4, ql = lane & 15, tidl = WV * 64 + lane;
                const int p0 = i0 + 16 * (WV + 8 * h), L = SEQ;
                f32x4 s[9];
                {
                    const LAS unsigned char* kb0 = shb + (16 * WV + ql) * ATT_KROW + g * 16;
                    bf16x8 f0[9], f1[9];
#pragma unroll
                    for (int kt = 0; kt < 9; ++kt) { f0[kt] = *(const LAS bf16x8*)(kb0 + kt * 16 * ATT_KROW); f1[kt] = *(const LAS bf16x8*)(kb0 + kt * 16 * ATT_KROW + 64); }
#pragma unroll
                    for (int kt = 0; kt < 9; ++kt) {
                        f32x4 z = {0.f, 0.f, 0.f, 0.f};
                        z = __builtin_amdgcn_mfma_f32_16x16x32_bf16(f0[kt], qf[0], z, 0, 0, 0);
                        s[kt] = __builtin_amdgcn_mfma_f32_16x16x32_bf16(f1[kt], qf[1], z, 0, 0, 0); }
                }
                __builtin_amdgcn_sched_barrier(0);
                if (h == 0) { ATT_TILE_LOAD(1); ATT_LOAD_Q(1, SEQ, i0 + 16 * (WV + 8), 0); }
                __builtin_amdgcn_sched_barrier(0);
                float m = -3.0e38f;
                if (p0 >= 64 && p0 <= L - 80) {
#pragma unroll
                    for (int j = 0; j < 4; ++j) { s[0][j] = (4 * g + j >= ql) ? s[0][j] : -INFINITY; s[8][j] = (4 * g + j <= ql) ? s[8][j] : -INFINITY; }
#pragma unroll
                    for (int kt = 0; kt < 9; ++kt)
#pragma unroll
                        for (int j = 0; j < 4; ++j) m = fmaxf(m, s[kt][j]);
                } else {
                    const int klo = max(ql, 64 - p0), khi = min(ql + 128, L + 63 - p0);
#pragma unroll
                    for (int kt = 0; kt < 9; ++kt)
#pragma unroll
                        for (int j = 0; j < 4; ++j) { const int kk = 16 * kt + 4 * g + j; const bool ok = (kk >= klo) && (kk <= khi); s[kt][j] = ok ? s[kt][j] : -INFINITY; m = fmaxf(m, s[kt][j]); }
                }
                m = fmaxf(m, __shfl_xor(m, 16)); m = fmaxf(m, __shfl_xor(m, 32));
                float lsum = 0.f;
#pragma unroll
                for (int kt = 0; kt < 9; ++kt)
#pragma unroll
                    for (int j = 0; j < 4; ++j) { const float pe = __builtin_amdgcn_exp2f(s[kt][j] - m); s[kt][j] = pe; lsum += pe; }
                lsum += __shfl_xor(lsum, 16); lsum += __shfl_xor(lsum, 32);
                f32x4 o[4];
#pragma unroll
                for (int c = 0; c < 4; ++c) o[c] = (f32x4){0.f, 0.f, 0.f, 0.f};
                const int vrs = (int)(uintptr_t)(shb + ATT_SHV) + (16 * WV + 4 * g + ((lane >> 2) & 3)) * ATT_VROW + (lane & 3) * 8;
#pragma unroll
                for (int k2 = 0; k2 < 5; ++k2) {
                    bf16x8 pf;
                    { const f32x4 pa = s[2 * k2]; const f32x4 pb = (k2 < 4) ? s[2 * k2 + 1 < 9 ? 2 * k2 + 1 : 8] : (f32x4){0.f, 0.f, 0.f, 0.f};
                      u32x4 pw; pw.x = pg8::cvt_pk_bf16(pa[0], pa[1]); pw.y = pg8::cvt_pk_bf16(pa[2], pa[3]); pw.z = pg8::cvt_pk_bf16(pb[0], pb[1]); pw.w = pg8::cvt_pk_bf16(pb[2], pb[3]);
                      pf = __builtin_bit_cast(bf16x8, pw); }
                    s16x4 lo[4], hi[4];
#pragma unroll
                    for (int c = 0; c < 4; ++c) {
                        asm volatile("ds_read_b64_tr_b16 %0, %1 offset:%2" : "=&v"(lo[c]) : "v"(vrs), "i"(k2 * (32 * ATT_VROW) + 32 * c) : "memory");
                        asm volatile("ds_read_b64_tr_b16 %0, %1 offset:%2" : "=&v"(hi[c]) : "v"(vrs), "i"(k2 * (32 * ATT_VROW) + 16 * ATT_VROW + 32 * c) : "memory");
                    }
                    asm volatile("s_waitcnt lgkmcnt(0)" : "+v"(lo[0]), "+v"(hi[0]), "+v"(lo[1]), "+v"(hi[1]), "+v"(lo[2]), "+v"(hi[2]), "+v"(lo[3]), "+v"(hi[3]) :: "memory"); __builtin_amdgcn_sched_barrier(0);
#pragma unroll
                    for (int c = 0; c < 4; ++c) {
                        const bf16x8 af = (bf16x8){lo[c][0], lo[c][1], lo[c][2], lo[c][3], hi[c][0], hi[c][1], hi[c][2], hi[c][3]};
                        o[c] = __builtin_amdgcn_mfma_f32_16x16x32_bf16(af, pf, o[c], 0, 0, 0);
                    }
                }
                __builtin_amdgcn_sched_barrier(0);
                {
                    LAS float* sp = st + (p0 + ql - i0) * ATT_ST_STRIDE;
#pragma unroll
                    for (int c = 0; c < 4; ++c) *(LAS f32x4*)(sp + 16 * c + 4 * g) = o[c];
                    if (g == 0) { sp[64] = m; sp[65] = lsum; }
                }
                if (h == 0) { __syncthreads(); ATT_TILE_WRITE(); __syncthreads(); }
            }
#undef ATT_TILE_LOAD
#undef ATT_TILE_WRITE
        }
        u32x4 kr[18]; u32x4 vv[5][4];
        { const int lane = o_tid(WV) & 63, g = lane >> 4, ql = lane & 15; int d, L, p0, r; ATT_GEOM(2, d, L, p0, r); ATT_LOAD_KQ(d, L, p0, r); ATT_LOAD_V(d, L, p0, r, 0, ATT_VPRE); }
        __syncthreads();
#pragma unroll 1
        for (int n = 2; n < 6; ++n) {
            const int lane = o_tid(WV) & 63, g = lane >> 4, ql = lane & 15;
            const int vrd = (int)(uintptr_t)vbp + (4 * g + ((lane >> 2) & 3)) * ATT_VROW + (lane & 3) * 8;
            const int br = n >> 1;
            int d, L, p0, r; ATT_GEOM(n, d, L, p0, r);
            const int tq = d * (p0 + ql) + r;
            f32x4 s[9];
            {
                const int kwr = (lane >> 3) * ATT_KROW + (lane & 7) * 16, krd = ql * ATT_KROW + g * 16;
#pragma unroll
                for (int grp = 0; grp < 3; ++grp) {
#pragma unroll
                    for (int t = 0; t < 3; ++t) { const int kt = 3 * grp + t;
                        *(LAS u32x4*)(vbp + t * 16 * ATT_KROW + kwr) = kr[2 * kt]; *(LAS u32x4*)(vbp + t * 16 * ATT_KROW + 8 * ATT_KROW + kwr) = kr[2 * kt + 1]; }
                    bf16x8 f0[3], f1[3];
#pragma unroll
                    for (int t = 0; t < 3; ++t) { f0[t] = *(const LAS bf16x8*)(vbp + t * 16 * ATT_KROW + krd); f1[t] = *(const LAS bf16x8*)(vbp + t * 16 * ATT_KROW + krd + 64); }
#pragma unroll
                    for (int t = 0; t < 3; ++t) { const int kt = 3 * grp + t;
                        f32x4 z = {0.f, 0.f, 0.f, 0.f};
                        z = __builtin_amdgcn_mfma_f32_16x16x32_bf16(f0[t], qf[0], z, 0, 0, 0);
                        s[kt] = __builtin_amdgcn_mfma_f32_16x16x32_bf16(f1[t], qf[1], z, 0, 0, 0); }
                }
            }
            __builtin_amdgcn_sched_barrier(0);
            ATT_LOAD_V(d, L, p0, r, ATT_VPRE, 5);
            if (n < 5) { int d2, L2, p02, r2; ATT_GEOM(n + 1, d2, L2, p02, r2); ATT_LOAD_KQ(d2, L2, p02, r2); }
            __builtin_amdgcn_sched_barrier(0);
            float m = -3.0e38f;
            if (p0 >= 64 && p0 <= L - 80) {
#pragma unroll
                for (int j = 0; j < 4; ++j) { s[0][j] = (4 * g + j >= ql) ? s[0][j] : -INFINITY; s[8][j] = (4 * g + j <= ql) ? s[8][j] : -INFINITY; }
#pragma unroll
                for (int kt = 0; kt < 9; ++kt)
#pragma unroll
                    for (int j = 0; j < 4; ++j) m = fmaxf(m, s[kt][j]);
            } else {
                const int klo = max(ql, 64 - p0), khi = min(ql + 128, L + 63 - p0);
#pragma unroll
                for (int kt = 0; kt < 9; ++kt)
#pragma unroll
                    for (int j = 0; j < 4; ++j) { const int kk = 16 * kt + 4 * g + j; const bool ok = (kk >= klo) && (kk <= khi); s[kt][j] = ok ? s[kt][j] : -INFINITY; m = fmaxf(m, s[kt][j]); }
            }
            m = fmaxf(m, __shfl_xor(m, 16)); m = fmaxf(m, __shfl_xor(m, 32));
            float lsum = 0.f;
#pragma unroll
            for (int kt = 0; kt < 9; ++kt)
#pragma unroll
                for (int j = 0; j < 4; ++j) { const float pe = __builtin_amdgcn_exp2f(s[kt][j] - m); s[kt][j] = pe; lsum += pe; }
            lsum += __shfl_xor(lsum, 16); lsum += __shfl_xor(lsum, 32);
            f32x4 o[4];
#pragma unroll
            for (int c = 0; c < 4; ++c) o[c] = (f32x4){0.f, 0.f, 0.f, 0.f};
#pragma unroll
            for (int j = 0; j < 4; ++j) { const int rr = (lane >> 3) + 8 * j; *(LAS u32x4*)(vbp + rr * ATT_VROW + (lane & 7) * 16) = vv[0][j]; }
#pragma unroll
            for (int k2 = 0; k2 < 5; ++k2) {
                if (k2 < 4) {
#pragma unroll
                    for (int j = 0; j < 4; ++j) { const int rr = (lane >> 3) + 8 * j; *(LAS u32x4*)(vbp + ((k2 + 1) & 1) * (32 * ATT_VROW) + rr * ATT_VROW + (lane & 7) * 16) = vv[k2 + 1][j]; } }
                bf16x8 pf;
                { const f32x4 pa = s[2 * k2]; const f32x4 pb = (k2 < 4) ? s[2 * k2 + 1 < 9 ? 2 * k2 + 1 : 8] : (f32x4){0.f, 0.f, 0.f, 0.f};
                  u32x4 pw; pw.x = pg8::cvt_pk_bf16(pa[0], pa[1]); pw.y = pg8::cvt_pk_bf16(pa[2], pa[3]); pw.z = pg8::cvt_pk_bf16(pb[0], pb[1]); pw.w = pg8::cvt_pk_bf16(pb[2], pb[3]);
                  pf = __builtin_bit_cast(bf16x8, pw); }
                s16x4 lo[4], hi[4];
#pragma unroll
                for (int c = 0; c < 4; ++c) {
                    asm volatile("ds_read_b64_tr_b16 %0, %1 offset:%2" : "=&v"(lo[c]) : "v"(vrd), "i"((k2 & 1) * (32 * ATT_VROW) + 32 * c) : "memory");
                    asm volatile("ds_read_b64_tr_b16 %0, %1 offset:%2" : "=&v"(hi[c]) : "v"(vrd), "i"((k2 & 1) * (32 * ATT_VROW) + 16 * ATT_VROW + 32 * c) : "memory");
                }
                asm volatile("s_waitcnt lgkmcnt(0)" ::: "memory"); __builtin_amdgcn_sched_barrier(0);
#pragma unroll
                for (int c = 0; c < 4; ++c) {
                    const bf16x8 af = (bf16x8){lo[c][0], lo[c][1], lo[c][2], lo[c][3], hi[c][0], hi[c][1], hi[c][2], hi[c][3]};
                    o[c] = __builtin_amdgcn_mfma_f32_16x16x32_bf16(af, pf, o[c], 0, 0, 0);
                }
            }
            __builtin_amdgcn_sched_barrier(0);
            if (n < 5) { int d2, L2, p02, r2; ATT_GEOM(n + 1, d2, L2, p02, r2); ATT_LOAD_V(d2, L2, p02, r2, 0, ATT_VPRE); }
            __builtin_amdgcn_sched_barrier(0);
            const int tl = tq - i0;
            LAS float* sp = st + tl * ATT_ST_STRIDE;
            if (br == 0) {
#pragma unroll
                for (int c = 0; c < 4; ++c) *(LAS f32x4*)(sp + 16 * c + 4 * g) = o[c];
                if (g == 0) { sp[64] = m; sp[65] = lsum; }
            } else {
                const float mo = sp[64], lo_ = sp[65];
                f32x4 oo[4];
#pragma unroll
                for (int c = 0; c < 4; ++c) oo[c] = *(const LAS f32x4*)(sp + 16 * c + 4 * g);
                const float mn = fmaxf(mo, m);
                const float fa = __builtin_amdgcn_exp2f(mo - mn), fb = __builtin_amdgcn_exp2f(m - mn);
                const float ln = fa * lo_ + fb * lsum;
                if (br == 1) {
#pragma unroll
                    for (int c = 0; c < 4; ++c) *(LAS f32x4*)(sp + 16 * c + 4 * g) = oo[c] * fa + o[c] * fb;
                    if (g == 0) { sp[64] = mn; sp[65] = ln; }
                } else {
                    const float inv = 1.0f / ln;
                    bf16_t* yp = y + ((size_t)b * SEQ + tq) * DM + 512 + head * 64 + 4 * g;
#pragma unroll
                    for (int c = 0; c < 4; ++c) { const f32x4 ov = (oo[c] * fa + o[c] * fb) * inv;
                        u32x2 wv2; wv2.x = pg8::cvt_pk_bf16(ov[0], ov[1]); wv2.y = pg8::cvt_pk_bf16(ov[2], ov[3]); *(u32x2*)(yp + 16 * c) = wv2; }
                }
            }
            if (n & 1) __syncthreads();
        }
#undef ATT_GEOM
#undef ATT_LOAD_KQ
#undef ATT_LOAD_Q
    }
}

#define HG_QS 272
#define HG_SS 144
#define HG_QT 0
#define HG_KT 17408
#define HG_VT 34816
#define HG_ST 52224
#define HG_OST 34816
#define HG_MISC 68608
#define HG_GRP 70656
#define HG_OS 528
typedef float f32x16 __attribute__((ext_vector_type(16)));
#define TR_READ(dst, base, off) asm volatile("ds_read_b64_tr_b16 %0, %1 offset:%2" : "=&v"(dst) : "v"(base), "i"(off) : "memory")
#define HG_BAR() do { asm volatile("s_waitcnt lgkmcnt(0)" ::: "memory"); __builtin_amdgcn_s_barrier(); asm volatile("" ::: "memory"); } while (0)
__device__ void hgrn_phase(int WV, const Params& p, int layer, LAS unsigned char* lds) {
    const int BID = o_bid();
    const int grp = WV >> 2, w = WV & 3;
    LAS unsigned char* gl = lds + grp * HG_GRP;
    LAS float* tot = (LAS float*)(gl + HG_MISC); LAS float* sref = tot + 256; LAS float* send = tot + 384;
    const int half = (WV >> 1) & 1;
#pragma unroll 1
    for (int item = BID; item < NB * 4; item += gridDim.x) {
        const int h = item & 3, b = item >> 2;
        const int c = (WV & 1) * 64 + (o_tid(WV) & 63);
        const bf16_t* pb = p.proj + (size_t)b * SEQ * INC;
        f32x16 stt[4];
#pragma unroll
        for (int ct = 0; ct < 4; ++ct)
#pragma unroll
            for (int i = 0; i < 16; ++i) stt[ct][i] = 0.f;
        { const int lane0 = o_tid(WV) & 63, cw0 = WV & 1, cf0 = grp ? 31 * 64 : 0;
#pragma unroll
          for (int k = 0; k < 4; ++k) { const int id = lane0 + 64 * k, tau = 32 * half + (id >> 3), ch = id & 7; const int t = grp ? (cf0 + 63 - tau) : (cf0 + tau);
              const bf16_t* row = pb + (size_t)t * INC + h * 128 + 64 * cw0 + 8 * ch; const u32x4 q0 = *(const u32x4*)row, a0 = *(const u32x4*)(row + 512 + grp * 512);
              *(LAS u32x4*)(gl + HG_QT + tau * HG_QS + (64 * cw0 + 8 * ch) * 2) = q0; *(LAS u32x4*)(gl + HG_KT + tau * HG_QS + (64 * cw0 + 8 * ch) * 2) = a0; } }
        u32x4 vld[4];
        { const int gt0 = (WV & 3) * 64 + (o_tid(WV) & 63), cf0 = grp ? 31 * 64 : 0;
#pragma unroll
          for (int i = 0; i < 4; ++i) { const int id = gt0 + 256 * i, tau = id >> 4, ch = id & 15; const int t = grp ? (cf0 + 63 - tau) : (cf0 + tau);
              vld[i] = *(const u32x4*)(pb + (size_t)t * INC + 1536 + h * 128 + 8 * ch); } }
#pragma unroll 1
        for (int j = 0; j < 32; ++j) {
            const int ci = grp ? (31 - j) : j, c0 = ci * 64;
            const int lane = o_tid(WV) & 63, gt = w * 64 + lane, r = lane & 31, hh = lane >> 5;
            const int gi = lane >> 4, li = lane & 15, tq = li >> 2, tp = li & 3;
            const int trV = (int)(uintptr_t)(gl + HG_VT) + (8 * hh + tq) * HG_QS + (32 * w + 16 * (gi & 1) + 4 * tp) * 2;
            const int trK = (int)(uintptr_t)(gl + HG_KT) + (8 * hh + tq) * HG_QS + (16 * (gi & 1) + 4 * tp) * 2;
            if (j > 0) {
#pragma unroll
                for (int i = 0; i < 4; ++i) { const int id = gt + 256 * i, tau = id >> 4, ch = id & 15; const int t = grp ? (c0 + 63 - tau) : (c0 + tau);
                    vld[i] = *(const u32x4*)(pb + (size_t)t * INC + 1536 + h * 128 + 8 * ch); }
            }
            const int cw = WV & 1;
            unsigned kq[32];
            {
                float pl = 1.0f;
#pragma unroll
                for (int i = 0; i < 32; ++i) { const int tau = 32 * half + i;
                    const unsigned qraw = *(const LAS bf16_t*)(gl + HG_QT + tau * HG_QS + c * 2), fraw = *(const LAS bf16_t*)(gl + HG_KT + tau * HG_QS + c * 2);
                    pl = fmaxf(pl * __uint_as_float(fraw << 16), 1e-30f);
                    kq[i] = fraw | (qraw << 16);
                    if ((i & 7) == 7) __builtin_amdgcn_sched_barrier(0);
                }
                tot[half * 128 + c] = pl;
            }
            asm volatile("s_waitcnt vmcnt(0)" ::: "memory");
            HG_BAR();
            {
                const float t0 = tot[c], t1 = tot[128 + c];
                const float fa = half ? 1.0f : __builtin_amdgcn_rcpf(t0), fb = half ? 1.0f : t0;
                float pl = 1.0f;
#pragma unroll
                for (int i = 0; i < 32; ++i) { const int tau = 32 * half + i;
                    const float f = __uint_as_float(kq[i] << 16), qq = __uint_as_float(kq[i] & 0xffff0000u);
                    pl = fmaxf(pl * f, 1e-30f);
                    const float eq = pl * fa, ek = fb * __builtin_amdgcn_rcpf(pl);
                    const unsigned pk = pg8::cvt_pk_bf16(qq * eq, (1.0f - f) * ek);
                    *(LAS bf16_t*)(gl + HG_QT + tau * HG_QS + c * 2) = (bf16_t)(pk & 0xffffu);
                    *(LAS bf16_t*)(gl + HG_KT + tau * HG_QS + c * 2) = (bf16_t)(pk >> 16);
                    if ((i & 7) == 7) __builtin_amdgcn_sched_barrier(0); }
                if (half == 0) sref[c] = t0; else send[c] = t1;
#pragma unroll
                for (int i = 0; i < 4; ++i) { const int id = gt + 256 * i, tau = id >> 4, ch = id & 15; *(LAS u32x4*)(gl + HG_VT + tau * HG_QS + ch * 16) = vld[i]; }
            }
            HG_BAR();
            u32x4 rq[4], ra[4];
            if (j < 31) {
                const int cn = grp ? (30 - j) : (j + 1), cn0 = cn * 64;
#pragma unroll
                for (int k = 0; k < 4; ++k) { const int id = lane + 64 * k, tau = 32 * half + (id >> 3), ch = id & 7; const int t = grp ? (cn0 + 63 - tau) : (cn0 + tau);
                    const bf16_t* row = pb + (size_t)t * INC + h * 128 + 64 * cw + 8 * ch; rq[k] = *(const u32x4*)row; ra[k] = *(const u32x4*)(row + 512 + grp * 512); }
            }
#pragma unroll
            for (int ct = 0; ct < 4; ++ct)
#pragma unroll
                for (int s = 0; s < 2; ++s) { const f32x4 s0 = *(const LAS f32x4*)(sref + 32 * ct + 16 * s + 4 * hh), s1 = *(const LAS f32x4*)(sref + 32 * ct + 16 * s + 8 + 4 * hh);
#pragma unroll
                    for (int i = 0; i < 4; ++i) { stt[ct][8 * s + i] *= s0[i]; stt[ct][8 * s + 4 + i] *= s1[i]; } }
            if (w != 1) {
                const int st_ = (w == 3) ? 1 : 0, tt_ = (w == 0) ? 0 : 1;
                f32x16 sa;
#pragma unroll
                for (int i = 0; i < 16; ++i) sa[i] = 0.f;
#pragma unroll
                for (int ks = 0; ks < 8; ++ks) {
                    const bf16x8 ka = *(const LAS bf16x8*)(gl + HG_KT + (32 * st_ + r) * HG_QS + (16 * ks + 8 * hh) * 2);
                    const bf16x8 qb = *(const LAS bf16x8*)(gl + HG_QT + (32 * tt_ + r) * HG_QS + (16 * ks + 8 * hh) * 2);
                    sa = __builtin_amdgcn_mfma_f32_32x32x16_bf16(ka, qb, sa, 0, 0, 0);
                }
                const int tau_abs = 32 * tt_ + r;
#pragma unroll
                for (int rg = 0; rg < 4; ++rg) { float v4[4];
#pragma unroll
                    for (int i = 0; i < 4; ++i) { const int sig_abs = 32 * st_ + 8 * rg + 4 * hh + i; v4[i] = (sig_abs <= tau_abs) ? sa[4 * rg + i] : 0.f; }
                    u32x2 wv2; wv2.x = pg8::cvt_pk_bf16(v4[0], v4[1]); wv2.y = pg8::cvt_pk_bf16(v4[2], v4[3]);
                    *(LAS u32x2*)(gl + HG_ST + tau_abs * HG_SS + (32 * st_ + 8 * rg + 4 * hh) * 2) = wv2; }
            }
            __builtin_amdgcn_sched_barrier(0);
            f32x16 oacc[2];
#pragma unroll
            for (int tt = 0; tt < 2; ++tt)
#pragma unroll
                for (int i = 0; i < 16; ++i) oacc[tt][i] = 0.f;
#pragma unroll
            for (int ct = 0; ct < 4; ++ct)
#pragma unroll
                for (int s = 0; s < 2; ++s) {
                    u32x4 bw; bw.x = pg8::cvt_pk_bf16(stt[ct][8 * s + 0], stt[ct][8 * s + 1]); bw.y = pg8::cvt_pk_bf16(stt[ct][8 * s + 2], stt[ct][8 * s + 3]);
                    bw.z = pg8::cvt_pk_bf16(stt[ct][8 * s + 4], stt[ct][8 * s + 5]); bw.w = pg8::cvt_pk_bf16(stt[ct][8 * s + 6], stt[ct][8 * s + 7]);
                    const bf16x8 bfr = __builtin_bit_cast(bf16x8, bw);
#pragma unroll
                    for (int tt = 0; tt < 2; ++tt) {
                        const LAS unsigned char* qa = gl + HG_QT + (32 * tt + r) * HG_QS + (32 * ct + 16 * s + 4 * hh) * 2;
                        const u32x2 a0 = *(const LAS u32x2*)qa, a1 = *(const LAS u32x2*)(qa + 16);
                        u32x4 aw; aw.x = a0.x; aw.y = a0.y; aw.z = a1.x; aw.w = a1.y;
                        oacc[tt] = __builtin_amdgcn_mfma_f32_32x32x16_bf16(__builtin_bit_cast(bf16x8, aw), bfr, oacc[tt], 0, 0, 0);
                    }
                    __builtin_amdgcn_sched_barrier(0);
                }
            HG_BAR();
            bf16x8 vf[4];
            { s16x4 lo[4], hi[4];
#pragma unroll
              for (int ks = 0; ks < 4; ++ks) { TR_READ(lo[ks], trV, (16 * ks) * HG_QS); TR_READ(hi[ks], trV, (16 * ks + 4) * HG_QS); }
              asm volatile("s_waitcnt lgkmcnt(0)" : "+v"(lo[0]), "+v"(hi[0]), "+v"(lo[1]), "+v"(hi[1]), "+v"(lo[2]), "+v"(hi[2]), "+v"(lo[3]), "+v"(hi[3]) :: "memory");
#pragma unroll
              for (int ks = 0; ks < 4; ++ks) vf[ks] = (bf16x8){lo[ks][0], lo[ks][1], lo[ks][2], lo[ks][3], hi[ks][0], hi[ks][1], hi[ks][2], hi[ks][3]}; }
            __builtin_amdgcn_sched_barrier(0);
#pragma unroll
            for (int tt = 0; tt < 2; ++tt)
#pragma unroll
                for (int ks = 0; ks < 4; ++ks) { if (tt == 0 && ks >= 2) continue;
                    const bf16x8 sfr = *(const LAS bf16x8*)(gl + HG_ST + (32 * tt + r) * HG_SS + (16 * ks + 8 * hh) * 2);
                    oacc[tt] = __builtin_amdgcn_mfma_f32_32x32x16_bf16(sfr, vf[ks], oacc[tt], 0, 0, 0); }
#pragma unroll
            for (int ct = 0; ct < 4; ++ct) {
                bf16x8 kf[4];
                { s16x4 lo[4], hi[4];
#pragma unroll
                  for (int ks = 0; ks < 4; ++ks) { TR_READ(lo[ks], trK, (16 * ks) * HG_QS + 64 * ct); TR_READ(hi[ks], trK, (16 * ks + 4) * HG_QS + 64 * ct); }
                  asm volatile("s_waitcnt lgkmcnt(0)" : "+v"(lo[0]), "+v"(hi[0]), "+v"(lo[1]), "+v"(hi[1]), "+v"(lo[2]), "+v"(hi[2]), "+v"(lo[3]), "+v"(hi[3]) :: "memory");
#pragma unroll
                  for (int ks = 0; ks < 4; ++ks) kf[ks] = (bf16x8){lo[ks][0], lo[ks][1], lo[ks][2], lo[ks][3], hi[ks][0], hi[ks][1], hi[ks][2], hi[ks][3]}; }
                __builtin_amdgcn_sched_barrier(0);
#pragma unroll
                for (int ks = 0; ks < 4; ++ks) stt[ct] = __builtin_amdgcn_mfma_f32_32x32x16_bf16(kf[ks], vf[ks], stt[ct], 0, 0, 0);
#pragma unroll
                for (int s = 0; s < 2; ++s) { const f32x4 s0 = *(const LAS f32x4*)(send + 32 * ct + 16 * s + 4 * hh), s1 = *(const LAS f32x4*)(send + 32 * ct + 16 * s + 8 + 4 * hh);
#pragma unroll
                    for (int i = 0; i < 4; ++i) { stt[ct][8 * s + i] *= s0[i]; stt[ct][8 * s + 4 + i] *= s1[i]; } }
            }
            HG_BAR();
            if (j < 31) {
#pragma unroll
                for (int k = 0; k < 4; ++k) { const int id = lane + 64 * k, tau = 32 * half + (id >> 3), ch = id & 7;
                    *(LAS u32x4*)(gl + HG_QT + tau * HG_QS + (64 * cw + 8 * ch) * 2) = rq[k]; *(LAS u32x4*)(gl + HG_KT + tau * HG_QS + (64 * cw + 8 * ch) * 2) = ra[k]; }
            }
#pragma unroll
            for (int tt = 0; tt < 2; ++tt)
#pragma unroll
                for (int i = 0; i < 16; ++i) { const int tau = 32 * tt + (i & 3) + 8 * (i >> 2) + 4 * hh; *(LAS float*)(gl + HG_OST + tau * HG_OS + (32 * w + r) * 4) = oacc[tt][i]; }
            HG_BAR();
            {
                const int tau = gt >> 2, seg = gt & 3; const int t = grp ? (c0 + 63 - tau) : (c0 + tau);
                const LAS f32x4* orow = (const LAS f32x4*)(gl + HG_OST + tau * HG_OS + seg * 128);
                bf16_t* yp = p.y + ((size_t)b * SEQ + t) * DM + h * 128 + seg * 32;
                if (j < 16) {
#pragma unroll
                    for (int i = 0; i < 4; ++i) { const f32x4 oa = orow[2 * i], ob = orow[2 * i + 1];
                        u32x4 o4; o4.x = pg8::cvt_pk_bf16(oa[0], oa[1]); o4.y = pg8::cvt_pk_bf16(oa[2], oa[3]); o4.z = pg8::cvt_pk_bf16(ob[0], ob[1]); o4.w = pg8::cvt_pk_bf16(ob[2], ob[3]); *(u32x4*)(yp + 8 * i) = o4; }
                } else {
                    const bf16_t* hg = p.proj + ((size_t)b * SEQ + t) * INC + 2048 + h * 128 + seg * 32;
                    LAS f32x4* erow = (LAS f32x4*)(gl + HG_OST + tau * HG_OS + seg * 128);
                    float ss = 0.f;
                    { u32x4 fpv[4];
#pragma unroll
                      for (int i = 0; i < 4; ++i) fpv[i] = *(const u32x4*)(yp + 8 * i);
                      __builtin_amdgcn_sched_barrier(0);
#pragma unroll
                      for (int i = 0; i < 4; ++i) { f32x4 oa = erow[2 * i], ob = erow[2 * i + 1]; const u32x4 pv = fpv[i];
                          oa[0] += __uint_as_float(pv.x << 16); oa[1] += __uint_as_float(pv.x & 0xffff0000u); oa[2] += __uint_as_float(pv.y << 16); oa[3] += __uint_as_float(pv.y & 0xffff0000u);
                          ob[0] += __uint_as_float(pv.z << 16); ob[1] += __uint_as_float(pv.z & 0xffff0000u); ob[2] += __uint_as_float(pv.w << 16); ob[3] += __uint_as_float(pv.w & 0xffff0000u);
                          erow[2 * i] = oa; erow[2 * i + 1] = ob;
                          const f32x4 qa = oa * oa, qb = ob * ob; ss += (qa[0] + qa[1]) + (qa[2] + qa[3]) + (qb[0] + qb[1]) + (qb[2] + qb[3]); } }
                    __builtin_amdgcn_sched_barrier(0);
                    u32x4 fgv[4];
#pragma unroll
                    for (int i = 0; i < 4; ++i) fgv[i] = *(const u32x4*)(hg + 8 * i);
                    ss += __shfl_xor(ss, 1); ss += __shfl_xor(ss, 2);
                    const float rn = rsqrtf(ss * (1.0f / 128.0f) + 1e-6f);
                    __builtin_amdgcn_sched_barrier(0);
#pragma unroll
                    for (int i = 0; i < 4; ++i) { const f32x4 oa = erow[2 * i] * rn, ob = erow[2 * i + 1] * rn; const u32x4 gv = fgv[i];
                        u32x4 o4;
                        o4.x = pg8::cvt_pk_bf16(oa[0] * __uint_as_float(gv.x << 16), oa[1] * __uint_as_float(gv.x & 0xffff0000u));
                        o4.y = pg8::cvt_pk_bf16(oa[2] * __uint_as_float(gv.y << 16), oa[3] * __uint_as_float(gv.y & 0xffff0000u));
                        o4.z = pg8::cvt_pk_bf16(ob[0] * __uint_as_float(gv.z << 16), ob[1] * __uint_as_float(gv.z & 0xffff0000u));
                        o4.w = pg8::cvt_pk_bf16(ob[2] * __uint_as_float(gv.w << 16), ob[3] * __uint_as_float(gv.w & 0xffff0000u));
                        *(u32x4*)(yp + 8 * i) = o4; }
                }
            }
        }
        asm volatile("s_waitcnt vmcnt(0)" ::: "memory");
        __syncthreads();
    }
}

#define H2_QT 0
#define H2_KT 17408
#define H2_VT 34816
#define H2_ST 52224
#define H2_MISC 61440
#define H2_BUF 62464
#define H2_OST (2 * H2_BUF)
#define H2_FLAG (H2_OST + 17408)
__device__ void hgrn2_phase(int WV, const Params& p, int layer, LAS unsigned char* lds) {
    const int BID = o_bid();
    const int w = WV & 3;
#pragma unroll 1
    for (int item = BID; item < NB * 4 * 2; item += gridDim.x) {
        const int dir = item & 1, h = (item >> 1) & 3, b = item >> 3;
        const bf16_t* pb = p.proj + (size_t)b * SEQ * INC;
        bf16_t* odst = dir ? (p.ob + (size_t)b * SEQ * 512 + h * 128) : (p.y + (size_t)b * SEQ * DM + h * 128);
        const int ostride = dir ? 512 : DM;
        if (WV < 4) {
            f32x16 stt[4];
#pragma unroll
            for (int ct = 0; ct < 4; ++ct)
#pragma unroll
                for (int i = 0; i < 16; ++i) stt[ct][i] = 0.f;
#pragma unroll 1
            for (int k = -1; k <= 32; ++k) {
                const int lane = o_tid(WV) & 63, r = lane & 31, hh = lane >> 5;
                if (k >= 1) {
                    const int st_ = w * 64 + lane; const int cp0 = (dir ? (31 - (k - 1)) : (k - 1)) * 64; const int row = st_ >> 2, seg = st_ & 3; const int t = dir ? (cp0 + 63 - row) : (cp0 + row);
                    const LAS u32x4* sp = (const LAS u32x4*)(lds + H2_OST + row * HG_QS + seg * 64);
                    u32x4* dp = (u32x4*)(odst + (size_t)t * ostride + seg * 32);
#pragma unroll
                    for (int i = 0; i < 4; ++i) dp[i] = sp[i];
                }
                if (k < 0 || k > 31) { HG_BAR(); HG_BAR(); continue; }
                const int gi = lane >> 4, li = lane & 15, tq = li >> 2, tp = li & 3;
                LAS unsigned char* gl = lds + (k & 1) * H2_BUF;
                LAS float* sref = (LAS float*)(gl + H2_MISC); LAS float* send = sref + 128;
                const int trV = (int)(uintptr_t)(gl + H2_VT) + (8 * hh + tq) * HG_QS + (32 * w + 16 * (gi & 1) + 4 * tp) * 2;
                const int trK = (int)(uintptr_t)(gl + H2_KT) + (8 * hh + tq) * HG_QS + (16 * (gi & 1) + 4 * tp) * 2;
                u32x4 aw[4][2][2];
#pragma unroll
                for (int ct = 0; ct < 4; ++ct)
#pragma unroll
                    for (int s = 0; s < 2; ++s)
#pragma unroll
                        for (int tt = 0; tt < 2; ++tt) {
                            const LAS unsigned char* qa = gl + H2_QT + (32 * tt + r) * HG_QS + (32 * ct + 16 * s + 4 * hh) * 2;
                            const u32x2 a0 = *(const LAS u32x2*)qa, a1 = *(const LAS u32x2*)(qa + 16);
                            aw[ct][s][tt].x = a0.x; aw[ct][s][tt].y = a0.y; aw[ct][s][tt].z = a1.x; aw[ct][s][tt].w = a1.y; }
#pragma unroll
                for (int ct = 0; ct < 4; ++ct)
#pragma unroll
                    for (int s = 0; s < 2; ++s) { const f32x4 s0 = *(const LAS f32x4*)(sref + 32 * ct + 16 * s + 4 * hh), s1 = *(const LAS f32x4*)(sref + 32 * ct + 16 * s + 8 + 4 * hh);
#pragma unroll
                        for (int i = 0; i < 4; ++i) { stt[ct][8 * s + i] *= s0[i]; stt[ct][8 * s + 4 + i] *= s1[i]; } }
                f32x16 oacc[2];
#pragma unroll
                for (int tt = 0; tt < 2; ++tt)
#pragma unroll
                    for (int i = 0; i < 16; ++i) oacc[tt][i] = 0.f;
#pragma unroll
                for (int ct = 0; ct < 4; ++ct)
#pragma unroll
                    for (int s = 0; s < 2; ++s) {
                        u32x4 bw; bw.x = pg8::cvt_pk_bf16(stt[ct][8 * s + 0], stt[ct][8 * s + 1]); bw.y = pg8::cvt_pk_bf16(stt[ct][8 * s + 2], stt[ct][8 * s + 3]);
                        bw.z = pg8::cvt_pk_bf16(stt[ct][8 * s + 4], stt[ct][8 * s + 5]); bw.w = pg8::cvt_pk_bf16(stt[ct][8 * s + 6], stt[ct][8 * s + 7]);
                        const bf16x8 bfr = __builtin_bit_cast(bf16x8, bw);
#pragma unroll
                        for (int tt = 0; tt < 2; ++tt) oacc[tt] = __builtin_amdgcn_mfma_f32_32x32x16_bf16(bfr, __builtin_bit_cast(bf16x8, aw[ct][s][tt]), oacc[tt], 0, 0, 0);
                    }
                bf16x8 vf[4];
                { s16x4 lo[4], hi[4];
#pragma unroll
                  for (int ks = 0; ks < 4; ++ks) { TR_READ(lo[ks], trV, (16 * ks) * HG_QS); TR_READ(hi[ks], trV, (16 * ks + 4) * HG_QS); }
                  asm volatile("s_waitcnt lgkmcnt(0)" : "+v"(lo[0]), "+v"(hi[0]), "+v"(lo[1]), "+v"(hi[1]), "+v"(lo[2]), "+v"(hi[2]), "+v"(lo[3]), "+v"(hi[3]) :: "memory");
#pragma unroll
                  for (int ks = 0; ks < 4; ++ks) vf[ks] = (bf16x8){lo[ks][0], lo[ks][1], lo[ks][2], lo[ks][3], hi[ks][0], hi[ks][1], hi[ks][2], hi[ks][3]}; }
                __builtin_amdgcn_sched_barrier(0);
#pragma unroll
                for (int ct = 0; ct < 4; ++ct) {
                    bf16x8 kf[4];
                    { s16x4 lo[4], hi[4];
#pragma unroll
                      for (int ks = 0; ks < 4; ++ks) { TR_READ(lo[ks], trK, (16 * ks) * HG_QS + 64 * ct); TR_READ(hi[ks], trK, (16 * ks + 4) * HG_QS + 64 * ct); }
                      asm volatile("s_waitcnt lgkmcnt(0)" : "+v"(lo[0]), "+v"(hi[0]), "+v"(lo[1]), "+v"(hi[1]), "+v"(lo[2]), "+v"(hi[2]), "+v"(lo[3]), "+v"(hi[3]) :: "memory");
#pragma unroll
                      for (int ks = 0; ks < 4; ++ks) kf[ks] = (bf16x8){lo[ks][0], lo[ks][1], lo[ks][2], lo[ks][3], hi[ks][0], hi[ks][1], hi[ks][2], hi[ks][3]}; }
                    __builtin_amdgcn_sched_barrier(0);
#pragma unroll
                    for (int ks = 0; ks < 4; ++ks) stt[ct] = __builtin_amdgcn_mfma_f32_32x32x16_bf16(kf[ks], vf[ks], stt[ct], 0, 0, 0);
#pragma unroll
                    for (int s = 0; s < 2; ++s) { const f32x4 s0 = *(const LAS f32x4*)(send + 32 * ct + 16 * s + 4 * hh), s1 = *(const LAS f32x4*)(send + 32 * ct + 16 * s + 8 + 4 * hh);
#pragma unroll
                        for (int i = 0; i < 4; ++i) { stt[ct][8 * s + i] *= s0[i]; stt[ct][8 * s + 4 + i] *= s1[i]; } }
                }
                HG_BAR();
#pragma unroll
                for (int tt = 0; tt < 2; ++tt)
#pragma unroll
                    for (int ks = 0; ks < 4; ++ks) { if (tt == 0 && ks >= 2) continue;
                        const bf16x8 sfr = *(const LAS bf16x8*)(gl + H2_ST + (32 * tt + r) * HG_SS + (16 * ks + 8 * hh) * 2);
                        oacc[tt] = __builtin_amdgcn_mfma_f32_32x32x16_bf16(vf[ks], sfr, oacc[tt], 0, 0, 0); }
#pragma unroll
                for (int tt = 0; tt < 2; ++tt)
#pragma unroll
                    for (int q = 0; q < 4; ++q) { u32x2 pk; pk.x = pg8::cvt_pk_bf16(oacc[tt][4 * q], oacc[tt][4 * q + 1]); pk.y = pg8::cvt_pk_bf16(oacc[tt][4 * q + 2], oacc[tt][4 * q + 3]);
                        *(LAS u32x2*)(lds + H2_OST + (32 * tt + r) * HG_QS + (32 * w + 8 * q + 4 * hh) * 2) = pk; }
                HG_BAR();
            }
        } else {
            const int pw = WV - 4;
            u32x4 rq[4], rf[4], rv[4];
            {
                const int lane = o_tid(WV) & 63, pt = pw * 64 + lane; const int c0 = (dir ? 31 : 0) * 64;
#pragma unroll
                for (int i = 0; i < 4; ++i) { const int row = 16 * i + (lane & 15), ch = lane >> 4; const int t = dir ? (c0 + 63 - row) : (c0 + row);
                    const bf16_t* src = pb + (size_t)t * INC + h * 128 + 32 * pw + 8 * ch; rq[i] = *(const u32x4*)src; rf[i] = *(const u32x4*)(src + 512 + dir * 512); }
#pragma unroll
                for (int i = 0; i < 4; ++i) { const int id = pt + 256 * i, tau = id >> 4, ch = id & 15; const int t = dir ? (c0 + 63 - tau) : (c0 + tau);
                    rv[i] = *(const u32x4*)(pb + (size_t)t * INC + 1536 + h * 128 + 8 * ch); }
            }
#pragma unroll 1
            for (int k = -1; k <= 32; ++k) {
                const int lane = o_tid(WV) & 63, pt = pw * 64 + lane, cl = lane & 31, half = lane >> 5, c = 32 * pw + cl;
                LAS unsigned char* gn = lds + ((k + 1) & 1) * H2_BUF;
                if (k + 1 <= 31) {
#pragma unroll
                    for (int i = 0; i < 4; ++i) { const int id = pt + 256 * i, tau = id >> 4, ch = id & 15; *(LAS u32x4*)(gn + H2_VT + tau * HG_QS + ch * 16) = rv[i]; }
                    {
                        const int fr = lane & 15, ch = lane >> 4;
#define HG_BF(w_, j_) (((j_) & 1) ? __uint_as_float((w_)[(j_) >> 1] & 0xffff0000u) : __uint_as_float((w_)[(j_) >> 1] << 16))
#define HG_DPP(v_, ctrl_) __int_as_float(__builtin_amdgcn_update_dpp(0, __float_as_int(v_), ctrl_, 0xf, 0xf, false))
#define HG_SCAN8(Pi, CTRL) asm volatile("s_nop 1\n\t" \
                            "v_mul_f32_dpp %0, %0, %0 " CTRL " row_mask:0xf bank_mask:0xf\n\tv_mul_f32_dpp %1, %1, %1 " CTRL " row_mask:0xf bank_mask:0xf\n\t" \
                            "v_mul_f32_dpp %2, %2, %2 " CTRL " row_mask:0xf bank_mask:0xf\n\tv_mul_f32_dpp %3, %3, %3 " CTRL " row_mask:0xf bank_mask:0xf\n\t" \
                            "v_mul_f32_dpp %4, %4, %4 " CTRL " row_mask:0xf bank_mask:0xf\n\tv_mul_f32_dpp %5, %5, %5 " CTRL " row_mask:0xf bank_mask:0xf\n\t" \
                            "v_mul_f32_dpp %6, %6, %6 " CTRL " row_mask:0xf bank_mask:0xf\n\tv_mul_f32_dpp %7, %7, %7 " CTRL " row_mask:0xf bank_mask:0xf" \
                            : "+v"(Pi[0]), "+v"(Pi[1]), "+v"(Pi[2]), "+v"(Pi[3]), "+v"(Pi[4]), "+v"(Pi[5]), "+v"(Pi[6]), "+v"(Pi[7]))
#define HG_CARRY8(Pd, Ps) asm volatile("s_nop 1\n\t" \
                            "v_mul_f32_dpp %0, %8, %0 row_newbcast:15 row_mask:0xf bank_mask:0xf\n\tv_mul_f32_dpp %1, %9, %1 row_newbcast:15 row_mask:0xf bank_mask:0xf\n\t" \
                            "v_mul_f32_dpp %2, %10, %2 row_newbcast:15 row_mask:0xf bank_mask:0xf\n\tv_mul_f32_dpp %3, %11, %3 row_newbcast:15 row_mask:0xf bank_mask:0xf\n\t" \
                            "v_mul_f32_dpp %4, %12, %4 row_newbcast:15 row_mask:0xf bank_mask:0xf\n\tv_mul_f32_dpp %5, %13, %5 row_newbcast:15 row_mask:0xf bank_mask:0xf\n\t" \
                            "v_mul_f32_dpp %6, %14, %6 row_newbcast:15 row_mask:0xf bank_mask:0xf\n\tv_mul_f32_dpp %7, %15, %7 row_newbcast:15 row_mask:0xf bank_mask:0xf" \
                            : "+v"(Pd[0]), "+v"(Pd[1]), "+v"(Pd[2]), "+v"(Pd[3]), "+v"(Pd[4]), "+v"(Pd[5]), "+v"(Pd[6]), "+v"(Pd[7]) \
                            : "v"(Ps[0]), "v"(Ps[1]), "v"(Ps[2]), "v"(Ps[3]), "v"(Ps[4]), "v"(Ps[5]), "v"(Ps[6]), "v"(Ps[7]))
                        float P[4][8];
#pragma unroll
                        for (int i = 0; i < 4; ++i)
#pragma unroll
                            for (int j = 0; j < 8; ++j) P[i][j] = HG_BF(rf[i], j);
                        HG_SCAN8(P[0], "row_shr:1"); HG_SCAN8(P[1], "row_shr:1"); HG_SCAN8(P[2], "row_shr:1"); HG_SCAN8(P[3], "row_shr:1");
                        HG_SCAN8(P[0], "row_shr:2"); HG_SCAN8(P[1], "row_shr:2"); HG_SCAN8(P[2], "row_shr:2"); HG_SCAN8(P[3], "row_shr:2");
                        HG_SCAN8(P[0], "row_shr:4"); HG_SCAN8(P[1], "row_shr:4"); HG_SCAN8(P[2], "row_shr:4"); HG_SCAN8(P[3], "row_shr:4");
                        HG_SCAN8(P[0], "row_shr:8"); HG_SCAN8(P[1], "row_shr:8"); HG_SCAN8(P[2], "row_shr:8"); HG_SCAN8(P[3], "row_shr:8");
                        HG_CARRY8(P[1], P[0]); HG_CARRY8(P[3], P[2]);
                        float t0[8], t1[8], rt0[8];
#pragma unroll
                        for (int i = 0; i < 4; ++i)
#pragma unroll
                            for (int j = 0; j < 8; ++j) P[i][j] = __builtin_amdgcn_fmed3f(P[i][j], 1e-30f, 3.0e38f);
#pragma unroll
                        for (int j = 0; j < 8; ++j) { t0[j] = HG_DPP(P[1][j], 0x15F); t1[j] = HG_DPP(P[3][j], 0x15F); rt0[j] = __builtin_amdgcn_rcpf(t0[j]); }
#pragma unroll
                        for (int i = 0; i < 4; ++i) {
                            float qo[8], ko[8];
#pragma unroll
                            for (int j = 0; j < 8; ++j) { const float Pv = P[i][j], rP = __builtin_amdgcn_rcpf(Pv);
                                const float eq = (i >= 2) ? Pv : Pv * rt0[j], ek = (i >= 2) ? rP : t0[j] * rP;
                                qo[j] = HG_BF(rq[i], j) * eq; ko[j] = __builtin_fmaf(-HG_BF(rf[i], j), ek, ek); }
                            u32x4 qw, kw;
                            qw.x = pg8::cvt_pk_bf16(qo[0], qo[1]); qw.y = pg8::cvt_pk_bf16(qo[2], qo[3]); qw.z = pg8::cvt_pk_bf16(qo[4], qo[5]); qw.w = pg8::cvt_pk_bf16(qo[6], qo[7]);
                            kw.x = pg8::cvt_pk_bf16(ko[0], ko[1]); kw.y = pg8::cvt_pk_bf16(ko[2], ko[3]); kw.z = pg8::cvt_pk_bf16(ko[4], ko[5]); kw.w = pg8::cvt_pk_bf16(ko[6], ko[7]);
                            const int row = 16 * i + fr;
                            *(LAS u32x4*)(gn + H2_QT + row * HG_QS + (32 * pw + 8 * ch) * 2) = qw; *(LAS u32x4*)(gn + H2_KT + row * HG_QS + (32 * pw + 8 * ch) * 2) = kw;
                        }
                        LAS float* srefn = (LAS float*)(gn + H2_MISC);
                        if (fr == 0) {
#pragma unroll
                            for (int j = 0; j < 8; ++j) { srefn[32 * pw + 8 * ch + j] = t0[j]; srefn[128 + 32 * pw + 8 * ch + j] = t1[j]; } }
#undef HG_DPP
#undef HG_BF
#undef HG_SCAN8
#undef HG_CARRY8
                    }
                }
                if (k + 2 <= 31) {
                    const int c0 = (dir ? (31 - (k + 2)) : (k + 2)) * 64;
#pragma unroll
                    for (int i = 0; i < 4; ++i) { const int row = 16 * i + (lane & 15), ch = lane >> 4; const int t = dir ? (c0 + 63 - row) : (c0 + row);
                        const bf16_t* src = pb + (size_t)t * INC + h * 128 + 32 * pw + 8 * ch; rq[i] = *(const u32x4*)src; rf[i] = *(const u32x4*)(src + 512 + dir * 512); }
#pragma unroll
                    for (int i = 0; i < 4; ++i) { const int id = pt + 256 * i, tau = id >> 4, ch = id & 15; const int t = dir ? (c0 + 63 - tau) : (c0 + tau);
                        rv[i] = *(const u32x4*)(pb + (size_t)t * INC + 1536 + h * 128 + 8 * ch); }
                }
                HG_BAR();
                if (k + 1 <= 31 && pw < 3) {
                    const int r = lane & 31, hh = lane >> 5;
                    const int st_ = (pw == 2) ? 1 : 0, tt_ = (pw == 0) ? 0 : 1;
                    f32x16 sa;
#pragma unroll
                    for (int i = 0; i < 16; ++i) sa[i] = 0.f;
#pragma unroll
                    for (int ks = 0; ks < 8; ++ks) {
                        const bf16x8 ka = *(const LAS bf16x8*)(gn + H2_KT + (32 * st_ + r) * HG_QS + (16 * ks + 8 * hh) * 2);
                        const bf16x8 qb = *(const LAS bf16x8*)(gn + H2_QT + (32 * tt_ + r) * HG_QS + (16 * ks + 8 * hh) * 2);
                        sa = __builtin_amdgcn_mfma_f32_32x32x16_bf16(ka, qb, sa, 0, 0, 0);
                    }
                    const int tau_abs = 32 * tt_ + r;
#pragma unroll
                    for (int rg = 0; rg < 4; ++rg) { float v4[4];
#pragma unroll
                        for (int i = 0; i < 4; ++i) { const int sig_abs = 32 * st_ + 8 * rg + 4 * hh + i; v4[i] = (sig_abs <= tau_abs) ? sa[4 * rg + i] : 0.f; }
                        u32x2 wv2; wv2.x = pg8::cvt_pk_bf16(v4[0], v4[1]); wv2.y = pg8::cvt_pk_bf16(v4[2], v4[3]);
                        *(LAS u32x2*)(gn + H2_ST + tau_abs * HG_SS + (32 * st_ + 8 * rg + 4 * hh) * 2) = wv2; }
                }
                HG_BAR();
            }
        }
        asm volatile("s_waitcnt vmcnt(0)" ::: "memory");
        __syncthreads();
        LAS int* flagp = (LAS int*)(lds + H2_FLAG);
        if (o_tid(WV) == 0) {
            __builtin_amdgcn_fence(__ATOMIC_RELEASE, "agent");
            asm volatile("s_waitcnt vmcnt(0)" ::: "memory");
            const int old = __hip_atomic_fetch_add(p.hdone + layer * 64 + b * 4 + h, 1, __ATOMIC_RELAXED, __HIP_MEMORY_SCOPE_AGENT);
            if (old == 1) { __builtin_amdgcn_fence(__ATOMIC_ACQUIRE, "agent"); asm volatile("s_waitcnt vmcnt(0)" ::: "memory"); }
            *flagp = old;
        }
        __syncthreads();
        if (*flagp == 1) {
            const int tid = o_tid(WV);
            bf16_t* yb = p.y + (size_t)b * SEQ * DM + h * 128; const bf16_t* obb = p.ob + (size_t)b * SEQ * 512 + h * 128; const bf16_t* gb = pb + 2048 + h * 128;
#pragma unroll 1
            for (int it = 0; it < (SEQ * 4) / NTHREADS; ++it) {
                const int piece = tid + NTHREADS * it, row = piece >> 2, seg = piece & 3;
                u32x4* yp = (u32x4*)(yb + (size_t)row * DM + seg * 32); const u32x4* op = (const u32x4*)(obb + (size_t)row * 512 + seg * 32); const u32x4* gp = (const u32x4*)(gb + (size_t)row * INC + seg * 32);
                u32x4 fv[4], bv[4], gv[4];
#pragma unroll
                for (int i = 0; i < 4; ++i) { fv[i] = yp[i]; bv[i] = op[i]; gv[i] = gp[i]; }
                __builtin_amdgcn_sched_barrier(0);
                f32x4 e[8]; float ss = 0.f;
#pragma unroll
                for (int i = 0; i < 4; ++i) {
                    e[2 * i][0] = __uint_as_float(fv[i].x << 16) + __uint_as_float(bv[i].x << 16); e[2 * i][1] = __uint_as_float(fv[i].x & 0xffff0000u) + __uint_as_float(bv[i].x & 0xffff0000u);
                    e[2 * i][2] = __uint_as_float(fv[i].y << 16) + __uint_as_float(bv[i].y << 16); e[2 * i][3] = __uint_as_float(fv[i].y & 0xffff0000u) + __uint_as_float(bv[i].y & 0xffff0000u);
                    e[2 * i + 1][0] = __uint_as_float(fv[i].z << 16) + __uint_as_float(bv[i].z << 16); e[2 * i + 1][1] = __uint_as_float(fv[i].z & 0xffff0000u) + __uint_as_float(bv[i].z & 0xffff0000u);
                    e[2 * i + 1][2] = __uint_as_float(fv[i].w << 16) + __uint_as_float(bv[i].w << 16); e[2 * i + 1][3] = __uint_as_float(fv[i].w & 0xffff0000u) + __uint_as_float(bv[i].w & 0xffff0000u);
                    const f32x4 q0 = e[2 * i] * e[2 * i], q1 = e[2 * i + 1] * e[2 * i + 1]; ss += (q0[0] + q0[1]) + (q0[2] + q0[3]) + (q1[0] + q1[1]) + (q1[2] + q1[3]); }
                ss += __shfl_xor(ss, 1); ss += __shfl_xor(ss, 2);
                const float rn = rsqrtf(ss * (1.0f / 128.0f) + 1e-6f);
#pragma unroll
                for (int i = 0; i < 4; ++i) { u32x4 o4;
                    o4.x = pg8::cvt_pk_bf16(e[2 * i][0] * rn * __uint_as_float(gv[i].x << 16), e[2 * i][1] * rn * __uint_as_float(gv[i].x & 0xffff0000u));
                    o4.y = pg8::cvt_pk_bf16(e[2 * i][2] * rn * __uint_as_float(gv[i].y << 16), e[2 * i][3] * rn * __uint_as_float(gv[i].y & 0xffff0000u));
                    o4.z = pg8::cvt_pk_bf16(e[2 * i + 1][0] * rn * __uint_as_float(gv[i].z << 16), e[2 * i + 1][1] * rn * __uint_as_float(gv[i].z & 0xffff0000u));
                    o4.w = pg8::cvt_pk_bf16(e[2 * i + 1][2] * rn * __uint_as_float(gv[i].w << 16), e[2 * i + 1][3] * rn * __uint_as_float(gv[i].w & 0xffff0000u));
                    yp[i] = o4; }
            }
        }
        __syncthreads();
    }
}

#define RT_STRIDE 1028
__device__ void ln_router_phase(int WV, const bf16_t* mix, bf16_t* xb, const float* g, const float* bta, const float* w1, const float* b1, const float* w2, const float* b2,
                                int* expert, float* gate, int* rank, int* hist  , int* slot_tok, LAS float* wl) {
    const int TID = o_tid(WV), BID = o_bid();
    LAS int* lhist = (LAS int*)((LAS unsigned char*)wl + 150 * 1024);
    if (TID < NEXP) lhist[TID] = 0;
    for (long i = (long)BID * NTHREADS + TID; i < PSLOTS; i += (long)gridDim.x * NTHREADS) slot_tok[i] = T_TOK;
    {
        f32x4 t1[2], t2[16];
#pragma unroll
        for (int m = 0; m < 2; ++m) t1[m] = ((const f32x4*)w1)[TID + NTHREADS * m];
#pragma unroll
        for (int m = 0; m < 16; ++m) t2[m] = ((const f32x4*)w2)[TID + NTHREADS * m];
        __builtin_amdgcn_sched_barrier(0);
#pragma unroll
        for (int m = 0; m < 2; ++m) { const int k = TID + NTHREADS * m;
#pragma unroll
            for (int i = 0; i < 4; ++i) wl[i * RT_STRIDE + k] = t1[m][i]; }
#pragma unroll
        for (int m = 0; m < 16; ++m) { const int q = TID + NTHREADS * m, k = q >> 3, o4 = (q & 7) * 4;
#pragma unroll
            for (int i = 0; i < 4; ++i) wl[(4 + o4 + i) * RT_STRIDE + k] = t2[m][i]; }
        if (TID < 32) wl[36 * RT_STRIDE + TID] = b2[TID];
    }
    __syncthreads();
    const int lane = TID & 63, gw = BID * NWAVES + (TID >> 6), ngw = gridDim.x * NWAVES;
    const LAS float* wlane = wl + 4 * lane;
    f32x4 gg[4], bb[4];
#pragma unroll
    for (int j = 0; j < 4; ++j) { gg[j] = ((const f32x4*)g)[lane + 64 * j]; bb[j] = ((const f32x4*)bta)[lane + 64 * j]; }
    float b1v[4];
#pragma unroll
    for (int o = 0; o < 4; ++o) b1v[o] = b1[o];
    long w = gw;
    u32x2 hb_[4], mx_[4];
    if (w < T_TOK) {
#pragma unroll
        for (int j = 0; j < 4; ++j) { hb_[j] = ((const u32x2*)(xb + w * DM))[lane + 64 * j]; mx_[j] = ((const u32x2*)(mix + w * DM))[lane + 64 * j]; } }
    for (; w < T_TOK; w += ngw) {
        u32x2 hn_[4], mn_[4]; const long wn = w + ngw;
        if (wn < T_TOK) {
#pragma unroll
            for (int j = 0; j < 4; ++j) { hn_[j] = ((const u32x2*)(xb + wn * DM))[lane + 64 * j]; mn_[j] = ((const u32x2*)(mix + wn * DM))[lane + 64 * j]; } }
        __builtin_amdgcn_sched_barrier(0);
        f32x4 v[4];
#pragma unroll
        for (int j = 0; j < 4; ++j) { v[j][0] = ALPHA * __uint_as_float(hb_[j].x << 16) + __uint_as_float(mx_[j].x << 16); v[j][1] = ALPHA * __uint_as_float(hb_[j].x & 0xffff0000u) + __uint_as_float(mx_[j].x & 0xffff0000u);
            v[j][2] = ALPHA * __uint_as_float(hb_[j].y << 16) + __uint_as_float(mx_[j].y << 16); v[j][3] = ALPHA * __uint_as_float(hb_[j].y & 0xffff0000u) + __uint_as_float(mx_[j].y & 0xffff0000u); }
        float s = 0.f;
#pragma unroll
        for (int j = 0; j < 4; ++j) s += (v[j][0] + v[j][1]) + (v[j][2] + v[j][3]);
        const float mu = wave_sum(s) * (1.0f / 1024.0f);
        float qq = 0.f;
#pragma unroll
        for (int j = 0; j < 4; ++j) { const f32x4 d = v[j] - mu; qq += (d[0] * d[0] + d[1] * d[1]) + (d[2] * d[2] + d[3] * d[3]); }
        const float r = rsqrtf(wave_sum(qq) * (1.0f / 1024.0f) + 1e-5f);
        u32x2* xp = (u32x2*)(xb + w * DM) + lane;
#pragma unroll
        for (int j = 0; j < 4; ++j) { v[j] = (v[j] - mu) * r * gg[j] + bb[j];
            u32x2 o; o.x = pg8::cvt_pk_bf16(v[j][0], v[j][1]); o.y = pg8::cvt_pk_bf16(v[j][2], v[j][3]); xp[64 * j] = o; }
        float l1[4];
#pragma unroll
        for (int o = 0; o < 4; o += 2) {
            f32x2 a0 = {0.f, 0.f}, b0 = a0, a1 = a0, b1 = a0;
#pragma unroll
            for (int j = 0; j < 4; ++j) { const f32x4 w0 = *(const LAS f32x4*)(wlane + o * RT_STRIDE + 256 * j), w1 = *(const LAS f32x4*)(wlane + (o + 1) * RT_STRIDE + 256 * j);
                const f32x2 vlo = (f32x2){v[j][0], v[j][1]}, vhi = (f32x2){v[j][2], v[j][3]};
                a0 = vlo * (f32x2){w0[0], w0[1]} + a0; a1 = vlo * (f32x2){w1[0], w1[1]} + a1; b0 = vhi * (f32x2){w0[2], w0[3]} + b0; b1 = vhi * (f32x2){w1[2], w1[3]} + b1; }
            const f32x2 t0 = a0 + b0, t1 = a1 + b1; l1[o] = t0[0] + t0[1]; l1[o + 1] = t1[0] + t1[1]; }
        wave_sum_n<4>(l1);
        int grp = 0; float mx = l1[0] + b1v[0];
#pragma unroll
        for (int o = 0; o < 4; ++o) l1[o] += b1v[o];
#pragma unroll
        for (int o = 1; o < 4; ++o) if (l1[o] > mx) { mx = l1[o]; grp = o; }
        grp = __builtin_amdgcn_readfirstlane(grp);
        float den = 0.f;
#pragma unroll
        for (int o = 0; o < 4; ++o) den += __expf(l1[o] - mx);
        const float pgrp = __builtin_amdgcn_rcpf(den);
        float l2[8];
        const LAS float* wg2 = wlane + (4 + grp * 8) * RT_STRIDE;
#pragma unroll
        for (int o = 0; o < 8; o += 2) {
            f32x2 a0 = {0.f, 0.f}, b0 = a0, a1 = a0, b1 = a0;
#pragma unroll
            for (int j = 0; j < 4; ++j) { const f32x4 w0 = *(const LAS f32x4*)(wg2 + o * RT_STRIDE + 256 * j), w1 = *(const LAS f32x4*)(wg2 + (o + 1) * RT_STRIDE + 256 * j);
                const f32x2 vlo = (f32x2){v[j][0], v[j][1]}, vhi = (f32x2){v[j][2], v[j][3]};
                a0 = vlo * (f32x2){w0[0], w0[1]} + a0; a1 = vlo * (f32x2){w1[0], w1[1]} + a1; b0 = vhi * (f32x2){w0[2], w0[3]} + b0; b1 = vhi * (f32x2){w1[2], w1[3]} + b1; }
            const f32x2 t0 = a0 + b0, t1 = a1 + b1; l2[o] = t0[0] + t0[1]; l2[o + 1] = t1[0] + t1[1]; }
        wave_sum_n<8>(l2);
#pragma unroll
        for (int o = 0; o < 8; ++o) l2[o] += wl[36 * RT_STRIDE + grp * 8 + o];
        int e0 = 0; float m0 = l2[0];
#pragma unroll
        for (int o = 1; o < 8; ++o) if (l2[o] > m0) { m0 = l2[o]; e0 = o; }
        int e1 = -1; float m1 = -3.0e38f;
#pragma unroll
        for (int o = 0; o < 8; ++o) if (o != e0 && l2[o] > m1) { m1 = l2[o]; e1 = o; }
        const float rr = __expf(m1 - m0);
        const float wa = __builtin_amdgcn_rcpf(1.0f + rr), wb = rr * wa;
        if (lane == 0) {
            const int ea = grp * 8 + e0, eb = grp * 8 + e1;
            expert[w * 2] = ea; expert[w * 2 + 1] = eb;
            gate[w * 2] = pgrp * wa; gate[w * 2 + 1] = pgrp * wb;
            rank[w * 2] = __hip_atomic_fetch_add(lhist + ea, 1, __ATOMIC_RELAXED, __HIP_MEMORY_SCOPE_WORKGROUP);
            rank[w * 2 + 1] = __hip_atomic_fetch_add(lhist + eb, 1, __ATOMIC_RELAXED, __HIP_MEMORY_SCOPE_WORKGROUP);
        }
#pragma unroll
        for (int j = 0; j < 4; ++j) { hb_[j] = hn_[j]; mx_[j] = mn_[j]; }
    }
    __syncthreads();
    if (TID < NEXP) hist[BID * NEXP + TID] = lhist[TID];
}
__device__ void moe_tables(int WV, const int* hist, int* lds_pstart, int* lds_tile_exp) {
    const int TID = o_tid(WV), BID = o_bid();
    int* tot = lds_pstart + 384; int* part = lds_pstart + 416; int* base = lds_pstart + 448;
    if (TID < 64) tot[TID] = 0;
    __syncthreads();
    const int nent = gridDim.x * NEXP;
    int tl = 0, pl = 0;
    for (int i0 = TID; i0 < nent; i0 += 16 * NTHREADS) {
        int vv_[16];
#pragma unroll
        for (int k = 0; k < 16; ++k) { const int i = i0 + k * NTHREADS; vv_[k] = (i < nent) ? __hip_atomic_load(hist + i, __ATOMIC_RELAXED, __HIP_MEMORY_SCOPE_AGENT) : 0; }
#pragma unroll
        for (int k = 0; k < 16; ++k) { const int i = i0 + k * NTHREADS; tl += vv_[k]; if ((i >> 5) < BID) pl += vv_[k]; }
    }
    __hip_atomic_fetch_add(tot + (TID & 31), tl, __ATOMIC_RELAXED, __HIP_MEMORY_SCOPE_WORKGROUP);
    __hip_atomic_fetch_add(part + (TID & 31), pl, __ATOMIC_RELAXED, __HIP_MEMORY_SCOPE_WORKGROUP);
    __syncthreads();
    if (TID < 64) {
        const int nt = (TID < NEXP) ? ((tot[TID] + 255) >> 8) : 0;
        int inc = nt;
#pragma unroll
        for (int s = 1; s < 32; s <<= 1) { const int v = __shfl_up(inc, s); if ((TID & 63) >= s) inc += v; }
        const int exc = inc - nt;
        if (TID < NEXP) { lds_pstart[TID] = exc * 256; base[TID] = exc * 256 + part[TID]; }
        if (TID == NEXP - 1) lds_pstart[32] = inc;
    }
    __syncthreads();
    if (TID < NTILES) {
        const int nact = lds_pstart[32];
        int e = -1;
        if (TID < nact) {
#pragma unroll 1
            for (int q = 0; q < NEXP; ++q) { if ((lds_pstart[q] >> 8) <= TID) e = q; }
        }
        lds_tile_exp[TID] = e;
    }
    __syncthreads();
}
__device__ void moe_scatter_phase(int WV, const int* expert, const int* rank, const int* lds_pstart, int* slot_tok, int* dest) {
    const int TID = o_tid(WV), BID = o_bid();
    const int* base = lds_pstart + 448;
    const int ngw = gridDim.x * NWAVES;
    for (int a = TID; a < 2 * NWAVES * ((T_TOK + ngw - 1) / ngw); a += NTHREADS) {
        const int r = a >> 1, k = a & 1;
        const long w = (long)(BID * NWAVES + (r & 7)) + (long)ngw * (r >> 3);
        if (w < T_TOK) { const long i = w * 2 + k; const int s = base[expert[i]] + rank[i]; dest[i] = s; slot_tok[s] = (int)w; }
    }
}
__device__ void moe_combine_ln_phase(int WV, float* h, bf16_t* xb, const bf16_t* ys, const int* dest, const float* gate, const float* g, const float* bta, bool write_xb) {
    const int TID = o_tid(WV), BID = o_bid();
    const int lane = TID & 63, gw = BID * NWAVES + (TID >> 6), ngw = gridDim.x * NWAVES;
    f32x4 gg[4], bb[4];
#pragma unroll
    for (int j = 0; j < 4; ++j) { gg[j] = ((const f32x4*)g)[lane + 64 * j]; bb[j] = ((const f32x4*)bta)[lane + 64 * j]; }
    if (ngw * 16 != T_TOK) {
        long w = gw;
        int d0n = 0, d1n = 0; float g0n = 0.f, g1n = 0.f;
        u32x2 hv[4]; u32x2 ya[4], yb[4]; float g0 = 0.f, g1 = 0.f;
        if (w < T_TOK) { const int d0 = dest[w * 2], d1 = dest[w * 2 + 1]; g0 = gate[w * 2]; g1 = gate[w * 2 + 1];
    #pragma unroll
            for (int j = 0; j < 4; ++j) { hv[j] = ((const u32x2*)(xb + w * DM))[lane + 64 * j]; ya[j] = ((const u32x2*)(ys + (long)d0 * DM))[lane + 64 * j]; yb[j] = ((const u32x2*)(ys + (long)d1 * DM))[lane + 64 * j]; } }
        if (w + ngw < T_TOK) { d0n = dest[(w + ngw) * 2]; d1n = dest[(w + ngw) * 2 + 1]; g0n = gate[(w + ngw) * 2]; g1n = gate[(w + ngw) * 2 + 1]; }
        for (; w < T_TOK; w += ngw) {
            u32x2 hn[4]; u32x2 yan[4], ybn[4]; const float g0c = g0n, g1c = g1n;
            const long wn = w + ngw, wnn = w + 2 * (long)ngw;
            if (wn < T_TOK) {
    #pragma unroll
                for (int j = 0; j < 4; ++j) { hn[j] = ((const u32x2*)(xb + wn * DM))[lane + 64 * j]; yan[j] = ((const u32x2*)(ys + (long)d0n * DM))[lane + 64 * j]; ybn[j] = ((const u32x2*)(ys + (long)d1n * DM))[lane + 64 * j]; } }
            if (wnn < T_TOK) { d0n = dest[wnn * 2]; d1n = dest[wnn * 2 + 1]; g0n = gate[wnn * 2]; g1n = gate[wnn * 2 + 1]; }
            __builtin_amdgcn_sched_barrier(0);
            f32x4 v[4]; float s = 0.f;
    #pragma unroll
            for (int j = 0; j < 4; ++j) {
                v[j][0] = ALPHA * __uint_as_float(hv[j].x << 16) + g0 * __uint_as_float(ya[j].x << 16) + g1 * __uint_as_float(yb[j].x << 16);
                v[j][1] = ALPHA * __uint_as_float(hv[j].x & 0xffff0000u) + g0 * __uint_as_float(ya[j].x & 0xffff0000u) + g1 * __uint_as_float(yb[j].x & 0xffff0000u);
                v[j][2] = ALPHA * __uint_as_float(hv[j].y << 16) + g0 * __uint_as_float(ya[j].y << 16) + g1 * __uint_as_float(yb[j].y << 16);
                v[j][3] = ALPHA * __uint_as_float(hv[j].y & 0xffff0000u) + g0 * __uint_as_float(ya[j].y & 0xffff0000u) + g1 * __uint_as_float(yb[j].y & 0xffff0000u);
                s += (v[j][0] + v[j][1]) + (v[j][2] + v[j][3]); }
            const float mu = wave_sum(s) * (1.0f / 1024.0f);
            float qq = 0.f;
    #pragma unroll
            for (int j = 0; j < 4; ++j) { const f32x4 d = v[j] - mu; qq += (d[0] * d[0] + d[1] * d[1]) + (d[2] * d[2] + d[3] * d[3]); }
            const float r = rsqrtf(wave_sum(qq) * (1.0f / 1024.0f) + 1e-5f);
    #pragma unroll
            for (int j = 0; j < 4; ++j) { const f32x4 o = (v[j] - mu) * r * gg[j] + bb[j]; if (!write_xb) ((f32x4*)(h + w * DM))[lane + 64 * j] = o;
                if (write_xb) { u32x2 ob; ob.x = pg8::cvt_pk_bf16(o[0], o[1]); ob.y = pg8::cvt_pk_bf16(o[2], o[3]); ((u32x2*)(xb + w * DM))[lane + 64 * j] = ob; } }
    #pragma unroll
            for (int j = 0; j < 4; ++j) { hv[j] = hn[j]; ya[j] = yan[j]; yb[j] = ybn[j]; }
            g0 = g0c; g1 = g1c;
        }
        return;
    }
    int dv0 = 0, dv1 = 0; float gv0 = 0.f, gv1 = 0.f;
    { const long wr = gw + (long)(lane & 15) * ngw; if (wr < T_TOK) { dv0 = dest[wr * 2]; dv1 = dest[wr * 2 + 1]; gv0 = gate[wr * 2]; gv1 = gate[wr * 2 + 1]; } }
    u32x2 hv[2][4]; u32x2 ya[2][4], yb[2][4];
#define CMB_LOAD(HV, YA, YB, i_) do { _Pragma("unroll") for (int q_ = 0; q_ < 2; ++q_) { const int ii_ = (i_) + 8 * q_; const long wq_ = gw + (long)ii_ * ngw; \
        const int d0_ = __builtin_amdgcn_readlane(dv0, ii_), d1_ = __builtin_amdgcn_readlane(dv1, ii_); \
        _Pragma("unroll") for (int j = 0; j < 4; ++j) { HV[q_][j] = ((const u32x2*)(xb + wq_ * DM))[lane + 64 * j]; YA[q_][j] = ((const u32x2*)(ys + (long)d0_ * DM))[lane + 64 * j]; YB[q_][j] = ((const u32x2*)(ys + (long)d1_ * DM))[lane + 64 * j]; } } } while (0)
    CMB_LOAD(hv, ya, yb, 0);
#pragma unroll 1
    for (int i = 0; i < 8; ++i) {
        u32x2 hn[2][4]; u32x2 yan[2][4], ybn[2][4];
        if (i < 7) CMB_LOAD(hn, yan, ybn, i + 1);
        __builtin_amdgcn_sched_barrier(0);
#pragma unroll
        for (int q = 0; q < 2; ++q) {
            const int ii = i + 8 * q; const long w = gw + (long)ii * ngw;
            const float g0 = __int_as_float(__builtin_amdgcn_readlane(__float_as_int(gv0), ii)), g1 = __int_as_float(__builtin_amdgcn_readlane(__float_as_int(gv1), ii));
            f32x4 v[4]; float s = 0.f;
#pragma unroll
            for (int j = 0; j < 4; ++j) {
                v[j][0] = ALPHA * __uint_as_float(hv[q][j].x << 16) + g0 * __uint_as_float(ya[q][j].x << 16) + g1 * __uint_as_float(yb[q][j].x << 16);
                v[j][1] = ALPHA * __uint_as_float(hv[q][j].x & 0xffff0000u) + g0 * __uint_as_float(ya[q][j].x & 0xffff0000u) + g1 * __uint_as_float(yb[q][j].x & 0xffff0000u);
                v[j][2] = ALPHA * __uint_as_float(hv[q][j].y << 16) + g0 * __uint_as_float(ya[q][j].y << 16) + g1 * __uint_as_float(yb[q][j].y << 16);
                v[j][3] = ALPHA * __uint_as_float(hv[q][j].y & 0xffff0000u) + g0 * __uint_as_float(ya[q][j].y & 0xffff0000u) + g1 * __uint_as_float(yb[q][j].y & 0xffff0000u);
                s += (v[j][0] + v[j][1]) + (v[j][2] + v[j][3]); }
            const float mu = wave_sum(s) * (1.0f / 1024.0f);
            float qq = 0.f;
#pragma unroll
            for (int j = 0; j < 4; ++j) { const f32x4 d = v[j] - mu; qq += (d[0] * d[0] + d[1] * d[1]) + (d[2] * d[2] + d[3] * d[3]); }
            const float r = rsqrtf(wave_sum(qq) * (1.0f / 1024.0f) + 1e-5f);
#pragma unroll
            for (int j = 0; j < 4; ++j) { const f32x4 o = (v[j] - mu) * r * gg[j] + bb[j]; if (!write_xb) ((f32x4*)(h + w * DM))[lane + 64 * j] = o;
                if (write_xb) { u32x2 ob; ob.x = pg8::cvt_pk_bf16(o[0], o[1]); ob.y = pg8::cvt_pk_bf16(o[2], o[3]); ((u32x2*)(xb + w * DM))[lane + 64 * j] = ob; } }
        }
#pragma unroll
        for (int q = 0; q < 2; ++q)
#pragma unroll
            for (int j = 0; j < 4; ++j) { hv[q][j] = hn[q][j]; ya[q][j] = yan[q][j]; yb[q][j] = ybn[q][j]; }
    }
#undef CMB_LOAD
}

#define XB_TMO      128
#define XB_XCNT(j)  (256  + 64 * (j))
#define XB_XSUB(j)  (1280 + 64 * (j))
#define XB_XGEN(j)  (2304 + 64 * (j))
#define XB_TOP      3328
#define XB_TOPGEN   3392
#define XCD_BAR_WORDS 3456
#define RESET_WORDS (1024 + XCD_BAR_WORDS)
#define XB_SPIN_CAP (1u << 22)
__device__ __forceinline__ unsigned xb_ld(unsigned* p)              { return __hip_atomic_load(p, __ATOMIC_RELAXED, __HIP_MEMORY_SCOPE_AGENT); }
__device__ __forceinline__ unsigned xb_add(unsigned* p, unsigned v) { return __hip_atomic_fetch_add(p, v, __ATOMIC_RELAXED, __HIP_MEMORY_SCOPE_AGENT); }
__device__ __forceinline__ unsigned xb_xcc_id() { return (unsigned)__builtin_amdgcn_s_getreg((3 << 11) | 20) & 0xFu; }
#define XB_SPIN(cond, bar) do { unsigned _sp = 0; while (cond) { __builtin_amdgcn_s_sleep(1); \
    if ((++_sp & 255u) == 0u) { if (xb_ld(&(bar)[XB_TMO])) break; if (_sp > XB_SPIN_CAP) { atomicAdd(&(bar)[XB_TMO], 1u); break; } } } } while (0)
struct XcdBarrier { unsigned* bar; unsigned x; volatile LAS unsigned* st; };
__device__ __forceinline__ XcdBarrier xcd_barrier_post(unsigned* bar, volatile LAS unsigned* st, bool leader) {
    XcdBarrier b; b.bar = bar; b.x = xb_xcc_id(); b.st = st;
    if (leader) st[2] = xb_add(&bar[XB_XCNT(b.x)], 1u);
    return b;
}
__device__ __forceinline__ void xcd_barrier_complete(unsigned* bar, unsigned x, unsigned& nloc, unsigned& nx, unsigned& before) {
    const unsigned G = gridDim.x * gridDim.y * gridDim.z;
    unsigned sum, cnt, mine, bef, sp = 0u;
    for (;;) {
        sum = 0u; cnt = 0u; mine = 0u; bef = 0u;
#pragma unroll
        for (unsigned j = 0; j < 16; ++j) { const unsigned c = xb_ld(&bar[XB_XCNT(j)]); sum += c; cnt += (c > 0u) ? 1u : 0u; mine = (j == x) ? c : mine; bef += (j < x) ? c : 0u; }
        if (sum == G) break;
        __builtin_amdgcn_s_sleep(1);
        if ((++sp & 255u) == 0u) { if (xb_ld(&bar[XB_TMO])) break; if (sp > XB_SPIN_CAP) { atomicAdd(&bar[XB_TMO], 1u); break; } }
    }
    nloc = mine > 0u ? mine : 1u; nx = cnt > 0u ? cnt : 1u; before = bef;
}
__device__ __forceinline__ void xcd_barrier(const XcdBarrier& b, bool leader) {
    asm volatile("s_waitcnt vmcnt(0)" ::: "memory");
    __syncthreads();
    if (leader) {
        unsigned* bar = b.bar;
        __builtin_amdgcn_s_waitcnt(0);
        unsigned nloc = b.st[0], nx = b.st[1];
        if (nloc == 0u) { unsigned bef; xcd_barrier_complete(bar, b.x, nloc, nx, bef); b.st[0] = nloc; b.st[1] = nx; b.st[3] = bef; }
        const unsigned old = xb_add(&bar[XB_XSUB(b.x)], 1u);
        const unsigned gen = old / nloc;
        if (old + 1u == (gen + 1u) * nloc) {
            __builtin_amdgcn_fence(__ATOMIC_RELEASE, "agent");
            asm volatile("s_waitcnt vmcnt(0)" ::: "memory");
            const unsigned og = xb_add(&bar[XB_TOP], 1u);
            const unsigned tg = og / nx;
            if (og + 1u == (tg + 1u) * nx) xb_add(&bar[XB_TOPGEN], 1u);
            else XB_SPIN(xb_ld(&bar[XB_TOPGEN]) == tg, bar);
            __builtin_amdgcn_fence(__ATOMIC_ACQUIRE, "agent");
            xb_add(&bar[XB_XGEN(b.x)], 1u);
            asm volatile("s_waitcnt vmcnt(0)" ::: "memory");
        } else {
            XB_SPIN(xb_ld(&bar[XB_XGEN(b.x)]) == gen, bar);
            __builtin_amdgcn_fence(__ATOMIC_ACQUIRE, "agent");
            asm volatile("s_waitcnt vmcnt(0)" ::: "memory");
        }
    }
    __syncthreads();
}

__global__ void __launch_bounds__(NTHREADS, 2) fwd_megakernel(Params p) {
    extern __shared__ __attribute__((aligned(16))) unsigned char lds_raw[];
    cg::grid_group grid = cg::this_grid();
    const int WV = __builtin_amdgcn_readfirstlane(threadIdx.x >> 6);
    float* lds = (float*)lds_raw;
    LAS unsigned char* ldsl = (LAS unsigned char*)lds_raw;
    int* lds_pstart = (int*)(lds_raw + LDS_TAB_OFF);
    int* lds_tile_exp = lds_pstart + 64;
    int* lds_tok = lds_pstart + 512;
    volatile LAS unsigned* xst = (volatile LAS unsigned*)(lds_raw + LDS_BYTES - 16);
    const bool xlead = (o_tid(WV) == 0);
    if (xlead) { xst[0] = 0u; xst[1] = 0u; }
    __syncthreads();
    if (o_bid() == 0) { const int t0 = o_tid(WV); for (int i = t0; i < RESET_WORDS; i += NTHREADS) p.counts[i] = 0; }
    rope_table_phase(WV, p.rope_tab, p.lbtab, p.lb_logits);
    convert_dense_phase(WV, p, ldsl);
    grid.sync();
    const XcdBarrier xb = xcd_barrier_post(p.bar, xst, xlead);
#pragma unroll 1
    for (int l = 0; l < 2; ++l) {
        { pg8::Gemm g{p.xb, p.wt_in + (size_t)l * INC * DM, DM, 0, nullptr}; pg8::StaticOrder S; S.init(T_TOK, INC, gridDim.x, o_bid());
          pg8::EpiInProj E{p.proj, p.rope_tab, p.lbtab + l * 1024, p.norm_g + l * 512};
          pg8::gemm_phase<pg8::EpiInProj, pg8::StaticOrder, false>(WV, ldsl, g, S, E, nullptr, (int)((2u * xb.x) & 15u)); }
        xcd_barrier(xb, o_tid(WV) == 0);
        hgrn2_phase(WV, p, l, ldsl);
        attn_phase(WV, p, l, p.proj, p.y, ldsl, p.counts + 128 + l);
        xcd_barrier(xb, o_tid(WV) == 0);
        { pg8::Gemm g{p.y, p.wt_out + (size_t)l * DM * DM, DM, 0, nullptr}; pg8::StaticOrder S; S.init(T_TOK, DM, gridDim.x, o_bid());
          pg8::EpiBf16Plain E{p.mix, DM};
          pg8::gemm_phase<pg8::EpiBf16Plain, pg8::StaticOrder, false>(WV, ldsl, g, S, E, nullptr, (int)((2u * xb.x) & 15u)); }
        xcd_barrier(xb, o_tid(WV) == 0);
        ln_router_phase(WV, p.mix, p.xb, p.ln1_g + l * DM, p.ln1_b + l * DM, p.rw1 + l * DM * 4, p.rb1 + l * 4, p.rw2 + l * DM * 32, p.rb2 + l * 32, p.expert, p.gate, p.rank, p.hist, p.slot_tok, (LAS float*)ldsl);
        xcd_barrier(xb, o_tid(WV) == 0);
        moe_tables(WV, p.hist, lds_pstart, lds_tile_exp);
        moe_scatter_phase(WV, p.expert, p.rank, lds_pstart, p.slot_tok, p.dest);
        xcd_barrier(xb, o_tid(WV) == 0);
        { const int xn = (int)xst[0], xr = (int)xst[2], xbef = (int)xst[3];
          { pg8::Gemm g{p.xb, p.wt_gu, DM, (long)DM * DM, p.slot_tok}; pg8::MoeOrderPub S; S.init(lds_pstart[32], 4, xn, xr, xbef, gridDim.x, lds_tile_exp); S.cnt = p.mcnt + l * NTILES;
            pg8::EpiGateUp E{p.hid};
            { const int t0 = o_tid(WV); pg8::Unit u; for (int i = 0; S.next(i, u); ++i) { if (t0 < 256) lds_tok[i * 256 + t0] = p.slot_tok[u.pm * 256 + t0]; } }
            __syncthreads();
            pg8::gemm_phase<pg8::EpiGateUp, pg8::MoeOrderPub, true>(WV, ldsl, g, S, E, (const LAS int*)lds_tok); }
          { pg8::Gemm g{p.hid, p.wt_dn, DEXP, (long)DM * DEXP, nullptr}; pg8::MoeOrderWait S; S.init(lds_pstart[32], 4, xn, (xr + xn / 2) % xn, xbef, gridDim.x, lds_tile_exp); S.cnt = p.mcnt + l * NTILES;
            S.pollw = (LAS int*)(lds_raw + LDS_BYTES - 32);
            pg8::EpiBf16Plain E{p.ys, DM};
            pg8::gemm_phase<pg8::EpiBf16Plain, pg8::MoeOrderWait, false>(WV, ldsl, g, S, E, nullptr); } }
        xcd_barrier(xb, o_tid(WV) == 0);
        moe_combine_ln_phase(WV, p.hbuf, p.xb, p.ys, p.dest, p.gate, p.ln2_g + l * DM, p.ln2_b + l * DM, l == 0);
        if (l == 0) xcd_barrier(xb, o_tid(WV) == 0);
    }
}

extern "C" void kernel_launch(void* const* d_in, const int* in_sizes, int n_in, void* d_out, int out_size, void* d_ws, size_t ws_size, hipStream_t stream) {
    static int grid_blocks = 0;
    if (!grid_blocks) {
        int dev = 0, cus = 0, per_cu = 0;
        (void)hipGetDevice(&dev);
        (void)hipDeviceGetAttribute(&cus, hipDeviceAttributeMultiprocessorCount, dev);
        (void)hipFuncSetAttribute((const void*)fwd_megakernel, hipFuncAttributeMaxDynamicSharedMemorySize, LDS_BYTES);
        (void)hipOccupancyMaxActiveBlocksPerMultiprocessor(&per_cu, (const void*)fwd_megakernel, NTHREADS, LDS_BYTES);
        if (per_cu < 1) { fprintf(stderr, "occupancy query says %d blocks/CU\n", per_cu); per_cu = 1; }
        grid_blocks = cus;
        fprintf(stderr, "megakernel: cus=%d per_cu=%d grid=%d\n", cus, per_cu, grid_blocks);
    }
    Params p{};
    p.x = (const float*)d_in[0]; p.w_in = (const float*)d_in[1]; p.lb_logits = (const float*)d_in[2]; p.norm_g = (const float*)d_in[3]; p.w_out = (const float*)d_in[4];
    p.ln1_g = (const float*)d_in[5]; p.ln1_b = (const float*)d_in[6]; p.rw1 = (const float*)d_in[7]; p.rb1 = (const float*)d_in[8]; p.rw2 = (const float*)d_in[9]; p.rb2 = (const float*)d_in[10];
    p.wg = (const float*)d_in[11]; p.wu = (const float*)d_in[12]; p.wd = (const float*)d_in[13]; p.ln2_g = (const float*)d_in[14]; p.ln2_b = (const float*)d_in[15];
    p.hbuf = (float*)d_out;
    char* ws = (char*)d_ws;
    size_t off = 0;
    auto take = [&](size_t bytes) { char* q = ws + off; off += (bytes + 255) & ~(size_t)255; return q; };
    p.counts = (int*)take(4096);
    p.bar = (unsigned*)take((size_t)XCD_BAR_WORDS * 4);
    p.hist = (int*)take((size_t)1024 * NEXP * 4);
    p.rope_tab = (float2*)take((size_t)SEQ * 8 * 8);
    p.lbtab = (float*)take((size_t)2 * 2 * 512 * 4);
    p.expert = (int*)take((size_t)T_TOK * 2 * 4);
    p.rank = (int*)take((size_t)T_TOK * 2 * 4);
    p.gate = (float*)take((size_t)T_TOK * 2 * 4);
    p.dest = (int*)take((size_t)T_TOK * 2 * 4);
    p.slot_tok = (int*)take((size_t)PSLOTS * 4);
    p.wt_in = (bf16_t*)take((size_t)2 * INC * DM * 2);
    p.wt_out = (bf16_t*)take((size_t)2 * DM * DM * 2);
    p.xb = (bf16_t*)take((size_t)T_TOK * DM * 2);
    char* big = take(0);
    p.proj = (bf16_t*)big;
    p.y = (bf16_t*)(big + (size_t)T_TOK * INC * 2);
    p.o_f = (float*)(big + (size_t)T_TOK * INC * 2 + (size_t)T_TOK * DM * 2);
    p.o_b = p.o_f + (size_t)T_TOK * 512;
    char* moe = big + (size_t)T_TOK * INC * 2 + (size_t)T_TOK * DM * 2;
    p.wt_gu = (bf16_t*)moe;
    p.wt_dn = (bf16_t*)(moe + (size_t)NEXP * DM * DM * 2);
    p.ob = (bf16_t*)(moe + (size_t)NEXP * DM * DM * 2 + (size_t)NEXP * DM * DEXP * 2);
    p.hdone = p.counts;
    p.mcnt = p.counts + 256;
    p.hid = (bf16_t*)big;
    p.mix = (bf16_t*)big;
    p.ys = (bf16_t*)(big + (size_t)PSLOTS * DEXP * 2);
    if (off + (size_t)T_TOK * INC * 2 + (size_t)T_TOK * DM * 2 + (size_t)T_TOK * 512 * 8 > ws_size) fprintf(stderr, "workspace too small: %zu\n", ws_size);
    void* args[] = {&p};
    hipError_t e = hipLaunchCooperativeKernel((const void*)fwd_megakernel, dim3(grid_blocks), dim3(NTHREADS), args, LDS_BYTES, stream);
    if (e != hipSuccess) fprintf(stderr, "cooperative launch failed: %s (grid %d)\n", hipGetErrorString(e), grid_blocks);
}
```
